# Optimizing an MI355X kernel written in HIP

```python
import math
import jax, jax.numpy as jnp
from jax import lax
import numpy as np

D_MODEL = 1024
BATCH = 16
SEQ = 2048
DEPTH = 2

CHUNK = 64
Q_BLOCK = 128
HEAD_DIM = 64
N_HEADS_FOX = D_MODEL // (4 * HEAD_DIM)
N_HEADS_DIFF = D_MODEL // (4 * 2 * HEAD_DIM)
DIFF_QK_DIM = HEAD_DIM
DIFF_V_DIM = 2 * HEAD_DIM
N_HEADS_CHK = D_MODEL // (4 * HEAD_DIM)
CHUNK_LOOKBACK = 8
MAX_REL_DIST = 128
D_FF = 2816
CONV_WIDTH = 3
RMS_EPS = 1e-6
NEG_INF = -1e30

FOX_W = N_HEADS_FOX * HEAD_DIM
DIFF_QK_W = N_HEADS_DIFF * 2 * DIFF_QK_DIM
DIFF_W = N_HEADS_DIFF * DIFF_V_DIM
CHK_W = N_HEADS_CHK * HEAD_DIM
MIX_WIDTH = FOX_W + DIFF_W + CHK_W
IN_SPLITS = (FOX_W, FOX_W, FOX_W, N_HEADS_FOX, DIFF_QK_W, DIFF_QK_W, DIFF_W, CHK_W, CHK_W, CHK_W)
N_IN = 3 * FOX_W + N_HEADS_FOX + 2 * DIFF_QK_W + DIFF_W + 3 * CHK_W

kernel_name = 'hybrid_fox_diff_chunk_convffn_encoder'


def rms_norm(x, g):
    xf = x.astype(jnp.float32)
    y = xf * lax.rsqrt(jnp.mean(xf * xf, axis=-1, keepdims=True) + RMS_EPS)
    return (y * g.astype(jnp.float32)).astype(x.dtype)


def split_columns(proj):
    outs = []
    start = 0
    for w in IN_SPLITS:
        outs.append(proj[..., start:start + w])
        start += w
    return outs


def alibi_slopes(n_heads):
    return jnp.asarray([2.0 ** (-8.0 * (i + 1) / n_heads) for i in range(n_heads)], jnp.float32)


def forgetting_attention(q, k, v, log_f):
    S, D = q.shape[1], q.shape[3]
    cum = jnp.transpose(jnp.cumsum(log_f, axis=1), (0, 2, 1))
    scale = D ** -0.5
    outs = []
    for blk in range(S // Q_BLOCK):
        q0, q1 = blk * Q_BLOCK, (blk + 1) * Q_BLOCK
        s = jnp.einsum('bqhd,bkhd->bhqk', q[:, q0:q1], k[:, :q1]).astype(jnp.float32) * scale
        s = s + cum[:, :, q0:q1, None] - cum[:, :, None, :q1]
        qpos = jnp.arange(q0, q1)[:, None]
        kpos = jnp.arange(q1)[None, :]
        s = jnp.where(kpos <= qpos, s, NEG_INF)
        p = jax.nn.softmax(s, axis=-1).astype(v.dtype)
        outs.append(jnp.einsum('bhqk,bkhd->bqhd', p, v[:, :q1]))
    return jnp.concatenate(outs, axis=1)


def differential_attention(q, k, v, lam, slopes):
    S, Dqk = q.shape[1], q.shape[4]
    scale = Dqk ** -0.5
    outs = []
    for blk in range(S // Q_BLOCK):
        q0, q1 = blk * Q_BLOCK, (blk + 1) * Q_BLOCK
        s = jnp.einsum('bqhcd,bkhcd->bhcqk', q[:, q0:q1], k[:, :q1]).astype(jnp.float32) * scale
        qpos = jnp.arange(q0, q1)[:, None]
        kpos = jnp.arange(q1)[None, :]
        dist = jnp.abs(qpos - kpos).astype(jnp.float32)
        s = s - slopes[None, :, None, None, None] * dist
        allowed = (kpos // CHUNK) <= (qpos // CHUNK)
        s = jnp.where(allowed, s, NEG_INF)
        p = jax.nn.softmax(s, axis=-1)
        a = (p[:, :, 0] - lam * p[:, :, 1]).astype(v.dtype)
        outs.append(jnp.einsum('bhqk,bkhd->bqhd', a, v[:, :q1]))
    return jnp.concatenate(outs, axis=1)


def chunked_band_attention(q, k, v, rel_table):
    B, S, H, D = q.shape
    nc = S // CHUNK
    band = (CHUNK_LOOKBACK + 1) * CHUNK
    qc = q.reshape(B, nc, CHUNK, H, D)

    def gather_band(t):
        tc = t.reshape(B, nc, CHUNK, H, D)
        tp = jnp.pad(tc, ((0, 0), (CHUNK_LOOKBACK, 0), (0, 0), (0, 0), (0, 0)))
        return jnp.concatenate([tp[:, j:j + nc] for j in range(CHUNK_LOOKBACK + 1)], axis=2)

    kb, vb = gather_band(k), gather_band(v)
    s = jnp.einsum('bcqhd,bckhd->bchqk', qc, kb).astype(jnp.float32) * (D ** -0.5)
    i = jnp.arange(CHUNK)[:, None]
    j = jnp.arange(band)[None, :]
    rel = jnp.clip(i + CHUNK_LOOKBACK * CHUNK - j, -(CHUNK - 1), MAX_REL_DIST)
    bias = rel_table.astype(jnp.float32)[:, rel + CHUNK - 1]
    s = s + bias[None, None]
    key_chunk = jnp.arange(nc)[:, None] - CHUNK_LOOKBACK + (jnp.arange(band) // CHUNK)[None, :]
    valid = key_chunk >= 0
    s = jnp.where(valid[None, :, None, None, :], s, NEG_INF)
    p = jax.nn.softmax(s, axis=-1).astype(v.dtype)
    out = jnp.einsum('bchqk,bckhd->bcqhd', p, vb)
    return out.reshape(B, S, H, D)


def conv_gated_mlp(h, w_up, conv_w, conv_b, w_down):
    uv = h @ w_up
    S = uv.shape[1]
    padded = jnp.pad(uv, ((0, 0), (CONV_WIDTH - 1, 0), (0, 0)))
    y = conv_b
    for tap in range(CONV_WIDTH):
        y = y + conv_w[tap] * padded[:, tap:tap + S]
    u, g = jnp.split(y, 2, axis=-1)
    return (jax.nn.silu(g) * u) @ w_down


def setup_inputs(seed: int = 0) -> dict:
    key = jax.random.key(seed)
    ks = jax.random.split(key, 16)

    def nrm(k, shape, scale):
        return jax.random.normal(k, shape, jnp.float32) * scale

    return {
        'x': nrm(ks[0], (BATCH, SEQ, D_MODEL), 1.0),
        'g_mix': 1.0 + nrm(ks[1], (DEPTH, D_MODEL), 0.02),
        'w_in': nrm(ks[2], (DEPTH, D_MODEL, N_IN), D_MODEL ** -0.5),
        'b_fox_f': 2.0 + nrm(ks[3], (DEPTH, N_HEADS_FOX), 0.5),
        'diff_lambda': nrm(ks[4], (DEPTH, 4, DIFF_QK_DIM), 0.1),
        'g_diff': 1.0 + nrm(ks[5], (DEPTH, DIFF_V_DIM), 0.02),
        'rel_bias': nrm(ks[6], (DEPTH, N_HEADS_CHK, CHUNK + MAX_REL_DIST), 0.1),
        'w_out': nrm(ks[7], (DEPTH, MIX_WIDTH, D_MODEL), MIX_WIDTH ** -0.5),
        'g_ffn': 1.0 + nrm(ks[8], (DEPTH, D_MODEL), 0.02),
        'w_ffn_in': nrm(ks[9], (DEPTH, D_MODEL, 2 * D_FF), D_MODEL ** -0.5),
        'conv_w': nrm(ks[10], (DEPTH, CONV_WIDTH, 2 * D_FF), CONV_WIDTH ** -0.5),
        'conv_b': nrm(ks[11], (DEPTH, 2 * D_FF), 0.01),
        'w_ffn_out': nrm(ks[12], (DEPTH, D_FF, D_MODEL), D_FF ** -0.5),
        'g_final': 1.0 + nrm(ks[13], (D_MODEL,), 0.02),
    }


def reference(x, g_mix, w_in, b_fox_f, diff_lambda, g_diff, rel_bias, w_out,
              g_ffn, w_ffn_in, conv_w, conv_b, w_ffn_out, g_final):
    B, S, _ = x.shape
    slopes = alibi_slopes(N_HEADS_DIFF)
    for l in range(DEPTH):
        h = rms_norm(x, g_mix[l])
        proj = h @ w_in[l]
        fq, fk, fv, ff, dq, dk, dv, cq, ck, cv = split_columns(proj)

        log_f = jax.nn.log_sigmoid(ff.astype(jnp.float32) + b_fox_f[l].astype(jnp.float32))
        out_a = forgetting_attention(
            fq.reshape(B, S, N_HEADS_FOX, HEAD_DIM),
            fk.reshape(B, S, N_HEADS_FOX, HEAD_DIM),
            fv.reshape(B, S, N_HEADS_FOX, HEAD_DIM), log_f)

        lambda_init = 0.8 - 0.6 * math.exp(-0.3 * l)
        lam_vecs = diff_lambda[l].astype(jnp.float32)
        lam = (jnp.exp(jnp.sum(lam_vecs[0] * lam_vecs[1]))
               - jnp.exp(jnp.sum(lam_vecs[2] * lam_vecs[3])) + lambda_init)
        out_b = differential_attention(
            dq.reshape(B, S, N_HEADS_DIFF, 2, DIFF_QK_DIM),
            dk.reshape(B, S, N_HEADS_DIFF, 2, DIFF_QK_DIM),
            dv.reshape(B, S, N_HEADS_DIFF, DIFF_V_DIM), lam, slopes)
        out_b = rms_norm(out_b, g_diff[l]) * (1.0 - lambda_init)

        out_c = chunked_band_attention(
            cq.reshape(B, S, N_HEADS_CHK, HEAD_DIM),
            ck.reshape(B, S, N_HEADS_CHK, HEAD_DIM),
            cv.reshape(B, S, N_HEADS_CHK, HEAD_DIM), rel_bias[l])

        mix = jnp.concatenate([out_a.reshape(B, S, FOX_W),
                               out_b.reshape(B, S, DIFF_W),
                               out_c.reshape(B, S, CHK_W)], axis=-1)
        x = x + mix @ w_out[l]

        x = x + conv_gated_mlp(rms_norm(x, g_ffn[l]), w_ffn_in[l], conv_w[l], conv_b[l], w_ffn_out[l])
    return rms_norm(x, g_final)
```

```cpp
#include <hip/hip_runtime.h>
#include <cstdio>
#include <cstdint>
#include <hip/hip_cooperative_groups.h>
namespace cg = cooperative_groups;
namespace pg8 {
#define PG8_LAS __attribute__((address_space(3)))
typedef unsigned short bf16_t;
typedef short bf16x8 __attribute__((ext_vector_type(8)));
typedef float f32x4 __attribute__((ext_vector_type(4)));
typedef unsigned u32x4 __attribute__((ext_vector_type(4)));
constexpr int BM = 256, BK = 64, HALF = 128, HTB = HALF * BK * 2  , STAGE_BYTES = 8 * HTB, NXCD = 8, WGM = 8;

__host__ __device__ __forceinline__ int lds_byte(int r, int c) { const int st = (r >> 4) * 2 + (c >> 5), rr = r & 15, cc = c & 31, ob = rr * 64 + cc * 2; return st * 1024 + (ob ^ (((ob >> 9) & 1) << 5)); }
__host__ __device__ __forceinline__ void stage_rc(int b, int& R, int& C) { const int st = b / 1024, sb = b % 1024, swz = sb ^ (((sb >> 9) & 1) << 5); R = (st >> 1) * 16 + swz / 64; C = (st & 1) * 32 + (swz % 64) / 2; }
__host__ __device__ __forceinline__ int perm32(int rho) { const int n = rho >> 4, i = rho & 15; return 8 * (i >> 2) + 4 * n + (i & 3); }

struct Unit { int pm, pn; };
struct Gemm { const bf16_t* A; const bf16_t* Bt; int M, N, K; };

struct StaticOrder {
    int nM, nN, nwg, G, c;
    __host__ __device__ void init(int M, int N, int G_, int c_) { nM = M / BM; nN = N / BM; nwg = nM * nN; G = G_; c = c_; }
    __host__ __device__ bool next(int i, Unit& u) const {
        const long L = (long)i * G + c; if (L >= nwg) return false;
        int wgid = (int)L; { const int q = nwg / NXCD, r = nwg % NXCD, xcd = wgid % NXCD, off = wgid / NXCD; wgid = (xcd < r ? xcd * (q + 1) : r * (q + 1) + (xcd - r) * q) + off; }
        const int nig = WGM * nN, gid = wgid / nig, fm = gid * WGM, gsz = (nM - fm) < WGM ? (nM - fm) : WGM;
        u.pm = fm + ((wgid % nig) % gsz); u.pn = (wgid % nig) / gsz; return true;
    }
    __device__ __forceinline__ void a_ready(const Unit&) const {}
    __device__ __forceinline__ void done(const Unit&) const {}
};

typedef float f32x2c __attribute__((ext_vector_type(2))); typedef __bf16 bf16x2c __attribute__((ext_vector_type(2)));
__device__ __forceinline__ unsigned cvt_pk_bf16(float lo, float hi) { f32x2c v = {lo, hi}; bf16x2c b = __builtin_convertvector(v, bf16x2c); return __builtin_bit_cast(unsigned, b); }
typedef float f32x2 __attribute__((ext_vector_type(2)));
struct EpiBf16 {
    static constexpr bool PERM = true, AFTER_DRAIN = false, APERM = false;
    bf16_t* O; int ldc;
    __device__ __forceinline__ void operator()(const f32x4 (&acc)[2][2][4][2], const Unit& u, int wr, int wc, int fr, int fq) const {
        const int row0 = u.pm * BM + wr * 64 + fr; const int col0 = u.pn * BM + wc * 32 + 8 * fq;
#pragma unroll
        for (int ai = 0; ai < 2; ++ai)
#pragma unroll
            for (int m = 0; m < 4; ++m) { bf16_t* rowp = O + (size_t)(row0 + ai * HALF + m * 16) * ldc + col0;
#pragma unroll
                for (int bj = 0; bj < 2; ++bj) { const f32x4 v0 = acc[ai][bj][m][0], v1 = acc[ai][bj][m][1];
                    u32x4 w; w.x = cvt_pk_bf16(v0[0], v0[1]); w.y = cvt_pk_bf16(v0[2], v0[3]); w.z = cvt_pk_bf16(v1[0], v1[1]); w.w = cvt_pk_bf16(v1[2], v1[3]);
                    *(u32x4*)(rowp + bj * HALF) = w; } }
    }
};
struct EpiRes {
    static constexpr bool PERM = false, AFTER_DRAIN = false, APERM = false;
    const float* base; float* out; int ldc; float scale;
    __device__ __forceinline__ void operator()(const f32x4 (&acc)[2][2][4][2], const Unit& u, int wr, int wc, int fr, int fq) const {
        const int col0 = u.pn * BM + wc * 32 + 4 * fq;
#pragma unroll
        for (int ai = 0; ai < 2; ++ai)
#pragma unroll
            for (int m = 0; m < 4; ++m) { const size_t off = (size_t)(u.pm * BM + ai * HALF + wr * 64 + m * 16 + fr) * ldc + col0;
#pragma unroll
                for (int bj = 0; bj < 2; ++bj)
#pragma unroll
                    for (int n = 0; n < 2; ++n) { const f32x4 bs = *(const f32x4*)(base + off + bj * HALF + n * 16); *(f32x4*)(out + off + bj * HALF + n * 16) = bs + acc[ai][bj][m][n] * scale; } }
    }
};

__device__ __forceinline__ f32x4 dpp_shr1(f32x4 v) { f32x4 r;
#pragma unroll
    for (int i = 0; i < 4; ++i) r[i] = __shfl_up(v[i], 1, 16);
    return r; }
__device__ __forceinline__ f32x4 silu_mul(f32x4 yu, f32x4 yg) { f32x4 o;
#pragma unroll
    for (int i = 0; i < 4; ++i) o[i] = yu[i] * yg[i] * __builtin_amdgcn_rcpf(1.0f + __builtin_amdgcn_exp2f(-1.4426950408889634f * yg[i]));
    return o; }
struct EpiConv {
    static constexpr bool PERM = false, AFTER_DRAIN = false, APERM = true;
    bf16_t* act; bf16_t* halo; const float* cw; const float* cb;
    __device__ __forceinline__ void operator()(const f32x4 (&acc)[2][2][4][2], const Unit& u, int wr, int wc, int fr, int fq) const {
        constexpr int DFFc = 2816, N2 = 5632;
        typedef unsigned u32x2e __attribute__((ext_vector_type(2)));
#pragma unroll
        for (int n = 0; n < 2; ++n) {
            const int cu = u.pn * 128 + wc * 32 + n * 16 + 4 * fq, cg = DFFc + cu;
            const f32x4 w0u = *(const f32x4*)(cw + cu), w1u = *(const f32x4*)(cw + N2 + cu), w2u = *(const f32x4*)(cw + 2 * N2 + cu), bu = *(const f32x4*)(cb + cu);
            const f32x4 w0g = *(const f32x4*)(cw + cg), w1g = *(const f32x4*)(cw + N2 + cg), w2g = *(const f32x4*)(cw + 2 * N2 + cg), bg = *(const f32x4*)(cb + cg);
#pragma unroll
            for (int ai = 0; ai < 2; ++ai) {
                const f32x4 U0 = acc[ai][0][0][n], U1 = acc[ai][0][1][n], U2 = acc[ai][0][2][n], U3 = acc[ai][0][3][n];
                const f32x4 G0 = acc[ai][1][0][n], G1 = acc[ai][1][1][n], G2 = acc[ai][1][2][n], G3 = acc[ai][1][3][n];
                const f32x4 Um1 = dpp_shr1(U3), Um2 = dpp_shr1(U2), Gm1 = dpp_shr1(G3), Gm2 = dpp_shr1(G2);
                const int row0 = u.pm * BM + ai * HALF + wr * 64 + 4 * fr;
                f32x4 o[4];
                o[0] = silu_mul(bu + w0u * Um2 + w1u * Um1 + w2u * U0, bg + w0g * Gm2 + w1g * Gm1 + w2g * G0);
                o[1] = silu_mul(bu + w0u * Um1 + w1u * U0 + w2u * U1, bg + w0g * Gm1 + w1g * G0 + w2g * G1);
                o[2] = silu_mul(bu + w0u * U0 + w1u * U1 + w2u * U2, bg + w0g * G0 + w1g * G1 + w2g * G2);
                o[3] = silu_mul(bu + w0u * U1 + w1u * U2 + w2u * U3, bg + w0g * G1 + w1g * G2 + w2g * G3);
#pragma unroll
                for (int m = 0; m < 4; ++m) if (fr != 0 || m >= 2) { u32x2e w; w.x = cvt_pk_bf16(o[m][0], o[m][1]); w.y = cvt_pk_bf16(o[m][2], o[m][3]);
                    *(u32x2e*)(act + (size_t)(row0 + m) * DFFc + cu) = w; }
                if (fr == 0 || fr == 15) { bf16_t* hp = halo + ((size_t)(row0 >> 6) * 4 + (fr == 0 ? 0 : 2)) * N2;
                    const f32x4 ua = fr == 0 ? U0 : U2, ub = fr == 0 ? U1 : U3, ga = fr == 0 ? G0 : G2, gb = fr == 0 ? G1 : G3;
                    u32x2e w; w.x = cvt_pk_bf16(ua[0], ua[1]); w.y = cvt_pk_bf16(ua[2], ua[3]); *(u32x2e*)(hp + cu) = w;
                    w.x = cvt_pk_bf16(ub[0], ub[1]); w.y = cvt_pk_bf16(ub[2], ub[3]); *(u32x2e*)(hp + N2 + cu) = w;
                    w.x = cvt_pk_bf16(ga[0], ga[1]); w.y = cvt_pk_bf16(ga[2], ga[3]); *(u32x2e*)(hp + cg) = w;
                    w.x = cvt_pk_bf16(gb[0], gb[1]); w.y = cvt_pk_bf16(gb[2], gb[3]); *(u32x2e*)(hp + N2 + cg) = w; }
            }
        }
    }
};
template <class Epi, class Sched, bool ALIGN_EPI = false, bool SP2 = false>
__device__ __forceinline__ void gemm_phase(PG8_LAS unsigned char* lds, const Gemm g, const Sched& S, const Epi& E) {
    int tid_l = threadIdx.x; asm volatile("" : "+v"(tid_l)); const int tid = tid_l, wid = __builtin_amdgcn_readfirstlane(tid >> 6), lane = tid & 63, wr = wid >> 2, wc = wid & 3, fr = lane & 15, fq = lane >> 4;
    const int K = g.K, nt = K / BK;
    unsigned voffA[2], voffB[2];
#pragma unroll
    for (int i = 0; i < 2; ++i) { int R, C; stage_rc(tid * 16 + i * 8192, R, C); const int Rb = Epi::PERM ? ((R & ~31) + perm32(R & 31)) : R;
        const int Ra = Epi::APERM ? ((R & 64) + (R & 15) * 4 + ((R >> 4) & 3)) : R; voffA[i] = (unsigned)(Ra * K + C) * 2u; voffB[i] = (unsigned)(Rb * K + C) * 2u; }
    const size_t kstep = (size_t)(BK * 2);
    const size_t hstep = (size_t)HALF * K * 2;
    const size_t tstep = 2 * hstep;
    const unsigned ldsw = (unsigned)wid * 1024u;
    const int aoff = lds_byte(wr * 64 + fr, fq * 8), boff = lds_byte(wc * 32 + fr, fq * 8);
#define PG8_SA(b, h) (((b) * 2 + (h)) * HTB)
#define PG8_SB(b, h) ((4 + (b) * 2 + (h)) * HTB)
#define PG8_STAGE(bufoff, gbase, voff) do { _Pragma("unroll") for (int _i = 0; _i < 2; ++_i) \
        __builtin_amdgcn_global_load_lds((const unsigned*)((const char*)(gbase) + (voff)[_i]), (PG8_LAS unsigned*)(lds + (bufoff) + ldsw + _i * 8192), 16, 0, 0); } while (0)
#define PG8_LDA(dst, b, h) do { _Pragma("unroll") for (int m = 0; m < 4; ++m) _Pragma("unroll") for (int k = 0; k < 2; ++k) dst[m][k] = *(const PG8_LAS bf16x8*)(lds + PG8_SA(b, h) + aoff + m * 2048 + k * 1024); } while (0)
#define PG8_LDB(dst, b, h) do { _Pragma("unroll") for (int n = 0; n < 2; ++n) _Pragma("unroll") for (int k = 0; k < 2; ++k) dst[n][k] = *(const PG8_LAS bf16x8*)(lds + PG8_SB(b, h) + boff + n * 2048 + k * 1024); } while (0)
#define PG8_MMA(ai, bj, At, Bt) do { __builtin_amdgcn_s_setprio(1); _Pragma("unroll") for (int m = 0; m < 4; ++m) _Pragma("unroll") for (int n = 0; n < 2; ++n) _Pragma("unroll") for (int k = 0; k < 2; ++k) \
        acc[ai][bj][m][n] = __builtin_amdgcn_mfma_f32_16x16x32_bf16(Bt[n][k], At[m][k], acc[ai][bj][m][n], 0, 0, 0); __builtin_amdgcn_s_setprio(0); } while (0)
#define PG8_WAIT_V(n) asm volatile("s_waitcnt vmcnt(" #n ")" ::: "memory")
#define PG8_WAIT_L(n) asm volatile("s_waitcnt lgkmcnt(" #n ")" ::: "memory")
#define PG8_BAR __builtin_amdgcn_s_barrier()
#define PG8_SCHED __builtin_amdgcn_sched_barrier(0)
    Unit cur, nxt; int ui = 0;
    if (!S.next(0, cur)) return;
    f32x4 acc[2][2][4][2];
#pragma unroll
    for (int a = 0; a < 2; ++a)
#pragma unroll
        for (int b = 0; b < 2; ++b)
#pragma unroll
            for (int m = 0; m < 4; ++m)
#pragma unroll
                for (int n = 0; n < 2; ++n) acc[a][b][m][n] = (f32x4){0.f, 0.f, 0.f, 0.f};
    bf16x8 At[4][2], B0[2][2], B1[2][2];
    const char* cA = (const char*)g.A + (size_t)cur.pm * tstep; const char* cB = (const char*)g.Bt + (size_t)cur.pn * tstep;
    S.a_ready(cur);
    if constexpr (SP2) {
        PG8_STAGE(PG8_SB(0, 0), cB, voffB); PG8_STAGE(PG8_SB(0, 1), cB + hstep, voffB); PG8_STAGE(PG8_SA(0, 0), cA, voffA); PG8_STAGE(PG8_SA(0, 1), cA + hstep, voffA);
        if (wr == 1) PG8_BAR;
        PG8_WAIT_V(2); PG8_BAR;
        PG8_STAGE(PG8_SB(1, 0), cB + kstep, voffB); PG8_STAGE(PG8_SA(1, 0), cA + kstep, voffA); PG8_STAGE(PG8_SB(1, 1), cB + hstep + kstep, voffB);
        PG8_WAIT_V(6); PG8_BAR;
    } else {
        PG8_STAGE(PG8_SB(0, 0), cB, voffB); PG8_STAGE(PG8_SA(0, 0), cA, voffA); PG8_STAGE(PG8_SB(0, 1), cB + hstep, voffB); PG8_STAGE(PG8_SA(0, 1), cA + hstep, voffA);
        if (wr == 1) PG8_BAR;
        PG8_WAIT_V(4); PG8_BAR;
        PG8_STAGE(PG8_SB(1, 0), cB + kstep, voffB); PG8_STAGE(PG8_SA(1, 0), cA + kstep, voffA); PG8_STAGE(PG8_SB(1, 1), cB + hstep + kstep, voffB);
        PG8_WAIT_V(6); PG8_BAR;
    }
    for (;;) {
        const bool has_next = S.next(ui + 1, nxt);
        const char* nA = has_next ? (const char*)g.A + (size_t)nxt.pm * tstep : cA; const char* nB = has_next ? (const char*)g.Bt + (size_t)nxt.pn * tstep : cB;
        for (int t = 0; t < nt; t += 2) {
            const bool last = (t == nt - 2);
            const char* a1 = cA + (size_t)(t + 1) * kstep;
            const char* a2 = last ? nA : cA + (size_t)(t + 2) * kstep; const char* b2 = last ? nB : cB + (size_t)(t + 2) * kstep;
            const char* a3 = a2 + kstep; const char* b3 = b2 + kstep;
            if (last && has_next) S.a_ready(nxt);
            if constexpr (SP2) {
            PG8_LDB(B0, 0, 0); PG8_LDB(B1, 0, 1); PG8_SCHED; PG8_LDA(At, 0, 0); PG8_STAGE(PG8_SA(1, 1), a1 + hstep, voffA);
            PG8_WAIT_V(8); PG8_WAIT_L(0); PG8_BAR; PG8_MMA(0, 0, At, B0); PG8_MMA(0, 1, At, B1); PG8_BAR; PG8_SCHED;
            PG8_LDA(At, 0, 1); PG8_STAGE(PG8_SB(0, 0), b2, voffB); PG8_STAGE(PG8_SB(0, 1), b2 + hstep, voffB); PG8_STAGE(PG8_SA(0, 0), a2, voffA);
            PG8_WAIT_V(8); PG8_WAIT_L(0); PG8_BAR; PG8_MMA(1, 0, At, B0); PG8_MMA(1, 1, At, B1); PG8_BAR; PG8_SCHED;
            PG8_LDB(B0, 1, 0); PG8_LDB(B1, 1, 1); PG8_SCHED; PG8_LDA(At, 1, 0); PG8_STAGE(PG8_SA(0, 1), a2 + hstep, voffA);
            PG8_WAIT_V(8); PG8_WAIT_L(0); PG8_BAR; PG8_MMA(0, 0, At, B0); PG8_MMA(0, 1, At, B1); PG8_BAR; PG8_SCHED;
            PG8_LDA(At, 1, 1); PG8_STAGE(PG8_SB(1, 0), b3, voffB); PG8_STAGE(PG8_SB(1, 1), b3 + hstep, voffB); PG8_STAGE(PG8_SA(1, 0), a3, voffA);
            PG8_WAIT_V(8); PG8_WAIT_L(0); PG8_BAR; PG8_MMA(1, 0, At, B0); PG8_MMA(1, 1, At, B1); PG8_BAR; PG8_SCHED;
            } else {
            PG8_LDB(B0, 0, 0); PG8_SCHED; PG8_LDA(At, 0, 0); PG8_STAGE(PG8_SA(1, 1), a1 + hstep, voffA);
            PG8_WAIT_L(8); PG8_BAR; PG8_WAIT_L(0); PG8_MMA(0, 0, At, B0); PG8_BAR; PG8_SCHED;
            PG8_LDB(B1, 0, 1); PG8_STAGE(PG8_SB(0, 0), b2, voffB);
            PG8_BAR; PG8_WAIT_L(0); PG8_MMA(0, 1, At, B1); PG8_BAR;
            PG8_LDA(At, 0, 1); PG8_STAGE(PG8_SA(0, 0), a2, voffA);
            PG8_BAR; PG8_WAIT_L(0); PG8_MMA(1, 0, At, B0); PG8_BAR; PG8_SCHED;
            PG8_STAGE(PG8_SB(0, 1), b2 + hstep, voffB);
            PG8_WAIT_V(6); PG8_BAR; PG8_MMA(1, 1, At, B1); PG8_BAR;
            PG8_LDB(B0, 1, 0); PG8_SCHED; PG8_LDA(At, 1, 0); PG8_STAGE(PG8_SA(0, 1), a2 + hstep, voffA);
            PG8_WAIT_L(8); PG8_BAR; PG8_WAIT_L(0); PG8_MMA(0, 0, At, B0); PG8_BAR; PG8_SCHED;
            PG8_LDB(B1, 1, 1); PG8_STAGE(PG8_SB(1, 0), b3, voffB);
            PG8_BAR; PG8_WAIT_L(0); PG8_MMA(0, 1, At, B1); PG8_BAR;
            PG8_LDA(At, 1, 1); PG8_STAGE(PG8_SA(1, 0), a3, voffA);
            PG8_BAR; PG8_WAIT_L(0); PG8_MMA(1, 0, At, B0); PG8_BAR; PG8_SCHED;
            PG8_STAGE(PG8_SB(1, 1), b3 + hstep, voffB);
            PG8_WAIT_V(6); PG8_BAR; PG8_MMA(1, 1, At, B1); PG8_BAR;
            }
        }
        if constexpr (ALIGN_EPI) { if (wr == 0) PG8_BAR; }
        if constexpr (!Epi::AFTER_DRAIN) { E(acc, cur, wr, wc, fr, fq); S.done(cur); }
        if (!has_next) break;
#pragma unroll
        for (int a = 0; a < 2; ++a)
#pragma unroll
            for (int b = 0; b < 2; ++b)
#pragma unroll
                for (int m = 0; m < 4; ++m)
#pragma unroll
                    for (int n = 0; n < 2; ++n) acc[a][b][m][n] = (f32x4){0.f, 0.f, 0.f, 0.f};
        cur = nxt; cA = nA; cB = nB; ++ui;
        if constexpr (ALIGN_EPI) { if (wr == 1) PG8_BAR; }
    }
    PG8_WAIT_V(0);
    if constexpr (!ALIGN_EPI) { if (wr == 0) PG8_BAR; }
    PG8_BAR;
    if constexpr (Epi::AFTER_DRAIN) { E.fused(acc, cur, wr, wc, fr, fq, lds, wid, lane); S.done(cur); }
#undef PG8_SA
#undef PG8_SB
#undef PG8_STAGE
#undef PG8_LDA
#undef PG8_LDB
#undef PG8_MMA
#undef PG8_WAIT_V
#undef PG8_WAIT_L
#undef PG8_BAR
#undef PG8_SCHED
}
}
#define LAS __attribute__((address_space(3)))
typedef unsigned short bf16;
typedef short bf16x8 __attribute__((ext_vector_type(8)));
typedef short s16x4 __attribute__((ext_vector_type(4)));
typedef float f32x16 __attribute__((ext_vector_type(16)));
typedef float f32x4 __attribute__((ext_vector_type(4)));
typedef unsigned u32x4 __attribute__((ext_vector_type(4)));
typedef unsigned u32x2 __attribute__((ext_vector_type(2)));

constexpr int DM = 1024, BATCH = 16, SEQ = 2048, MTOK = BATCH * SEQ, DEPTH = 2;
constexpr int NIN_SRC = 2308, NQKV = 2304, MIXW = 768, DFF = 2816, NFF2 = 5632;
constexpr float RMS_EPS = 1e-6f, L2E = 1.4426950408889634f, QSCALE = 0.125f * 1.4426950408889634f;
constexpr int C_FQ = 0, C_FK = 256, C_FV = 512, C_DQ = 768, C_DK = 1024, C_DV = 1280, C_CQ = 1536, C_CK = 1792, C_CV = 2048;
constexpr int MX_FOX = 0, MX_DIFF = 256, MX_CHK = 512;
constexpr int NTHREADS = 512, NWAVES = 8;
constexpr size_t MiB = 1u << 20;
constexpr size_t WS_CTL = 0, WS_FF = 1 * MiB, WS_CUM = 1 * MiB + 512 * 1024;
constexpr size_t WS_WIN = 2 * MiB, WS_WOUT = 14 * MiB, WS_WFI = 18 * MiB, WS_WFO = 40 * MiB;
constexpr size_t SZ_WIN = 6 * MiB, SZ_WOUT = 2 * MiB, SZ_WFI = 11 * MiB, SZ_WFO = (size_t)DM * DFF * 2;
constexpr size_t WS_H = 52 * MiB, WS_QKV = 116 * MiB, WS_MIX = 308 * MiB, WS_UV = 116 * MiB, WS_ACT = 292 * MiB, WS_END = 468 * MiB;
static_assert(WS_WFO + 2 * SZ_WFO <= WS_H, "ws map");
constexpr int HALF_M = MTOK / 2;
constexpr int LDS_RING = 131072, LDS_WF = 131072, LDS_MISC = 147456, LDS_TAB = 147456 + 256, LDS_BYTES = 155648;

typedef float f32x2_t __attribute__((ext_vector_type(2))); typedef __bf16 bf16x2_t __attribute__((ext_vector_type(2)));
__device__ __forceinline__ unsigned cvtpk(float lo, float hi) { f32x2_t v = {lo, hi}; bf16x2_t b = __builtin_convertvector(v, bf16x2_t); return __builtin_bit_cast(unsigned, b); }
__device__ __forceinline__ float bf2f(unsigned short v) { return __uint_as_float((unsigned)v << 16); }
__device__ __forceinline__ float wave_sum(float v) {
#pragma unroll
    for (int o = 1; o < 64; o <<= 1) v += __shfl_xor(v, o);
    return v;
}
__device__ __forceinline__ float ex2(float v) { return __builtin_amdgcn_exp2f(v); }

struct Args { const float* in[14]; float* out; unsigned char* ws; };
struct WMeta { bf16* dst; int K; float scale; };
constexpr int W_I_IN = 16 * 72, W_I_OUT = 12 * 32, W_I_FI = 16 * 176, W_I_FO = 44 * 32, W_I_L = W_I_IN + W_I_OUT + W_I_FI + W_I_FO;
__device__ __forceinline__ void witem_load(const Args& a, int it, int lane, float (&wv)[32], WMeta& mt) {
    const int l = it / W_I_L; int r = it % W_I_L;
    const float* W; int K, Nsrc, nblk, mode; bf16* WT;
    if (r < W_I_IN) { W = a.in[2] + (size_t)l * DM * NIN_SRC; K = DM; Nsrc = NIN_SRC; nblk = 72; WT = (bf16*)(a.ws + WS_WIN + l * SZ_WIN); mode = 1; }
    else if ((r -= W_I_IN) < W_I_OUT) { W = a.in[7] + (size_t)l * MIXW * DM; K = MIXW; Nsrc = DM; nblk = 32; WT = (bf16*)(a.ws + WS_WOUT + l * SZ_WOUT); mode = 0; }
    else if ((r -= W_I_OUT) < W_I_FI) { W = a.in[9] + (size_t)l * DM * NFF2; K = DM; Nsrc = NFF2; nblk = 176; WT = (bf16*)(a.ws + WS_WFI + l * SZ_WFI); mode = 2; }
    else { r -= W_I_FI; W = a.in[12] + (size_t)l * DFF * DM; K = DFF; Nsrc = DM; nblk = 32; WT = (bf16*)(a.ws + WS_WFO + l * SZ_WFO); mode = 0; }
    const int kb = r / nblk, nb = r % nblk, k0 = 64 * kb, n0 = 32 * nb;
    int sc0 = n0; float scale = 1.f;
    if (mode == 2) sc0 = (n0 >> 8) * 128 + (n0 & 127) + ((n0 & 128) ? DFF : 0);
    if (mode == 1) { sc0 = n0 + (n0 >= 768 ? 4 : 0);
        if ((n0 >= C_FQ && n0 < C_FK) || (n0 >= C_DQ && n0 < C_DK) || (n0 >= C_CQ && n0 < C_CK)) scale = QSCALE; }
    const float* src = W + (size_t)(k0 + (lane >> 5)) * Nsrc + sc0 + (lane & 31);
#pragma unroll
    for (int i = 0; i < 32; ++i) wv[i] = src[(size_t)(2 * i) * Nsrc];
    mt.dst = WT + (size_t)n0 * K + k0; mt.K = K; mt.scale = scale;
}
__device__ __forceinline__ void witem_store(const WMeta& mt, const float (&wv)[32], LAS float* scr, int lane) {
#pragma unroll
    for (int i = 0; i < 32; ++i) { const int kk = 2 * i + (lane >> 5); scr[kk * 33 + (lane & 31)] = wv[i] * mt.scale; }
    asm volatile("s_waitcnt lgkmcnt(0)" ::: "memory");
    const int c = lane & 7;
#pragma unroll
    for (int j = 0; j < 4; ++j) { const int n = (lane >> 3) + 8 * j; const LAS float* s = scr + (8 * c) * 33 + n;
        u32x4 o; o.x = cvtpk(s[0 * 33], s[1 * 33]); o.y = cvtpk(s[2 * 33], s[3 * 33]); o.z = cvtpk(s[4 * 33], s[5 * 33]); o.w = cvtpk(s[6 * 33], s[7 * 33]);
        *(u32x4*)(mt.dst + (size_t)n * mt.K + 8 * c) = o; }
}
__device__ __forceinline__ void phase_weights(const Args& a, LAS unsigned char* lds, int gw, int NGW, int wave, int lane) {
    LAS float* scr = (LAS float*)(lds + wave * 16896);
    for (int it = gw; it < DEPTH * W_I_L; it += 2 * NGW) {
        float wa[32], wb[32]; WMeta ma, mb; const bool two = it + NGW < DEPTH * W_I_L;
        witem_load(a, it, lane, wa, ma);
        if (two) witem_load(a, it + NGW, lane, wb, mb);
        witem_store(ma, wa, scr, lane);
        if (two) witem_store(mb, wb, scr + 64 * 33, lane);
        asm volatile("s_waitcnt lgkmcnt(0)" ::: "memory");
    }
}

template <int MODE>
__device__ __forceinline__ void phase_norm(const float* x, const float* g, bf16* H, float* outf, const float* w_in_l, const float* b_fox, float* FF,
                                           LAS unsigned char* lds, int gw, int NGW, int tid, int lane) {
    LAS f32x4* wf = (LAS f32x4*)(lds + LDS_WF);
    if (MODE == 1) {
        __syncthreads();
        for (int k = tid; k < DM; k += NTHREADS) wf[k] = *(const f32x4*)(w_in_l + (size_t)k * NIN_SRC + 768);
        __syncthreads();
    }
    f32x4 gv[4];
#pragma unroll
    for (int j = 0; j < 4; ++j) gv[j] = *((const f32x4*)g + lane + 64 * j);
    f32x4 v[4], vn[4];
    if (gw < MTOK) { const f32x4* xr = (const f32x4*)(x + (size_t)gw * DM) + lane;
#pragma unroll
        for (int j = 0; j < 4; ++j) vn[j] = xr[64 * j]; }
    for (int m = gw; m < MTOK; m += NGW) {
        float s = 0.f;
#pragma unroll
        for (int j = 0; j < 4; ++j) v[j] = vn[j];
        if (m + NGW < MTOK) { const f32x4* xr = (const f32x4*)(x + (size_t)(m + NGW) * DM) + lane;
#pragma unroll
            for (int j = 0; j < 4; ++j) vn[j] = xr[64 * j]; }
#pragma unroll
        for (int j = 0; j < 4; ++j) s += (v[j].x * v[j].x + v[j].y * v[j].y) + (v[j].z * v[j].z + v[j].w * v[j].w);
        const float rstd = 1.0f / sqrtf(wave_sum(s) * (1.f / DM) + RMS_EPS);
#pragma unroll
        for (int j = 0; j < 4; ++j) v[j] = v[j] * rstd * gv[j];
        if (MODE == 2) {
            f32x4* o = (f32x4*)(outf + (size_t)m * DM) + lane;
#pragma unroll
            for (int j = 0; j < 4; ++j) o[64 * j] = v[j];
        } else {
            u32x2* o = (u32x2*)(H + (size_t)m * DM) + lane;
#pragma unroll
            for (int j = 0; j < 4; ++j) { u32x2 w; w.x = cvtpk(v[j].x, v[j].y); w.y = cvtpk(v[j].z, v[j].w); o[64 * j] = w; }
        }
        if (MODE == 1) {
            f32x4 d = {0.f, 0.f, 0.f, 0.f};
#pragma unroll
            for (int j = 0; j < 4; ++j) { const int k = 4 * lane + 256 * j;
                d += wf[k] * v[j].x; d += wf[k + 1] * v[j].y; d += wf[k + 2] * v[j].z; d += wf[k + 3] * v[j].w; }
            d.x = wave_sum(d.x); d.y = wave_sum(d.y); d.z = wave_sum(d.z); d.w = wave_sum(d.w);
            if (lane < 4) { float z = (lane == 0 ? d.x : lane == 1 ? d.y : lane == 2 ? d.z : d.w) + b_fox[lane];
                const float ls = fminf(z, 0.f) - log1pf(expf(-fabsf(z)));
                FF[(size_t)m * 4 + lane] = ls; }
        }
    }
}

__device__ __forceinline__ void cumsum_seq(const float* FF, float* CUM, int bh, int lane) {
    const int b = bh >> 2, h = bh & 3;
    const float* src = FF + ((size_t)b * SEQ + 32 * lane) * 4 + h;
    float v[32]; float s = 0.f;
#pragma unroll
    for (int i = 0; i < 32; ++i) { s += src[4 * i]; v[i] = s; }
    float inc = s;
#pragma unroll
    for (int o = 1; o < 64; o <<= 1) { const float t = __shfl_up(inc, o); if (lane >= o) inc += t; }
    const float excl = inc - s;
    float* dst = CUM + (size_t)bh * SEQ + 32 * lane;
#pragma unroll
    for (int i = 0; i < 32; i += 4) { f32x4 w = {v[i] + excl, v[i + 1] + excl, v[i + 2] + excl, v[i + 3] + excl}; *(f32x4*)(dst + i) = w; }
}

__device__ __forceinline__ void unpack8(const u32x4 a, float (&f)[8]) {
#pragma unroll
    for (int i = 0; i < 4; ++i) { f[2 * i] = __uint_as_float(a[i] << 16); f[2 * i + 1] = __uint_as_float(a[i] & 0xffff0000u); } }
__device__ __forceinline__ void phase_fixup(const bf16* HALO, bf16* ACT, const float* cw, const float* cb, int gt, int NGT) {
    constexpr int NCG = DFF / 8, NG = MTOK / 64;
    for (int it = gt; it < NG * 2 * NCG; it += NGT) {
        const int cg8 = it % NCG, rs = it / NCG, s = rs & 1, j = rs >> 1, c0 = cg8 * 8;
        const bool first = ((j * 64) % SEQ) == 0;
        const bf16* hj = HALO + (size_t)j * 4 * NFF2; const bf16* hp = hj - 4 * NFF2;
        const bf16* pt = hj + (size_t)s * NFF2;
        const bf16* p1 = (s == 0) ? hp + 3 * NFF2 : hj;
        const bf16* p2 = (s == 0) ? hp + 2 * NFF2 : hp + 3 * NFF2;
        const u32x4 z = {0u, 0u, 0u, 0u};
        float ut[8], u1[8], u2[8], gt_[8], g1[8], g2[8];
        unpack8(*(const u32x4*)(pt + c0), ut); unpack8(*(const u32x4*)(pt + DFF + c0), gt_);
        unpack8((s == 0 && first) ? z : *(const u32x4*)(p1 + c0), u1); unpack8((s == 0 && first) ? z : *(const u32x4*)(p1 + DFF + c0), g1);
        unpack8(first ? z : *(const u32x4*)(p2 + c0), u2); unpack8(first ? z : *(const u32x4*)(p2 + DFF + c0), g2);
        float o[8];
#pragma unroll
        for (int i = 0; i < 8; ++i) { const int c = c0 + i;
            const float yu = cb[c] + cw[c] * u2[i] + cw[NFF2 + c] * u1[i] + cw[2 * NFF2 + c] * ut[i];
            const float yg = cb[DFF + c] + cw[DFF + c] * g2[i] + cw[NFF2 + DFF + c] * g1[i] + cw[2 * NFF2 + DFF + c] * gt_[i];
            o[i] = yu * yg / (1.f + __expf(-yg)); }
        u32x4 w; w.x = cvtpk(o[0], o[1]); w.y = cvtpk(o[2], o[3]); w.z = cvtpk(o[4], o[5]); w.w = cvtpk(o[6], o[7]);
        *(u32x4*)(ACT + (size_t)(j * 64 + s) * DFF + c0) = w;
    }
}
__device__ __forceinline__ s16x4 vtr(LAS const char* p) { typedef short v4i16_t __attribute__((ext_vector_type(4))); return __builtin_bit_cast(s16x4, __builtin_amdgcn_ds_read_tr16_b64_v4i16((LAS v4i16_t*)p)); }
constexpr int KROWB = 144, KT_BYTES = 64 * KROWB;

__device__ __forceinline__ void qk_tile(f32x16& p0, f32x16& p1, LAS const char* kt, const bf16x8 (&qr)[4], int r32, int hi) {
    LAS const char* kb = kt + r32 * KROWB + hi * 16;
#pragma unroll
    for (int ks = 0; ks < 4; ++ks) {
        const bf16x8 a0 = *(LAS const bf16x8*)(kb + ks * 32), a1 = *(LAS const bf16x8*)(kb + 32 * KROWB + ks * 32);
        p0 = __builtin_amdgcn_mfma_f32_32x32x16_bf16(a0, qr[ks], p0, 0, 0, 0);
        p1 = __builtin_amdgcn_mfma_f32_32x32x16_bf16(a1, qr[ks], p1, 0, 0, 0);
    }
}
template <int NDB>
__device__ __forceinline__ void softmax_pv(f32x16& p0, f32x16& p1, float& m, float& l, f32x16 (&o)[NDB], LAS const char* vt, int vb) {
    float mx = fmaxf(p0[0], p1[0]);
#pragma unroll
    for (int r = 1; r < 16; ++r) mx = fmaxf(mx, fmaxf(p0[r], p1[r]));
    mx = fmaxf(mx, __shfl_xor(mx, 32));
    if (__builtin_amdgcn_ballot_w64(mx > m) != 0ull) {
        const float mn = fmaxf(m, mx);
        const float alpha = ex2(m - mn);
        m = mn; l *= alpha;
#pragma unroll
        for (int db = 0; db < NDB; ++db)
#pragma unroll
            for (int r = 0; r < 16; ++r) o[db][r] *= alpha;
    }
    const float mn = m;
    float rs = 0.f;
#pragma unroll
    for (int r = 0; r < 16; ++r) { p0[r] = ex2(p0[r] - mn); p1[r] = ex2(p1[r] - mn); rs += p0[r] + p1[r]; }
    l += rs;
    bf16x8 pf[4];
    { u32x4 w;
      w.x = cvtpk(p0[0], p0[1]); w.y = cvtpk(p0[2], p0[3]); w.z = cvtpk(p0[4], p0[5]); w.w = cvtpk(p0[6], p0[7]); pf[0] = __builtin_bit_cast(bf16x8, w);
      w.x = cvtpk(p0[8], p0[9]); w.y = cvtpk(p0[10], p0[11]); w.z = cvtpk(p0[12], p0[13]); w.w = cvtpk(p0[14], p0[15]); pf[1] = __builtin_bit_cast(bf16x8, w);
      w.x = cvtpk(p1[0], p1[1]); w.y = cvtpk(p1[2], p1[3]); w.z = cvtpk(p1[4], p1[5]); w.w = cvtpk(p1[6], p1[7]); pf[2] = __builtin_bit_cast(bf16x8, w);
      w.x = cvtpk(p1[8], p1[9]); w.y = cvtpk(p1[10], p1[11]); w.z = cvtpk(p1[12], p1[13]); w.w = cvtpk(p1[14], p1[15]); pf[3] = __builtin_bit_cast(bf16x8, w); }
#pragma unroll
    for (int kk = 0; kk < 4; ++kk)
#pragma unroll
        for (int db = 0; db < NDB; ++db) {
            const s16x4 lo = vtr(vt + vb + db * 4096 + kk * 1024), hh = vtr(vt + vb + db * 4096 + kk * 1024 + 512);
            const bf16x8 vf = {lo[0], lo[1], lo[2], lo[3], hh[0], hh[1], hh[2], hh[3]};
            o[db] = __builtin_amdgcn_mfma_f32_32x32x16_bf16(vf, pf[kk], o[db], 0, 0, 0);
        }
}

template <int MODE>
__device__ __forceinline__ void attn_unit64(const bf16* qkv, bf16* mix, const float* cum_bh, int b, int h, int blk, LAS unsigned char* lds, int tid, int wave, int lane) {
    constexpr int CUMOFF = KT_BYTES + 8192, BUFSZ = CUMOFF + 256;
    const int r32 = lane & 31, hi = lane >> 5;
    const size_t rowbase = (size_t)b * SEQ;
    const int Q0 = blk * 256, qw0 = Q0 + 32 * wave;
    const int CQ = (MODE == 0 ? C_FQ : C_CQ) + h * 64, CK = (MODE == 0 ? C_FK : C_CK) + h * 64, CV = (MODE == 0 ? C_FV : C_CV) + h * 64;
    const int c0 = 4 * blk, cw = c0 + (wave >> 1);
    int tbeg, tend, kvoff;
    if (MODE == 0) { tbeg = 0; tend = 4 * (blk + 1); kvoff = 0; }
    else { tbeg = (c0 >= 8) ? 0 : 8 - c0; tend = 12; kvoff = (c0 - 8) * 64; }
    const int srow = tid >> 3, sch = tid & 7;
    const bf16* kg = qkv + (rowbase + kvoff + srow) * NQKV + CK + sch * 8;
    const bf16* vg = qkv + (rowbase + kvoff + srow) * NQKV + CV + sch * 8;
    const int kdst = srow * KROWB + sch * 16, vdst = KT_BYTES + (sch >> 2) * 4096 + srow * 64 + (sch & 3) * 16;
    const float cref = (MODE == 0) ? cum_bh[Q0] : 0.f;
#define U64_LOAD(K, V, C, tt) do { if ((tt) >= tbeg) { K = *(const u32x4*)(kg + (size_t)(tt) * 64 * NQKV); V = *(const u32x4*)(vg + (size_t)(tt) * 64 * NQKV); \
        if (MODE == 0 && tid < 16) C = *(const f32x4*)(cum_bh + (tt) * 64 + 4 * tid); } } while (0)
#define U64_STAGE(K, V, C, buf) do { *(LAS u32x4*)((buf) + kdst) = K; *(LAS u32x4*)((buf) + vdst) = V; if (MODE == 0 && tid < 16) *(LAS f32x4*)((buf) + CUMOFF + tid * 16) = (cref - C) * L2E; } while (0)
#define LDS_BAR() asm volatile("s_waitcnt lgkmcnt(0)\n\ts_barrier" ::: "memory")
    u32x4 kA = {0u, 0u, 0u, 0u}, vA = kA, kB = kA, vB = kA; f32x4 cA = {0.f, 0.f, 0.f, 0.f}, cB = cA;
    U64_LOAD(kA, vA, cA, tend - 1); U64_LOAD(kB, vB, cB, tend - 2);
    bf16x8 qr[4];
#pragma unroll
    for (int ks = 0; ks < 4; ++ks) qr[ks] = *(const bf16x8*)(qkv + (rowbase + qw0 + r32) * NQKV + CQ + ks * 16 + hi * 8);
    float m = -1e30f, l = 0.f;
    f32x16 o[2];
#pragma unroll
    for (int db = 0; db < 2; ++db)
#pragma unroll
        for (int r = 0; r < 16; ++r) o[db][r] = 0.f;
    const int vb = (4 * hi + ((lane & 15) >> 2)) * 64 + ((lane >> 4) & 1) * 32 + (lane & 3) * 8;
    LAS const float* tab = (LAS const float*)(lds + LDS_TAB) + h * 192;
    auto compute = [&](const int t, LAS unsigned char* const buf) __attribute__((always_inline)) {
        const int kv0 = kvoff + 64 * t;
        bool doit;
        if (MODE == 0) doit = kv0 <= qw0 + 31; else { const int kc = c0 - 8 + t; doit = (kc >= cw - 8) && (kc <= cw); }
        if (doit) {
            f32x16 p0 = (f32x16){0.f, 0.f, 0.f, 0.f, 0.f, 0.f, 0.f, 0.f, 0.f, 0.f, 0.f, 0.f, 0.f, 0.f, 0.f, 0.f}, p1 = p0;
            if (MODE == 2 && cw - (c0 - 8 + t) >= 3) { const float bv = tab[191];
#pragma unroll
                for (int r = 0; r < 16; ++r) { p0[r] = bv; p1[r] = bv; } }
            if (MODE == 0) {
#pragma unroll
                for (int g = 0; g < 4; ++g) { const f32x4 ca = *(LAS const f32x4*)(buf + CUMOFF + (8 * g + 4 * hi) * 4), cb = *(LAS const f32x4*)(buf + CUMOFF + (32 + 8 * g + 4 * hi) * 4);
#pragma unroll
                    for (int i = 0; i < 4; ++i) { p0[4 * g + i] = ca[i]; p1[4 * g + i] = cb[i]; } }
            }
            qk_tile(p0, p1, (LAS const char*)buf, qr, r32, hi);
            if (MODE == 0) {
                if (kv0 + 63 > qw0) {
                    const int qa = qw0 + r32 - kv0 - 4 * hi;
#pragma unroll
                    for (int r = 0; r < 16; ++r) { const int kl = (r & 3) + 8 * (r >> 2); if (kl > qa) p0[r] = -INFINITY; if (kl + 32 > qa) p1[r] = -INFINITY; }
                }
            } else {
                const int dc = cw - (c0 - 8 + t);
                if (dc < 3) {
                    const int rel0 = qw0 + r32 - kv0 - 4 * hi + 63;
#pragma unroll
                    for (int r = 0; r < 16; ++r) { const int kl = (r & 3) + 8 * (r >> 2);
                        int i0 = rel0 - kl, i1 = rel0 - kl - 32; i0 = i0 < 0 ? 0 : (i0 > 191 ? 191 : i0); i1 = i1 < 0 ? 0 : (i1 > 191 ? 191 : i1);
                        p0[r] += tab[i0]; p1[r] += tab[i1]; }
                }
            }
            softmax_pv<2>(p0, p1, m, l, o, (LAS const char*)buf + KT_BYTES, vb);
        }
    };
    int pi = 0;
    for (int t = tend - 1; t >= tbeg; t -= 2, pi ^= 1) {
        LAS unsigned char* const sb = lds + (pi ? 2 * BUFSZ : 0); const bool two = (t - 1 >= tbeg);
        U64_STAGE(kA, vA, cA, sb); if (two) U64_STAGE(kB, vB, cB, sb + BUFSZ);
        LDS_BAR();
        U64_LOAD(kA, vA, cA, t - 2); U64_LOAD(kB, vB, cB, t - 3);
        compute(t, sb); if (two) compute(t - 1, sb + BUFSZ);
    }
#undef U64_LOAD
#undef U64_STAGE
    l += __shfl_xor(l, 32);
    const float inv = 1.0f / l;
    bf16* orow = mix + (rowbase + qw0 + r32) * MIXW + (MODE == 0 ? MX_FOX : MX_CHK) + h * 64 + 4 * hi;
#pragma unroll
    for (int db = 0; db < 2; ++db)
#pragma unroll
        for (int g = 0; g < 4; ++g) { u32x2 w; w.x = cvtpk(o[db][4 * g] * inv, o[db][4 * g + 1] * inv); w.y = cvtpk(o[db][4 * g + 2] * inv, o[db][4 * g + 3] * inv);
            *(u32x2*)(orow + 32 * db + 8 * g) = w; }
    __syncthreads();
}

template <int C>
__device__ __forceinline__ void diff_pass(const bf16* qkv, bf16* mix, float* park, int b, int h, int blk, float lam, float sl2, const float* gdiff, float outscale,
                                          LAS unsigned char* lds, int tid, int wave, int lane) {
    constexpr int VOFF = KT_BYTES, BUFSZ = VOFF + 16384;
    const int r32 = lane & 31, hi = lane >> 5;
    const size_t rowbase = (size_t)b * SEQ;
    const int Q0 = blk * 256, qw0 = Q0 + 32 * wave, cwv = qw0 >> 6, tend = 4 * (blk + 1);
    const int srow = tid >> 3, sch = tid & 7;
    const int vrow0 = tid >> 4, vch = tid & 15;
    const bf16* vg = qkv + (rowbase + vrow0) * NQKV + C_DV + h * 128 + vch * 8;
    const int kdst = srow * KROWB + sch * 16, vdst = VOFF + (vch >> 2) * 4096 + vrow0 * 64 + (vch & 3) * 16;
    const int vb = (4 * hi + ((lane & 15) >> 2)) * 64 + ((lane >> 4) & 1) * 32 + (lane & 3) * 8;
    const bf16* kg = qkv + (rowbase + srow) * NQKV + C_DK + h * 128 + C * 64 + sch * 8;
#define DF_LOAD(K, V0, V1, tt) do { if ((tt) >= 0) { const size_t go_ = (size_t)(tt) * 64 * NQKV; K = *(const u32x4*)(kg + go_); V0 = *(const u32x4*)(vg + go_); V1 = *(const u32x4*)(vg + go_ + (size_t)32 * NQKV); } } while (0)
#define DF_STAGE(K, V0, V1, buf) do { *(LAS u32x4*)((buf) + kdst) = K; *(LAS u32x4*)((buf) + vdst) = V0; *(LAS u32x4*)((buf) + vdst + 32 * 64) = V1; } while (0)
    u32x4 kA = {0u, 0u, 0u, 0u}, v0A = kA, v1A = kA, kB = kA, v0B = kA, v1B = kA;
    DF_LOAD(kA, v0A, v1A, tend - 1); DF_LOAD(kB, v0B, v1B, tend - 2);
    bf16x8 qr[4];
#pragma unroll
    for (int ks = 0; ks < 4; ++ks) qr[ks] = *(const bf16x8*)(qkv + (rowbase + qw0 + r32) * NQKV + C_DQ + h * 128 + C * 64 + ks * 16 + hi * 8);
    float m = -1e30f, l = 0.f;
    f32x16 o[4];
#pragma unroll
    for (int db = 0; db < 4; ++db)
#pragma unroll
        for (int r = 0; r < 16; ++r) o[db][r] = 0.f;
    f32x16 ab;
#pragma unroll
    for (int r = 0; r < 16; ++r) ab[r] = sl2 * (float)((r & 3) + 8 * (r >> 2) + 4 * hi);
    auto compute = [&](const int t, LAS unsigned char* const buf) __attribute__((always_inline)) {
        if (t <= cwv) {
            const int kv0 = 64 * t;
            f32x16 p0, p1;
            if (t < cwv) { const float d0 = sl2 * (float)(64 * (t - cwv)), d1 = d0 + 32.f * sl2;
#pragma unroll
                for (int r = 0; r < 16; ++r) { p0[r] = ab[r] + d0; p1[r] = ab[r] + d1; }
                qk_tile(p0, p1, (LAS const char*)buf, qr, r32, hi);
            } else { p0 = (f32x16){0.f, 0.f, 0.f, 0.f, 0.f, 0.f, 0.f, 0.f, 0.f, 0.f, 0.f, 0.f, 0.f, 0.f, 0.f, 0.f}; p1 = p0;
                qk_tile(p0, p1, (LAS const char*)buf, qr, r32, hi);
                const float ql = (float)(qw0 + r32 - kv0), base = ql - (float)(4 * hi);
#pragma unroll
                for (int r = 0; r < 16; ++r) { const float kl = (float)((r & 3) + 8 * (r >> 2)); p0[r] += sl2 * (ql - fabsf(base - kl)); p1[r] += sl2 * (ql - fabsf(base - kl - 32.f)); }
            }
            softmax_pv<4>(p0, p1, m, l, o, (LAS const char*)buf + VOFF, vb);
        }
    };
    int pi = 0;
    for (int t = tend - 1; t >= 0; t -= 2, pi ^= 1) {
        LAS unsigned char* const sb = lds + (pi ? 2 * BUFSZ : 0);
        DF_STAGE(kA, v0A, v1A, sb); DF_STAGE(kB, v0B, v1B, sb + BUFSZ);
        LDS_BAR();
        DF_LOAD(kA, v0A, v1A, t - 2); DF_LOAD(kB, v0B, v1B, t - 3);
        compute(t, sb); compute(t - 1, sb + BUFSZ);
    }
#undef DF_LOAD
#undef DF_STAGE
    l += __shfl_xor(l, 32);
    const float inv = 1.0f / l;
    if (C == 0) {
#pragma unroll
        for (int db = 0; db < 4; ++db)
#pragma unroll
            for (int r = 0; r < 16; ++r) park[(db * 16 + r) * NTHREADS] = o[db][r] * inv;
    } else {
        const float li = lam * inv;
        float ss = 0.f;
#pragma unroll
        for (int db = 0; db < 4; ++db) {
#pragma unroll
            for (int r = 0; r < 16; ++r) { const float v = park[(db * 16 + r) * NTHREADS] - o[db][r] * li; o[db][r] = v; ss += v * v; }
            asm volatile("" ::: "memory"); }
        ss += __shfl_xor(ss, 32);
        const float rn = outscale / sqrtf(ss * (1.f / 128.f) + RMS_EPS);
        bf16* orow = mix + (rowbase + qw0 + r32) * MIXW + MX_DIFF + h * 128 + 4 * hi;
#pragma unroll
        for (int db = 0; db < 4; ++db)
#pragma unroll
            for (int g = 0; g < 4; ++g) { const f32x4 gg = *(const f32x4*)(gdiff + 32 * db + 8 * g + 4 * hi);
                u32x2 w; w.x = cvtpk(o[db][4 * g] * rn * gg.x, o[db][4 * g + 1] * rn * gg.y); w.y = cvtpk(o[db][4 * g + 2] * rn * gg.z, o[db][4 * g + 3] * rn * gg.w);
                *(u32x2*)(orow + 32 * db + 8 * g) = w; }
    }
    __syncthreads();
}
__device__ __forceinline__ void attn_unit_diff2(const bf16* qkv, bf16* mix, int b, int h, int blk, float lam, float sl2, const float* gdiff, float outscale,
                                                LAS unsigned char* lds, int tid, int wave, int lane) {
    float* park = (float*)((unsigned char*)qkv - WS_QKV + WS_H) + (size_t)blockIdx.x * 64 * NTHREADS + tid;
    diff_pass<0>(qkv, mix, park, b, h, blk, lam, sl2, gdiff, outscale, lds, tid, wave, lane);
    int tid2 = threadIdx.x; asm volatile("" : "+v"(tid2) :: "memory"); __builtin_amdgcn_sched_barrier(0);
    float* park2 = (float*)((unsigned char*)qkv - WS_QKV + WS_H) + (size_t)blockIdx.x * 64 * NTHREADS + tid2;
    diff_pass<1>(qkv, mix, park2, b, h, blk, lam, sl2, gdiff, outscale, lds, tid2, __builtin_amdgcn_readfirstlane(tid2 >> 6), tid2 & 63);
}
#define SF(q) (0 << 5 | (q) << 1 | 0), (0 << 5 | (q) << 1 | 1)
#define SD(q) (1 << 5 | (q) << 1 | 0)
#define SC(q) (2 << 5 | (q) << 1 | 0), (2 << 5 | (q) << 1 | 1)
__device__ __forceinline__ int seg_code(int s) {
    constexpr unsigned char T[40] = { SD(7), SD(6), SD(5), SD(4), SD(3), SF(7), SD(2), SF(6), SF(5), SD(1), SF(4), SF(3), SD(0), SF(2),
        SC(7), SC(6), SC(5), SC(4), SC(3), SC(2), SC(1), SC(0), SF(1), SF(0) };
    return T[s];
}
__device__ __forceinline__ void phase_attn(const Args& a, int layer, unsigned* ctr, LAS unsigned char* lds, int tid0, int wave0, int lane0) {
    const bf16* qkv = (const bf16*)(a.ws + WS_QKV); bf16* mix = (bf16*)(a.ws + WS_MIX); const float* CUM = (const float*)(a.ws + WS_CUM);
    for (int i = tid0; i < 4 * 192; i += NTHREADS) ((LAS float*)(lds + LDS_TAB))[i] = a.in[6][(size_t)layer * 768 + i] * L2E;
    const float* dl = a.in[4] + (size_t)layer * 256;
    const float s01 = wave_sum(dl[lane0] * dl[64 + lane0]), s23 = wave_sum(dl[128 + lane0] * dl[192 + lane0]);
    const float lambda_init = 0.8f - 0.6f * expf(-0.3f * (float)layer);
    const float lam = expf(s01) - expf(s23) + lambda_init;
    const float* gdiff = a.in[5] + (size_t)layer * 128;
    LAS volatile unsigned* misc = (LAS volatile unsigned*)(lds + LDS_MISC);
    __syncthreads();
    for (;;) {
        if (threadIdx.x == 0) misc[0] = atomicAdd(ctr, 1u);
        __syncthreads();
        const unsigned idx = misc[0];
        int tidf = threadIdx.x; asm volatile("" : "+v"(tidf) :: "memory"); __builtin_amdgcn_sched_barrier(0);
        const int tid = tidf, lane = tidf & 63, wave = __builtin_amdgcn_readfirstlane(tidf >> 6);
        if (idx >= 1280u) break;
        const int code = seg_code((int)(idx >> 5)), kind = code >> 5, blk = (code >> 1) & 15, sub = (int)(idx & 31);
        if (kind == 1) { const int b = sub >> 1, h = sub & 1;
            attn_unit_diff2(qkv, mix, b, h, blk, lam, exp2f(-4.0f * (float)(h + 1)) * L2E, gdiff, 1.0f - lambda_init, lds, tid, wave, lane); }
        else { const int bh = (code & 1) * 32 + sub, b = bh >> 2, h = bh & 3;
            if (kind == 0) attn_unit64<0>(qkv, mix, CUM + (size_t)bh * SEQ, b, h, blk, lds, tid, wave, lane);
            else attn_unit64<2>(qkv, mix, nullptr, b, h, blk, lds, tid, wave, lane); }
    }
}
#define XB_TMO      128
#define XB_XCNT(j)  (256  + 64 * (j))
#define XB_XSUB(j)  (1280 + 64 * (j))
#define XB_XGEN(j)  (2304 + 64 * (j))
#define XB_TOP      3328
#define XB_TOPGEN   3392
#define XCD_BAR_WORDS 3456
#define XB_SPIN_CAP (1u << 18)

__device__ __forceinline__ unsigned xb_ld(unsigned* p)              { return __hip_atomic_load(p, __ATOMIC_RELAXED, __HIP_MEMORY_SCOPE_AGENT); }
__device__ __forceinline__ unsigned xb_add(unsigned* p, unsigned v) { return __hip_atomic_fetch_add(p, v, __ATOMIC_RELAXED, __HIP_MEMORY_SCOPE_AGENT); }
__device__ __forceinline__ unsigned xb_xcc_id() { return (unsigned)__builtin_amdgcn_s_getreg((3 << 11) | 20) & 0xFu; }
#define XB_SPIN(cond, bar) do { unsigned _sp = 0; while (cond) { __builtin_amdgcn_s_sleep(1); \
    if ((++_sp & 255u) == 0u) { if (xb_ld(&(bar)[XB_TMO])) break; if (_sp > XB_SPIN_CAP) { atomicAdd(&(bar)[XB_TMO], 1u); break; } } } } while (0)

struct XcdBarrier {
    unsigned* bar; unsigned x;
    volatile LAS unsigned* st;
};

__device__ __forceinline__ XcdBarrier xcd_barrier_post(unsigned* bar, volatile LAS unsigned* st) {
    XcdBarrier b; b.bar = bar; b.x = xb_xcc_id(); b.st = st;
    if (threadIdx.x == 0) (void)xb_add(&bar[XB_XCNT(b.x)], 1u);
    return b;
}
__device__ __forceinline__ void xcd_barrier_complete(unsigned* bar, unsigned x, unsigned& nloc, unsigned& nx) {
    const unsigned G = gridDim.x * gridDim.y * gridDim.z;
    unsigned sum, cnt, mine, sp = 0u;
    for (;;) {
        sum = 0u; cnt = 0u; mine = 0u;
#pragma unroll
        for (unsigned j = 0; j < 16; ++j) { const unsigned c = xb_ld(&bar[XB_XCNT(j)]); sum += c; cnt += (c > 0u) ? 1u : 0u; mine = (j == x) ? c : mine; }
        if (sum == G) break;
        __builtin_amdgcn_s_sleep(1);
        if ((++sp & 255u) == 0u) { if (xb_ld(&bar[XB_TMO])) break; if (sp > XB_SPIN_CAP) { atomicAdd(&bar[XB_TMO], 1u); break; } }
    }
    nloc = mine > 0u ? mine : 1u; nx = cnt > 0u ? cnt : 1u;
}

__device__ __forceinline__ void xcd_barrier(const XcdBarrier& b) {
    asm volatile("s_waitcnt vmcnt(0)" ::: "memory");
    __syncthreads();
    if (threadIdx.x == 0) {
        unsigned* bar = b.bar;
        __builtin_amdgcn_s_waitcnt(0);
        unsigned nloc = b.st[0], nx = b.st[1];
        if (nloc == 0u) { xcd_barrier_complete(bar, b.x, nloc, nx); b.st[0] = nloc; b.st[1] = nx; }
        const unsigned old = xb_add(&bar[XB_XSUB(b.x)], 1u);
        const unsigned gen = old / nloc;
        if (old + 1u == (gen + 1u) * nloc) {
            __builtin_amdgcn_fence(__ATOMIC_RELEASE, "agent");
            asm volatile("s_waitcnt vmcnt(0)" ::: "memory");
            const unsigned og = xb_add(&bar[XB_TOP], 1u);
            const unsigned tg = og / nx;
            if (og + 1u == (tg + 1u) * nx) xb_add(&bar[XB_TOPGEN], 1u);
            else XB_SPIN(xb_ld(&bar[XB_TOPGEN]) == tg, bar);
            __builtin_amdgcn_fence(__ATOMIC_ACQUIRE, "agent");
            xb_add(&bar[XB_XGEN(b.x)], 1u);
            asm volatile("s_waitcnt vmcnt(0)" ::: "memory");
        } else {
            XB_SPIN(xb_ld(&bar[XB_XGEN(b.x)]) == gen, bar);
            __builtin_amdgcn_fence(__ATOMIC_ACQUIRE, "agent");
            asm volatile("s_waitcnt vmcnt(0)" ::: "memory");
        }
    }
    __syncthreads();
}

#define GEMM_RUN(EPI, Aptr, Bptr, Mv, Nv, Kv, Eobj) GEMM_RUN2(EPI, Aptr, Bptr, Mv, Nv, Kv, Eobj, true, true)
#define GEMM_RUN2(EPI, Aptr, Bptr, Mv, Nv, Kv, Eobj, ALIGNV, SP2V) do { pg8::Gemm g_{(const pg8::bf16_t*)(Aptr), (const pg8::bf16_t*)(Bptr), (Mv), (Nv), (Kv)}; pg8::StaticOrder S_; S_.init((Mv), (Nv), (int)gridDim.x, (int)blockIdx.x); \
    pg8::gemm_phase<EPI, pg8::StaticOrder, ALIGNV, SP2V>(lds, g_, S_, Eobj); } while (0)

__global__ void __launch_bounds__(NTHREADS, 2) mk_fwd(Args a) {
    __shared__ __attribute__((aligned(16))) unsigned char lds_raw[LDS_BYTES];
    LAS unsigned char* lds = (LAS unsigned char*)lds_raw;
    cg::grid_group grid = cg::this_grid();
#define FRESH int tid = threadIdx.x; asm volatile("" : "+v"(tid)); const int lane = tid & 63, wave = __builtin_amdgcn_readfirstlane(tid >> 6); const int G = gridDim.x, gw = blockIdx.x * NWAVES + wave, NGW = G * NWAVES; (void)lane; (void)gw; (void)NGW; (void)G
    unsigned* ctl = (unsigned*)(a.ws + WS_CTL);
    unsigned* barw = ctl + 4096;
    volatile LAS unsigned* bst = (volatile LAS unsigned*)(lds + LDS_MISC + 64);
    if (threadIdx.x < 2) bst[threadIdx.x] = 0u;
    __syncthreads();
    if (a.out == nullptr) grid.sync();
    const XcdBarrier xbar = xcd_barrier_post(barw, bst);
#define GSYNC() xcd_barrier(xbar)
    bf16* H = (bf16*)(a.ws + WS_H); bf16* QKV = (bf16*)(a.ws + WS_QKV); bf16* MIX = (bf16*)(a.ws + WS_MIX); bf16* UV = (bf16*)(a.ws + WS_UV); bf16* ACT = (bf16*)(a.ws + WS_ACT);
    float* FF = (float*)(a.ws + WS_FF); float* CUM = (float*)(a.ws + WS_CUM);
    { FRESH; phase_weights(a, lds, gw, NGW, wave, lane); }
    for (int l = 0; l < DEPTH; ++l) {
        const float* xin = (l == 0) ? a.in[0] : (const float*)a.out;
        { FRESH; phase_norm<1>(xin, a.in[1] + (size_t)l * DM, H, nullptr, a.in[2] + (size_t)l * DM * NIN_SRC, a.in[3] + l * 4, FF, lds, gw, NGW, tid, lane); }
        GSYNC();
        { FRESH; if (blockIdx.x < 64 && wave == 0) cumsum_seq(FF, CUM, blockIdx.x, lane); }
        { pg8::EpiBf16 E{(pg8::bf16_t*)QKV, NQKV}; GEMM_RUN(pg8::EpiBf16, H, a.ws + WS_WIN + l * SZ_WIN, MTOK, NQKV, DM, E); }
        GSYNC();
        { FRESH; phase_attn(a, l, ctl + 64 * l, lds, tid, wave, lane); }
        GSYNC();
        { pg8::EpiRes E{xin, a.out, DM, 1.0f}; GEMM_RUN(pg8::EpiRes, MIX, a.ws + WS_WOUT + l * SZ_WOUT, MTOK, DM, MIXW, E); }
        GSYNC();
        { FRESH; phase_norm<0>(a.out, a.in[8] + (size_t)l * DM, H, nullptr, nullptr, nullptr, nullptr, lds, gw, NGW, tid, lane); }
        GSYNC();
        { pg8::EpiConv E{(pg8::bf16_t*)ACT, (pg8::bf16_t*)UV, a.in[10] + (size_t)l * 3 * NFF2, a.in[11] + (size_t)l * NFF2}; GEMM_RUN(pg8::EpiConv, H, a.ws + WS_WFI + l * SZ_WFI, MTOK, NFF2, DM, E); }
        GSYNC();
        { FRESH; phase_fixup(UV, ACT, a.in[10] + (size_t)l * 3 * NFF2, a.in[11] + (size_t)l * NFF2, blockIdx.x * NTHREADS + tid, G * NTHREADS); }
        GSYNC();
        { pg8::EpiRes E{a.out, a.out, DM, 1.0f}; GEMM_RUN(pg8::EpiRes, ACT, a.ws + WS_WFO + l * SZ_WFO, MTOK, DM, DFF, E); }
        GSYNC();
    }
    { FRESH; phase_norm<2>(a.out, a.in[13], nullptr, a.out, nullptr, nullptr, nullptr, lds, gw, NGW, tid, lane); }
}

extern "C" void kernel_launch(void* const* d_in, const int* in_sizes, int n_in, void* d_out, int out_size, void* d_ws, size_t ws_size, hipStream_t stream) {
    static int grid_blocks = 0;
    if (grid_blocks == 0) {
        if (n_in != 14 || out_size != MTOK * DM || ws_size < WS_END || in_sizes[2] != DEPTH * DM * NIN_SRC || in_sizes[7] != DEPTH * MIXW * DM || in_sizes[9] != DEPTH * DM * NFF2 || in_sizes[12] != DEPTH * DFF * DM || in_sizes[6] != DEPTH * 4 * 192 || in_sizes[5] != DEPTH * 128) { fprintf(stderr, "kernel_launch: unexpected sizes n_in %d out %d ws %zu\n", n_in, out_size, ws_size); grid_blocks = -1; return; }
        int dev = 0, cus = 0, per_cu = 0;
        (void)hipGetDevice(&dev);
        (void)hipDeviceGetAttribute(&cus, hipDeviceAttributeMultiprocessorCount, dev);
        (void)hipOccupancyMaxActiveBlocksPerMultiprocessor(&per_cu, (const void*)mk_fwd, NTHREADS, 0);
        if (per_cu < 1) { fprintf(stderr, "kernel_launch: occupancy query says %d blocks/CU\n", per_cu); per_cu = 1; }
        (void)hipGetLastError();
        grid_blocks = cus * 1;
        fprintf(stderr, "kernel_launch: cus %d per_cu %d grid %d\n", cus, per_cu, grid_blocks);
    }
    if (grid_blocks < 0) return;
    if (hipMemsetAsync((char*)d_ws + WS_CTL, 0, 65536, stream) != hipSuccess) { fprintf(stderr, "kernel_launch: memset of control words failed\n"); return; }
    Args a{};
    for (int i = 0; i < 14; ++i) a.in[i] = (const float*)d_in[i];
    a.out = (float*)d_out; a.ws = (unsigned char*)d_ws;
    void* args[] = {&a};
    hipError_t e = hipLaunchCooperativeKernel((const void*)mk_fwd, dim3(grid_blocks), dim3(NTHREADS), args, 0, stream);
    if (e != hipSuccess) fprintf(stderr, "cooperative launch failed: %s (grid %d)\n", hipGetErrorString(e), grid_blocks);
}
```

```cpp
#include <hip/hip_runtime.h>
#include <cstdio>
#include <cstdint>
#include <hip/hip_cooperative_groups.h>
namespace cg = cooperative_groups;
namespace pg8 {
#define PG8_LAS __attribute__((address_space(3)))
typedef unsigned short bf16_t;
typedef short bf16x8 __attribute__((ext_vector_type(8)));
typedef float f32x4 __attribute__((ext_vector_type(4)));
typedef unsigned u32x4 __attribute__((ext_vector_type(4)));
constexpr int BM = 256, BK = 64, HALF = 128, HTB = HALF * BK * 2  , STAGE_BYTES = 8 * HTB, NXCD = 8, WGM = 8;

__host__ __device__ __forceinline__ int lds_byte(int r, int c) { const int st = (r >> 4) * 2 + (c >> 5), rr = r & 15, cc = c & 31, ob = rr * 64 + cc * 2; return st * 1024 + (ob ^ (((ob >> 9) & 1) << 5)); }
__host__ __device__ __forceinline__ void stage_rc(int b, int& R, int& C) { const int st = b / 1024, sb = b % 1024, swz = sb ^ (((sb >> 9) & 1) << 5); R = (st >> 1) * 16 + swz / 64; C = (st & 1) * 32 + (swz % 64) / 2; }
__host__ __device__ __forceinline__ int perm32(int rho) { const int n = rho >> 4, i = rho & 15; return 8 * (i >> 2) + 4 * n + (i & 3); }

struct Unit { int pm, pn; };
struct Gemm { const bf16_t* A; const bf16_t* Bt; int M, N, K; };

struct StaticOrder {
    int nM, nN, nwg, G, c;
    __host__ __device__ void init(int M, int N, int G_, int c_) { nM = M / BM; nN = N / BM; nwg = nM * nN; G = G_; c = c_; }
    __host__ __device__ bool next(int i, Unit& u) const {
        const long L = (long)i * G + c; if (L >= nwg) return false;
        int wgid = (int)L; { const int q = nwg / NXCD, r = nwg % NXCD, xcd = wgid % NXCD, off = wgid / NXCD; wgid = (xcd < r ? xcd * (q + 1) : r * (q + 1) + (xcd - r) * q) + off; }
        const int nig = WGM * nN, gid = wgid / nig, fm = gid * WGM, gsz = (nM - fm) < WGM ? (nM - fm) : WGM;
        u.pm = fm + ((wgid % nig) % gsz); u.pn = (wgid % nig) / gsz; return true;
    }
    __device__ __forceinline__ void a_ready(const Unit&) const {}
    __device__ __forceinline__ void done(const Unit&) const {}
};

typedef float f32x2c __attribute__((ext_vector_type(2))); typedef __bf16 bf16x2c __attribute__((ext_vector_type(2)));
__device__ __forceinline__ unsigned cvt_pk_bf16(float lo, float hi) { f32x2c v = {lo, hi}; bf16x2c b = __builtin_convertvector(v, bf16x2c); return __builtin_bit_cast(unsigned, b); }
typedef float f32x2 __attribute__((ext_vector_type(2)));
struct EpiBf16 {
    static constexpr bool PERM = true, AFTER_DRAIN = false, APERM = false;
    bf16_t* O; int ldc;
    __device__ __forceinline__ void operator()(const f32x4 (&acc)[2][2][4][2], const Unit& u, int wr, int wc, int fr, int fq) const {
        const int row0 = u.pm * BM + wr * 64 + fr; const int col0 = u.pn * BM + wc * 32 + 8 * fq;
#pragma unroll
        for (int ai = 0; ai < 2; ++ai)
#pragma unroll
            for (int m = 0; m < 4; ++m) { bf16_t* rowp = O + (size_t)(row0 + ai * HALF + m * 16) * ldc + col0;
#pragma unroll
                for (int bj = 0; bj < 2; ++bj) { const f32x4 v0 = acc[ai][bj][m][0], v1 = acc[ai][bj][m][1];
                    u32x4 w; w.x = cvt_pk_bf16(v0[0], v0[1]); w.y = cvt_pk_bf16(v0[2], v0[3]); w.z = cvt_pk_bf16(v1[0], v1[1]); w.w = cvt_pk_bf16(v1[2], v1[3]);
                    *(u32x4*)(rowp + bj * HALF) = w; } }
    }
};
struct EpiRes {
    static constexpr bool PERM = false, AFTER_DRAIN = false, APERM = false;
    const float* base; float* out; int ldc; float scale;
    __device__ __forceinline__ void operator()(const f32x4 (&acc)[2][2][4][2], const Unit& u, int wr, int wc, int fr, int fq) const {
        const int col0 = u.pn * BM + wc * 32 + 4 * fq;
#pragma unroll
        for (int ai = 0; ai < 2; ++ai)
#pragma unroll
            for (int m = 0; m < 4; ++m) { const size_t off = (size_t)(u.pm * BM + ai * HALF + wr * 64 + m * 16 + fr) * ldc + col0;
#pragma unroll
                for (int bj = 0; bj < 2; ++bj)
#pragma unroll
                    for (int n = 0; n < 2; ++n) { const f32x4 bs = *(const f32x4*)(base + off + bj * HALF + n * 16); *(f32x4*)(out + off + bj * HALF + n * 16) = bs + acc[ai][bj][m][n] * scale; } }
    }
};

__device__ __forceinline__ f32x4 dpp_shr1(f32x4 v) { f32x4 r;
#pragma unroll
    for (int i = 0; i < 4; ++i) r[i] = __shfl_up(v[i], 1, 16);
    return r; }
__device__ __forceinline__ f32x4 silu_mul(f32x4 yu, f32x4 yg) { f32x4 o;
#pragma unroll
    for (int i = 0; i < 4; ++i) o[i] = yu[i] * yg[i] * __builtin_amdgcn_rcpf(1.0f + __builtin_amdgcn_exp2f(-1.4426950408889634f * yg[i]));
    return o; }
struct EpiConv {
    static constexpr bool PERM = false, AFTER_DRAIN = false, APERM = true;
    bf16_t* act; bf16_t* halo; const float* cw; const float* cb;
    __device__ __forceinline__ void operator()(const f32x4 (&acc)[2][2][4][2], const Unit& u, int wr, int wc, int fr, int fq) const {
        constexpr int DFFc = 2816, N2 = 5632;
        typedef unsigned u32x2e __attribute__((ext_vector_type(2)));
#pragma unroll
        for (int n = 0; n < 2; ++n) {
            const int cu = u.pn * 128 + wc * 32 + n * 16 + 4 * fq, cg = DFFc + cu;
            const f32x4 w0u = *(const f32x4*)(cw + cu), w1u = *(const f32x4*)(cw + N2 + cu), w2u = *(const f32x4*)(cw + 2 * N2 + cu), bu = *(const f32x4*)(cb + cu);
            const f32x4 w0g = *(const f32x4*)(cw + cg), w1g = *(const f32x4*)(cw + N2 + cg), w2g = *(const f32x4*)(cw + 2 * N2 + cg), bg = *(const f32x4*)(cb + cg);
#pragma unroll
            for (int ai = 0; ai < 2; ++ai) {
                const f32x4 U0 = acc[ai][0][0][n], U1 = acc[ai][0][1][n], U2 = acc[ai][0][2][n], U3 = acc[ai][0][3][n];
                const f32x4 G0 = acc[ai][1][0][n], G1 = acc[ai][1][1][n], G2 = acc[ai][1][2][n], G3 = acc[ai][1][3][n];
                const f32x4 Um1 = dpp_shr1(U3), Um2 = dpp_shr1(U2), Gm1 = dpp_shr1(G3), Gm2 = dpp_shr1(G2);
                const int row0 = u.pm * BM + ai * HALF + wr * 64 + 4 * fr;
                f32x4 o[4];
                o[0] = silu_mul(bu + w0u * Um2 + w1u * Um1 + w2u * U0, bg + w0g * Gm2 + w1g * Gm1 + w2g * G0);
                o[1] = silu_mul(bu + w0u * Um1 + w1u * U0 + w2u * U1, bg + w0g * Gm1 + w1g * G0 + w2g * G1);
                o[2] = silu_mul(bu + w0u * U0 + w1u * U1 + w2u * U2, bg + w0g * G0 + w1g * G1 + w2g * G2);
                o[3] = silu_mul(bu + w0u * U1 + w1u * U2 + w2u * U3, bg + w0g * G1 + w1g * G2 + w2g * G3);
#pragma unroll
                for (int m = 0; m < 4; ++m) if (fr != 0 || m >= 2) { u32x2e w; w.x = cvt_pk_bf16(o[m][0], o[m][1]); w.y = cvt_pk_bf16(o[m][2], o[m][3]);
                    *(u32x2e*)(act + (size_t)(row0 + m) * DFFc + cu) = w; }
                if (fr == 0 || fr == 15) { bf16_t* hp = halo + ((size_t)(row0 >> 6) * 4 + (fr == 0 ? 0 : 2)) * N2;
                    const f32x4 ua = fr == 0 ? U0 : U2, ub = fr == 0 ? U1 : U3, ga = fr == 0 ? G0 : G2, gb = fr == 0 ? G1 : G3;
                    u32x2e w; w.x = cvt_pk_bf16(ua[0], ua[1]); w.y = cvt_pk_bf16(ua[2], ua[3]); *(u32x2e*)(hp + cu) = w;
                    w.x = cvt_pk_bf16(ub[0], ub[1]); w.y = cvt_pk_bf16(ub[2], ub[3]); *(u32x2e*)(hp + N2 + cu) = w;
                    w.x = cvt_pk_bf16(ga[0], ga[1]); w.y = cvt_pk_bf16(ga[2], ga[3]); *(u32x2e*)(hp + cg) = w;
                    w.x = cvt_pk_bf16(gb[0], gb[1]); w.y = cvt_pk_bf16(gb[2], gb[3]); *(u32x2e*)(hp + N2 + cg) = w; }
            }
        }
    }
};

template <bool BASE_F32> struct EpiResB {
    static constexpr bool PERM = true, AFTER_DRAIN = false, APERM = false;
    const void* base; bf16_t* out; int ldc;
    __device__ __forceinline__ void operator()(const f32x4 (&acc)[2][2][4][2], const Unit& u, int wr, int wc, int fr, int fq) const {
        const int col0 = u.pn * BM + wc * 32 + 8 * fq;
#pragma unroll
        for (int ai = 0; ai < 2; ++ai)
#pragma unroll
            for (int m = 0; m < 4; ++m) { const size_t off = (size_t)(u.pm * BM + ai * HALF + wr * 64 + m * 16 + fr) * ldc + col0;
#pragma unroll
                for (int bj = 0; bj < 2; ++bj) { f32x4 b0, b1;
                    if (BASE_F32) { b0 = *(const f32x4*)((const float*)base + off + bj * HALF); b1 = *(const f32x4*)((const float*)base + off + bj * HALF + 4); }
                    else { const u32x4 r = *(const u32x4*)((const bf16_t*)base + off + bj * HALF);
                        b0[0] = __uint_as_float(r.x << 16); b0[1] = __uint_as_float(r.x & 0xffff0000u); b0[2] = __uint_as_float(r.y << 16); b0[3] = __uint_as_float(r.y & 0xffff0000u);
                        b1[0] = __uint_as_float(r.z << 16); b1[1] = __uint_as_float(r.z & 0xffff0000u); b1[2] = __uint_as_float(r.w << 16); b1[3] = __uint_as_float(r.w & 0xffff0000u); }
                    const f32x4 o0 = b0 + acc[ai][bj][m][0], o1 = b1 + acc[ai][bj][m][1];
                    u32x4 w; w.x = cvt_pk_bf16(o0[0], o0[1]); w.y = cvt_pk_bf16(o0[2], o0[3]); w.z = cvt_pk_bf16(o1[0], o1[1]); w.w = cvt_pk_bf16(o1[2], o1[3]);
                    *(u32x4*)(out + off + bj * HALF) = w; } }
    }
};
template <class Epi, class Sched, bool ALIGN_EPI = false, bool SP2 = false>
__device__ __forceinline__ void gemm_phase(PG8_LAS unsigned char* lds, const Gemm g, const Sched& S, const Epi& E) {
    int tid_l = threadIdx.x; asm volatile("" : "+v"(tid_l)); const int tid = tid_l, wid = __builtin_amdgcn_readfirstlane(tid >> 6), lane = tid & 63, wr = wid >> 2, wc = wid & 3, fr = lane & 15, fq = lane >> 4;
    const int K = g.K, nt = K / BK;
    unsigned voffA[2], voffB[2];
#pragma unroll
    for (int i = 0; i < 2; ++i) { int R, C; stage_rc(tid * 16 + i * 8192, R, C); const int Rb = Epi::PERM ? ((R & ~31) + perm32(R & 31)) : R;
        const int Ra = Epi::APERM ? ((R & 64) + (R & 15) * 4 + ((R >> 4) & 3)) : R; voffA[i] = (unsigned)(Ra * K + C) * 2u; voffB[i] = (unsigned)(Rb * K + C) * 2u; }
    const size_t kstep = (size_t)(BK * 2);
    const size_t hstep = (size_t)HALF * K * 2;
    const size_t tstep = 2 * hstep;
    const unsigned ldsw = (unsigned)wid * 1024u;
    const int aoff = lds_byte(wr * 64 + fr, fq * 8), boff = lds_byte(wc * 32 + fr, fq * 8);
#define PG8_SA(b, h) (((b) * 2 + (h)) * HTB)
#define PG8_SB(b, h) ((4 + (b) * 2 + (h)) * HTB)
#define PG8_STAGE(bufoff, gbase, voff) do { _Pragma("unroll") for (int _i = 0; _i < 2; ++_i) \
        __builtin_amdgcn_global_load_lds((const unsigned*)((const char*)(gbase) + (voff)[_i]), (PG8_LAS unsigned*)(lds + (bufoff) + ldsw + _i * 8192), 16, 0, 0); } while (0)
#define PG8_LDA(dst, b, h) do { _Pragma("unroll") for (int m = 0; m < 4; ++m) _Pragma("unroll") for (int k = 0; k < 2; ++k) dst[m][k] = *(const PG8_LAS bf16x8*)(lds + PG8_SA(b, h) + aoff + m * 2048 + k * 1024); } while (0)
#define PG8_LDB(dst, b, h) do { _Pragma("unroll") for (int n = 0; n < 2; ++n) _Pragma("unroll") for (int k = 0; k < 2; ++k) dst[n][k] = *(const PG8_LAS bf16x8*)(lds + PG8_SB(b, h) + boff + n * 2048 + k * 1024); } while (0)
#define PG8_MMA(ai, bj, At, Bt) do { __builtin_amdgcn_s_setprio(1); _Pragma("unroll") for (int m = 0; m < 4; ++m) _Pragma("unroll") for (int n = 0; n < 2; ++n) _Pragma("unroll") for (int k = 0; k < 2; ++k) \
        acc[ai][bj][m][n] = __builtin_amdgcn_mfma_f32_16x16x32_bf16(Bt[n][k], At[m][k], acc[ai][bj][m][n], 0, 0, 0); __builtin_amdgcn_s_setprio(0); } while (0)
#define PG8_WAIT_V(n) asm volatile("s_waitcnt vmcnt(" #n ")" ::: "memory")
#define PG8_WAIT_L(n) asm volatile("s_waitcnt lgkmcnt(" #n ")" ::: "memory")
#define PG8_BAR __builtin_amdgcn_s_barrier()
#define PG8_SCHED __builtin_amdgcn_sched_barrier(0)
    Unit cur, nxt; int ui = 0;
    if (!S.next(0, cur)) return;
    f32x4 acc[2][2][4][2];
#pragma unroll
    for (int a = 0; a < 2; ++a)
#pragma unroll
        for (int b = 0; b < 2; ++b)
#pragma unroll
            for (int m = 0; m < 4; ++m)
#pragma unroll
                for (int n = 0; n < 2; ++n) acc[a][b][m][n] = (f32x4){0.f, 0.f, 0.f, 0.f};
    bf16x8 At[4][2], B0[2][2], B1[2][2];
    const char* cA = (const char*)g.A + (size_t)cur.pm * tstep; const char* cB = (const char*)g.Bt + (size_t)cur.pn * tstep;
    S.a_ready(cur);
    if constexpr (SP2) {
        PG8_STAGE(PG8_SB(0, 0), cB, voffB); PG8_STAGE(PG8_SB(0, 1), cB + hstep, voffB); PG8_STAGE(PG8_SA(0, 0), cA, voffA); PG8_STAGE(PG8_SA(0, 1), cA + hstep, voffA);
        if (wr == 1) PG8_BAR;
        PG8_WAIT_V(2); PG8_BAR;
        PG8_STAGE(PG8_SB(1, 0), cB + kstep, voffB); PG8_STAGE(PG8_SA(1, 0), cA + kstep, voffA); PG8_STAGE(PG8_SB(1, 1), cB + hstep + kstep, voffB);
        PG8_WAIT_V(6); PG8_BAR;
    } else {
        PG8_STAGE(PG8_SB(0, 0), cB, voffB); PG8_STAGE(PG8_SA(0, 0), cA, voffA); PG8_STAGE(PG8_SB(0, 1), cB + hstep, voffB); PG8_STAGE(PG8_SA(0, 1), cA + hstep, voffA);
        if (wr == 1) PG8_BAR;
        PG8_WAIT_V(4); PG8_BAR;
        PG8_STAGE(PG8_SB(1, 0), cB + kstep, voffB); PG8_STAGE(PG8_SA(1, 0), cA + kstep, voffA); PG8_STAGE(PG8_SB(1, 1), cB + hstep + kstep, voffB);
        PG8_WAIT_V(6); PG8_BAR;
    }
    for (;;) {
        const bool has_next = S.next(ui + 1, nxt);
        const char* nA = has_next ? (const char*)g.A + (size_t)nxt.pm * tstep : cA; const char* nB = has_next ? (const char*)g.Bt + (size_t)nxt.pn * tstep : cB;
        for (int t = 0; t < nt; t += 2) {
            const bool last = (t == nt - 2);
            const char* a1 = cA + (size_t)(t + 1) * kstep;
            const char* a2 = last ? nA : cA + (size_t)(t + 2) * kstep; const char* b2 = last ? nB : cB + (size_t)(t + 2) * kstep;
            const char* a3 = a2 + kstep; const char* b3 = b2 + kstep;
            if (last && has_next) S.a_ready(nxt);
            if constexpr (SP2) {
            PG8_LDB(B0, 0, 0); PG8_LDB(B1, 0, 1); PG8_SCHED; PG8_LDA(At, 0, 0); PG8_STAGE(PG8_SA(1, 1), a1 + hstep, voffA);
            PG8_WAIT_V(8); PG8_WAIT_L(0); PG8_BAR; PG8_MMA(0, 0, At, B0); PG8_MMA(0, 1, At, B1); PG8_BAR; PG8_SCHED;
            PG8_LDA(At, 0, 1); PG8_STAGE(PG8_SB(0, 0), b2, voffB); PG8_STAGE(PG8_SB(0, 1), b2 + hstep, voffB); PG8_STAGE(PG8_SA(0, 0), a2, voffA);
            PG8_WAIT_V(8); PG8_WAIT_L(0); PG8_BAR; PG8_MMA(1, 0, At, B0); PG8_MMA(1, 1, At, B1); PG8_BAR; PG8_SCHED;
            PG8_LDB(B0, 1, 0); PG8_LDB(B1, 1, 1); PG8_SCHED; PG8_LDA(At, 1, 0); PG8_STAGE(PG8_SA(0, 1), a2 + hstep, voffA);
            PG8_WAIT_V(8); PG8_WAIT_L(0); PG8_BAR; PG8_MMA(0, 0, At, B0); PG8_MMA(0, 1, At, B1); PG8_BAR; PG8_SCHED;
            PG8_LDA(At, 1, 1); PG8_STAGE(PG8_SB(1, 0), b3, voffB); PG8_STAGE(PG8_SB(1, 1), b3 + hstep, voffB); PG8_STAGE(PG8_SA(1, 0), a3, voffA);
            PG8_WAIT_V(8); PG8_WAIT_L(0); PG8_BAR; PG8_MMA(1, 0, At, B0); PG8_MMA(1, 1, At, B1); PG8_BAR; PG8_SCHED;
            } else {
            PG8_LDB(B0, 0, 0); PG8_SCHED; PG8_LDA(At, 0, 0); PG8_STAGE(PG8_SA(1, 1), a1 + hstep, voffA);
            PG8_WAIT_L(8); PG8_BAR; PG8_WAIT_L(0); PG8_MMA(0, 0, At, B0); PG8_BAR; PG8_SCHED;
            PG8_LDB(B1, 0, 1); PG8_STAGE(PG8_SB(0, 0), b2, voffB);
            PG8_BAR; PG8_WAIT_L(0); PG8_MMA(0, 1, At, B1); PG8_BAR;
            PG8_LDA(At, 0, 1); PG8_STAGE(PG8_SA(0, 0), a2, voffA);
            PG8_BAR; PG8_WAIT_L(0); PG8_MMA(1, 0, At, B0); PG8_BAR; PG8_SCHED;
            PG8_STAGE(PG8_SB(0, 1), b2 + hstep, voffB);
            PG8_WAIT_V(6); PG8_BAR; PG8_MMA(1, 1, At, B1); PG8_BAR;
            PG8_LDB(B0, 1, 0); PG8_SCHED; PG8_LDA(At, 1, 0); PG8_STAGE(PG8_SA(0, 1), a2 + hstep, voffA);
            PG8_WAIT_L(8); PG8_BAR; PG8_WAIT_L(0); PG8_MMA(0, 0, At, B0); PG8_BAR; PG8_SCHED;
            PG8_LDB(B1, 1, 1); PG8_STAGE(PG8_SB(1, 0), b3, voffB);
            PG8_BAR; PG8_WAIT_L(0); PG8_MMA(0, 1, At, B1); PG8_BAR;
            PG8_LDA(At, 1, 1); PG8_STAGE(PG8_SA(1, 0), a3, voffA);
            PG8_BAR; PG8_WAIT_L(0); PG8_MMA(1, 0, At, B0); PG8_BAR; PG8_SCHED;
            PG8_STAGE(PG8_SB(1, 1), b3 + hstep, voffB);
            PG8_WAIT_V(6); PG8_BAR; PG8_MMA(1, 1, At, B1); PG8_BAR;
            }
        }
        if constexpr (ALIGN_EPI) { if (wr == 0) PG8_BAR; }
        if constexpr (!Epi::AFTER_DRAIN) { E(acc, cur, wr, wc, fr, fq); S.done(cur); }
        if (!has_next) break;
#pragma unroll
        for (int a = 0; a < 2; ++a)
#pragma unroll
            for (int b = 0; b < 2; ++b)
#pragma unroll
                for (int m = 0; m < 4; ++m)
#pragma unroll
                    for (int n = 0; n < 2; ++n) acc[a][b][m][n] = (f32x4){0.f, 0.f, 0.f, 0.f};
        cur = nxt; cA = nA; cB = nB; ++ui;
        if constexpr (ALIGN_EPI) { if (wr == 1) PG8_BAR; }
    }
    PG8_WAIT_V(0);
    if constexpr (!ALIGN_EPI) { if (wr == 0) PG8_BAR; }
    PG8_BAR;
    if constexpr (Epi::AFTER_DRAIN) { E.fused(acc, cur, wr, wc, fr, fq, lds, wid, lane); S.done(cur); }
#undef PG8_SA
#undef PG8_SB
#undef PG8_STAGE
#undef PG8_LDA
#undef PG8_LDB
#undef PG8_MMA
#undef PG8_WAIT_V
#undef PG8_WAIT_L
#undef PG8_BAR
#undef PG8_SCHED
}
}
#define LAS __attribute__((address_space(3)))
typedef unsigned short bf16;
typedef short bf16x8 __attribute__((ext_vector_type(8)));
typedef short s16x4 __attribute__((ext_vector_type(4)));
typedef float f32x16 __attribute__((ext_vector_type(16)));
typedef float f32x4 __attribute__((ext_vector_type(4)));
typedef unsigned u32x4 __attribute__((ext_vector_type(4)));
typedef unsigned u32x2 __attribute__((ext_vector_type(2)));

constexpr int DM = 1024, BATCH = 16, SEQ = 2048, MTOK = BATCH * SEQ, DEPTH = 2;
constexpr int NIN_SRC = 2308, NQKV = 2304, MIXW = 768, DFF = 2816, NFF2 = 5632;
constexpr float RMS_EPS = 1e-6f, L2E = 1.4426950408889634f, QSCALE = 0.125f * 1.4426950408889634f;
constexpr int C_FQ = 0, C_FK = 256, C_FV = 512, C_DQ = 768, C_DK = 1024, C_DV = 1280, C_CQ = 1536, C_CK = 1792, C_CV = 2048;
constexpr int MX_FOX = 0, MX_DIFF = 256, MX_CHK = 512;
constexpr int NTHREADS = 512, NWAVES = 8;
constexpr size_t MiB = 1u << 20;
constexpr size_t WS_CTL = 0, WS_FF = 1 * MiB, WS_CUM = 1 * MiB + 512 * 1024;
constexpr size_t WS_WIN = 2 * MiB, WS_WOUT = 14 * MiB, WS_WFI = 18 * MiB, WS_WFO = 40 * MiB;
constexpr size_t SZ_WIN = 6 * MiB, SZ_WOUT = 2 * MiB, SZ_WFI = 11 * MiB, SZ_WFO = (size_t)DM * DFF * 2;
constexpr size_t WS_H = 52 * MiB, WS_QKV = 116 * MiB, WS_MIX = 308 * MiB, WS_UV = 116 * MiB, WS_ACT = 260 * MiB, WS_XB = 436 * MiB, WS_END = 500 * MiB;
static_assert(WS_WFO + 2 * SZ_WFO <= WS_H, "ws map");
constexpr int HALF_M = MTOK / 2;
constexpr int LDS_RING = 131072, LDS_WF = 131072, LDS_MISC = 147456, LDS_TAB = 147456 + 256, LDS_BYTES = 155648;

typedef float f32x2_t __attribute__((ext_vector_type(2))); typedef __bf16 bf16x2_t __attribute__((ext_vector_type(2)));
__device__ __forceinline__ unsigned cvtpk(float lo, float hi) { f32x2_t v = {lo, hi}; bf16x2_t b = __builtin_convertvector(v, bf16x2_t); return __builtin_bit_cast(unsigned, b); }
__device__ __forceinline__ float bf2f(unsigned short v) { return __uint_as_float((unsigned)v << 16); }
__device__ __forceinline__ float wave_sum(float v) {
#pragma unroll
    for (int o = 1; o < 64; o <<= 1) v += __shfl_xor(v, o);
    return v;
}
__device__ __forceinline__ float ex2(float v) { return __builtin_amdgcn_exp2f(v); }

struct Args { const float* in[14]; float* out; unsigned char* ws; };
struct WMeta { bf16* dst; int K; float scale; };
constexpr int W_I_IN = 16 * 72, W_I_OUT = 12 * 32, W_I_FI = 16 * 176, W_I_FO = 44 * 32, W_I_L = W_I_IN + W_I_OUT + W_I_FI + W_I_FO;
__device__ __forceinline__ void witem_load(const Args& a, int it, int lane, float (&wv)[32], WMeta& mt) {
    const int l = it / W_I_L; int r = it % W_I_L;
    const float* W; int K, Nsrc, nblk, mode; bf16* WT;
    if (r < W_I_IN) { W = a.in[2] + (size_t)l * DM * NIN_SRC; K = DM; Nsrc = NIN_SRC; nblk = 72; WT = (bf16*)(a.ws + WS_WIN + l * SZ_WIN); mode = 1; }
    else if ((r -= W_I_IN) < W_I_OUT) { W = a.in[7] + (size_t)l * MIXW * DM; K = MIXW; Nsrc = DM; nblk = 32; WT = (bf16*)(a.ws + WS_WOUT + l * SZ_WOUT); mode = 0; }
    else if ((r -= W_I_OUT) < W_I_FI) { W = a.in[9] + (size_t)l * DM * NFF2; K = DM; Nsrc = NFF2; nblk = 176; WT = (bf16*)(a.ws + WS_WFI + l * SZ_WFI); mode = 2; }
    else { r -= W_I_FI; W = a.in[12] + (size_t)l * DFF * DM; K = DFF; Nsrc = DM; nblk = 32; WT = (bf16*)(a.ws + WS_WFO + l * SZ_WFO); mode = 0; }
    const int kb = r / nblk, nb = r % nblk, k0 = 64 * kb, n0 = 32 * nb;
    int sc0 = n0; float scale = 1.f;
    if (mode == 2) sc0 = (n0 >> 8) * 128 + (n0 & 127) + ((n0 & 128) ? DFF : 0);
    if (mode == 1) { sc0 = n0 + (n0 >= 768 ? 4 : 0);
        if ((n0 >= C_FQ && n0 < C_FK) || (n0 >= C_DQ && n0 < C_DK) || (n0 >= C_CQ && n0 < C_CK)) scale = QSCALE; }
    const float* src = W + (size_t)(k0 + (lane >> 5)) * Nsrc + sc0 + (lane & 31);
#pragma unroll
    for (int i = 0; i < 32; ++i) wv[i] = src[(size_t)(2 * i) * Nsrc];
    mt.dst = WT + (size_t)n0 * K + k0; mt.K = K; mt.scale = scale;
}
__device__ __forceinline__ void witem_store(const WMeta& mt, const float (&wv)[32], LAS float* scr, int lane) {
#pragma unroll
    for (int i = 0; i < 32; ++i) { const int kk = 2 * i + (lane >> 5); scr[kk * 33 + (lane & 31)] = wv[i] * mt.scale; }
    asm volatile("s_waitcnt lgkmcnt(0)" ::: "memory");
    const int c = lane & 7;
#pragma unroll
    for (int j = 0; j < 4; ++j) { const int n = (lane >> 3) + 8 * j; const LAS float* s = scr + (8 * c) * 33 + n;
        u32x4 o; o.x = cvtpk(s[0 * 33], s[1 * 33]); o.y = cvtpk(s[2 * 33], s[3 * 33]); o.z = cvtpk(s[4 * 33], s[5 * 33]); o.w = cvtpk(s[6 * 33], s[7 * 33]);
        *(u32x4*)(mt.dst + (size_t)n * mt.K + 8 * c) = o; }
}
__device__ __forceinline__ void phase_weights(const Args& a, LAS unsigned char* lds, int gw, int NGW, int wave, int lane) {
    LAS float* scr = (LAS float*)(lds + wave * 16896);
    for (int it = gw; it < DEPTH * W_I_L; it += 2 * NGW) {
        float wa[32], wb[32]; WMeta ma, mb; const bool two = it + NGW < DEPTH * W_I_L;
        witem_load(a, it, lane, wa, ma);
        if (two) witem_load(a, it + NGW, lane, wb, mb);
        witem_store(ma, wa, scr, lane);
        if (two) witem_store(mb, wb, scr + 64 * 33, lane);
        asm volatile("s_waitcnt lgkmcnt(0)" ::: "memory");
    }
}

template <bool XBF> struct RowLd;
template <> struct RowLd<false> { typedef f32x4 raw; static __device__ __forceinline__ raw ld(const void* x, size_t m, int lane, int j) { return *((const f32x4*)((const float*)x + m * DM) + lane + 64 * j); }
    static __device__ __forceinline__ f32x4 cv(raw r) { return r; } };
template <> struct RowLd<true> { typedef u32x2 raw; static __device__ __forceinline__ raw ld(const void* x, size_t m, int lane, int j) { return *((const u32x2*)((const bf16*)x + m * DM) + lane + 64 * j); }
    static __device__ __forceinline__ f32x4 cv(raw r) { f32x4 v; v.x = __uint_as_float(r.x << 16); v.y = __uint_as_float(r.x & 0xffff0000u); v.z = __uint_as_float(r.y << 16); v.w = __uint_as_float(r.y & 0xffff0000u); return v; } };
template <int MODE, bool XBF>
__device__ __forceinline__ void phase_norm(const void* x, const float* g, bf16* H, float* outf, const float* w_in_l, const float* b_fox, float* FF,
                                           LAS unsigned char* lds, int gw, int NGW, int tid, int lane) {
    LAS f32x4* wf = (LAS f32x4*)(lds + LDS_WF);
    if (MODE == 1) {
        __syncthreads();
        for (int k = tid; k < DM; k += NTHREADS) wf[k] = *(const f32x4*)(w_in_l + (size_t)k * NIN_SRC + 768);
        __syncthreads();
    }
    f32x4 gv[4];
#pragma unroll
    for (int j = 0; j < 4; ++j) gv[j] = *((const f32x4*)g + lane + 64 * j);
    f32x4 v[4]; typename RowLd<XBF>::raw vn[4];
    if (gw < MTOK) {
#pragma unroll
        for (int j = 0; j < 4; ++j) vn[j] = RowLd<XBF>::ld(x, (size_t)gw, lane, j); }
    for (int m = gw; m < MTOK; m += NGW) {
        float s = 0.f;
#pragma unroll
        for (int j = 0; j < 4; ++j) v[j] = RowLd<XBF>::cv(vn[j]);
        if (m + NGW < MTOK) {
#pragma unroll
            for (int j = 0; j < 4; ++j) vn[j] = RowLd<XBF>::ld(x, (size_t)(m + NGW), lane, j); }
#pragma unroll
        for (int j = 0; j < 4; ++j) s += (v[j].x * v[j].x + v[j].y * v[j].y) + (v[j].z * v[j].z + v[j].w * v[j].w);
        const float rstd = 1.0f / sqrtf(wave_sum(s) * (1.f / DM) + RMS_EPS);
#pragma unroll
        for (int j = 0; j < 4; ++j) v[j] = v[j] * rstd * gv[j];
        if (MODE == 2) {
            f32x4* o = (f32x4*)(outf + (size_t)m * DM) + lane;
#pragma unroll
            for (int j = 0; j < 4; ++j) o[64 * j] = v[j];
        } else {
            u32x2* o = (u32x2*)(H + (size_t)m * DM) + lane;
#pragma unroll
            for (int j = 0; j < 4; ++j) { u32x2 w; w.x = cvtpk(v[j].x, v[j].y); w.y = cvtpk(v[j].z, v[j].w); o[64 * j] = w; }
        }
        if (MODE == 1) {
            f32x4 d = {0.f, 0.f, 0.f, 0.f};
#pragma unroll
            for (int j = 0; j < 4; ++j) { const int k = 4 * lane + 256 * j;
                d += wf[k] * v[j].x; d += wf[k + 1] * v[j].y; d += wf[k + 2] * v[j].z; d += wf[k + 3] * v[j].w; }
            d.x = wave_sum(d.x); d.y = wave_sum(d.y); d.z = wave_sum(d.z); d.w = wave_sum(d.w);
            if (lane < 4) { float z = (lane == 0 ? d.x : lane == 1 ? d.y : lane == 2 ? d.z : d.w) + b_fox[lane];
                const float ls = fminf(z, 0.f) - log1pf(expf(-fabsf(z)));
                FF[(size_t)m * 4 + lane] = ls; }
        }
    }
}

__device__ __forceinline__ void cumsum_seq(const float* FF, float* CUM, int bh, int lane) {
    const int b = bh >> 2, h = bh & 3;
    const float* src = FF + ((size_t)b * SEQ + 32 * lane) * 4 + h;
    float v[32]; float s = 0.f;
#pragma unroll
    for (int i = 0; i < 32; ++i) { s += src[4 * i]; v[i] = s; }
    float inc = s;
#pragma unroll
    for (int o = 1; o < 64; o <<= 1) { const float t = __shfl_up(inc, o); if (lane >= o) inc += t; }
    const float excl = inc - s;
    float* dst = CUM + (size_t)bh * SEQ + 32 * lane;
#pragma unroll
    for (int i = 0; i < 32; i += 4) { f32x4 w = {v[i] + excl, v[i + 1] + excl, v[i + 2] + excl, v[i + 3] + excl}; *(f32x4*)(dst + i) = w; }
}

__device__ __forceinline__ void unpack8(const u32x4 a, float (&f)[8]) {
#pragma unroll
    for (int i = 0; i < 4; ++i) { f[2 * i] = __uint_as_float(a[i] << 16); f[2 * i + 1] = __uint_as_float(a[i] & 0xffff0000u); } }
__device__ __forceinline__ void phase_fixup(const bf16* HALO, bf16* ACT, const float* cw, const float* cb, int gt, int NGT) {
    constexpr int NCG = DFF / 8, NG = MTOK / 64;
    for (int it = gt; it < NG * 2 * NCG; it += NGT) {
        const int cg8 = it % NCG, rs = it / NCG, s = rs & 1, j = rs >> 1, c0 = cg8 * 8;
        const bool first = ((j * 64) % SEQ) == 0;
        const bf16* hj = HALO + (size_t)j * 4 * NFF2; const bf16* hp = hj - 4 * NFF2;
        const bf16* pt = hj + (size_t)s * NFF2;
        const bf16* p1 = (s == 0) ? hp + 3 * NFF2 : hj;
        const bf16* p2 = (s == 0) ? hp + 2 * NFF2 : hp + 3 * NFF2;
        const u32x4 z = {0u, 0u, 0u, 0u};
        float ut[8], u1[8], u2[8], gt_[8], g1[8], g2[8];
        unpack8(*(const u32x4*)(pt + c0), ut); unpack8(*(const u32x4*)(pt + DFF + c0), gt_);
        unpack8((s == 0 && first) ? z : *(const u32x4*)(p1 + c0), u1); unpack8((s == 0 && first) ? z : *(const u32x4*)(p1 + DFF + c0), g1);
        unpack8(first ? z : *(const u32x4*)(p2 + c0), u2); unpack8(first ? z : *(const u32x4*)(p2 + DFF + c0), g2);
        float o[8];
#pragma unroll
        for (int i = 0; i < 8; ++i) { const int c = c0 + i;
            const float yu = cb[c] + cw[c] * u2[i] + cw[NFF2 + c] * u1[i] + cw[2 * NFF2 + c] * ut[i];
            const float yg = cb[DFF + c] + cw[DFF + c] * g2[i] + cw[NFF2 + DFF + c] * g1[i] + cw[2 * NFF2 + DFF + c] * gt_[i];
            o[i] = yu * yg / (1.f + __expf(-yg)); }
        u32x4 w; w.x = cvtpk(o[0], o[1]); w.y = cvtpk(o[2], o[3]); w.z = cvtpk(o[4], o[5]); w.w = cvtpk(o[6], o[7]);
        *(u32x4*)(ACT + (size_t)(j * 64 + s) * DFF + c0) = w;
    }
}
__device__ __forceinline__ s16x4 vtr(LAS const char* p) { typedef short v4i16_t __attribute__((ext_vector_type(4))); return __builtin_bit_cast(s16x4, __builtin_amdgcn_ds_read_tr16_b64_v4i16((LAS v4i16_t*)p)); }
constexpr int KROWB = 144, KT_BYTES = 64 * KROWB;

__device__ __forceinline__ void qk_tile(f32x16& p0, f32x16& p1, LAS const char* kt, const bf16x8 (&qr)[4], int r32, int hi) {
    LAS const char* kb = kt + r32 * KROWB + hi * 16;
#pragma unroll
    for (int ks = 0; ks < 4; ++ks) {
        const bf16x8 a0 = *(LAS const bf16x8*)(kb + ks * 32), a1 = *(LAS const bf16x8*)(kb + 32 * KROWB + ks * 32);
        p0 = __builtin_amdgcn_mfma_f32_32x32x16_bf16(a0, qr[ks], p0, 0, 0, 0);
        p1 = __builtin_amdgcn_mfma_f32_32x32x16_bf16(a1, qr[ks], p1, 0, 0, 0);
    }
}
template <int NDB>
__device__ __forceinline__ void softmax_pv(f32x16& p0, f32x16& p1, float& m, float& l, f32x16 (&o)[NDB], LAS const char* vt, int vb) {
    float mx = fmaxf(p0[0], p1[0]);
#pragma unroll
    for (int r = 1; r < 16; ++r) mx = fmaxf(mx, fmaxf(p0[r], p1[r]));
    mx = fmaxf(mx, __shfl_xor(mx, 32));
    if (__builtin_amdgcn_ballot_w64(mx > m) != 0ull) {
        const float mn = fmaxf(m, mx);
        const float alpha = ex2(m - mn);
        m = mn; l *= alpha;
#pragma unroll
        for (int db = 0; db < NDB; ++db)
#pragma unroll
            for (int r = 0; r < 16; ++r) o[db][r] *= alpha;
    }
    const float mn = m;
    float rs = 0.f;
#pragma unroll
    for (int r = 0; r < 16; ++r) { p0[r] = ex2(p0[r] - mn); p1[r] = ex2(p1[r] - mn); rs += p0[r] + p1[r]; }
    l += rs;
    bf16x8 pf[4];
    { u32x4 w;
      w.x = cvtpk(p0[0], p0[1]); w.y = cvtpk(p0[2], p0[3]); w.z = cvtpk(p0[4], p0[5]); w.w = cvtpk(p0[6], p0[7]); pf[0] = __builtin_bit_cast(bf16x8, w);
      w.x = cvtpk(p0[8], p0[9]); w.y = cvtpk(p0[10], p0[11]); w.z = cvtpk(p0[12], p0[13]); w.w = cvtpk(p0[14], p0[15]); pf[1] = __builtin_bit_cast(bf16x8, w);
      w.x = cvtpk(p1[0], p1[1]); w.y = cvtpk(p1[2], p1[3]); w.z = cvtpk(p1[4], p1[5]); w.w = cvtpk(p1[6], p1[7]); pf[2] = __builtin_bit_cast(bf16x8, w);
      w.x = cvtpk(p1[8], p1[9]); w.y = cvtpk(p1[10], p1[11]); w.z = cvtpk(p1[12], p1[13]); w.w = cvtpk(p1[14], p1[15]); pf[3] = __builtin_bit_cast(bf16x8, w); }
#pragma unroll
    for (int kk = 0; kk < 4; ++kk)
#pragma unroll
        for (int db = 0; db < NDB; ++db) {
            const s16x4 lo = vtr(vt + vb + db * 4096 + kk * 1024), hh = vtr(vt + vb + db * 4096 + kk * 1024 + 512);
            const bf16x8 vf = {lo[0], lo[1], lo[2], lo[3], hh[0], hh[1], hh[2], hh[3]};
            o[db] = __builtin_amdgcn_mfma_f32_32x32x16_bf16(vf, pf[kk], o[db], 0, 0, 0);
        }
}

template <int MODE>
__device__ __forceinline__ void attn_unit64(const bf16* qkv, bf16* mix, const float* cum_bh, int b, int h, int blk, LAS unsigned char* lds, int tid, int wave, int lane) {
    constexpr int CUMOFF = KT_BYTES + 8192, BUFSZ = CUMOFF + 256;
    const int r32 = lane & 31, hi = lane >> 5;
    const size_t rowbase = (size_t)b * SEQ;
    const int Q0 = blk * 256, qw0 = Q0 + 32 * wave;
    const int CQ = (MODE == 0 ? C_FQ : C_CQ) + h * 64, CK = (MODE == 0 ? C_FK : C_CK) + h * 64, CV = (MODE == 0 ? C_FV : C_CV) + h * 64;
    const int c0 = 4 * blk, cw = c0 + (wave >> 1);
    int tbeg, tend, kvoff;
    if (MODE == 0) { tbeg = 0; tend = 4 * (blk + 1); kvoff = 0; }
    else { tbeg = (c0 >= 8) ? 0 : 8 - c0; tend = 12; kvoff = (c0 - 8) * 64; }
    const int srow = tid >> 3, sch = tid & 7;
    const bf16* kg = qkv + (rowbase + kvoff + srow) * NQKV + CK + sch * 8;
    const bf16* vg = qkv + (rowbase + kvoff + srow) * NQKV + CV + sch * 8;
    const int kdst = srow * KROWB + sch * 16, vdst = KT_BYTES + (sch >> 2) * 4096 + srow * 64 + (sch & 3) * 16;
    const float cref = (MODE == 0) ? cum_bh[Q0] : 0.f;
#define U64_LOAD(K, V, C, tt) do { if ((tt) >= tbeg) { K = *(const u32x4*)(kg + (size_t)(tt) * 64 * NQKV); V = *(const u32x4*)(vg + (size_t)(tt) * 64 * NQKV); \
        if (MODE == 0 && tid < 16) C = *(const f32x4*)(cum_bh + (tt) * 64 + 4 * tid); } } while (0)
#define U64_STAGE(K, V, C, buf) do { *(LAS u32x4*)((buf) + kdst) = K; *(LAS u32x4*)((buf) + vdst) = V; if (MODE == 0 && tid < 16) *(LAS f32x4*)((buf) + CUMOFF + tid * 16) = (cref - C) * L2E; } while (0)
#define LDS_BAR() asm volatile("s_waitcnt lgkmcnt(0)\n\ts_barrier" ::: "memory")
    u32x4 kA = {0u, 0u, 0u, 0u}, vA = kA, kB = kA, vB = kA; f32x4 cA = {0.f, 0.f, 0.f, 0.f}, cB = cA;
    U64_LOAD(kA, vA, cA, tend - 1); U64_LOAD(kB, vB, cB, tend - 2);
    bf16x8 qr[4];
#pragma unroll
    for (int ks = 0; ks < 4; ++ks) qr[ks] = *(const bf16x8*)(qkv + (rowbase + qw0 + r32) * NQKV + CQ + ks * 16 + hi * 8);
    float m = -1e30f, l = 0.f;
    f32x16 o[2];
#pragma unroll
    for (int db = 0; db < 2; ++db)
#pragma unroll
        for (int r = 0; r < 16; ++r) o[db][r] = 0.f;
    const int vb = (4 * hi + ((lane & 15) >> 2)) * 64 + ((lane >> 4) & 1) * 32 + (lane & 3) * 8;
    LAS const float* tab = (LAS const float*)(lds + LDS_TAB) + h * 192;
    auto compute = [&](const int t, LAS unsigned char* const buf) __attribute__((always_inline)) {
        const int kv0 = kvoff + 64 * t;
        bool doit;
        if (MODE == 0) doit = kv0 <= qw0 + 31; else { const int kc = c0 - 8 + t; doit = (kc >= cw - 8) && (kc <= cw); }
        if (doit) {
            f32x16 p0 = (f32x16){0.f, 0.f, 0.f, 0.f, 0.f, 0.f, 0.f, 0.f, 0.f, 0.f, 0.f, 0.f, 0.f, 0.f, 0.f, 0.f}, p1 = p0;
            if (MODE == 2 && cw - (c0 - 8 + t) >= 3) { const float bv = tab[191];
#pragma unroll
                for (int r = 0; r < 16; ++r) { p0[r] = bv; p1[r] = bv; } }
            if (MODE == 0) {
#pragma unroll
                for (int g = 0; g < 4; ++g) { const f32x4 ca = *(LAS const f32x4*)(buf + CUMOFF + (8 * g + 4 * hi) * 4), cb = *(LAS const f32x4*)(buf + CUMOFF + (32 + 8 * g + 4 * hi) * 4);
#pragma unroll
                    for (int i = 0; i < 4; ++i) { p0[4 * g + i] = ca[i]; p1[4 * g + i] = cb[i]; } }
            }
            qk_tile(p0, p1, (LAS const char*)buf, qr, r32, hi);
            if (MODE == 0) {
                if (kv0 + 63 > qw0) {
                    const int qa = qw0 + r32 - kv0 - 4 * hi;
#pragma unroll
                    for (int r = 0; r < 16; ++r) { const int kl = (r & 3) + 8 * (r >> 2); if (kl > qa) p0[r] = -INFINITY; if (kl + 32 > qa) p1[r] = -INFINITY; }
                }
            } else {
                const int dc = cw - (c0 - 8 + t);
                if (dc < 3) {
                    const int rel0 = qw0 + r32 - kv0 - 4 * hi + 63;
#pragma unroll
                    for (int r = 0; r < 16; ++r) { const int kl = (r & 3) + 8 * (r >> 2);
                        int i0 = rel0 - kl, i1 = rel0 - kl - 32; i0 = i0 < 0 ? 0 : (i0 > 191 ? 191 : i0); i1 = i1 < 0 ? 0 : (i1 > 191 ? 191 : i1);
                        p0[r] += tab[i0]; p1[r] += tab[i1]; }
                }
            }
            softmax_pv<2>(p0, p1, m, l, o, (LAS const char*)buf + KT_BYTES, vb);
        }
    };
    int pi = 0;
    for (int t = tend - 1; t >= tbeg; t -= 2, pi ^= 1) {
        LAS unsigned char* const sb = lds + (pi ? 2 * BUFSZ : 0); const bool two = (t - 1 >= tbeg);
        U64_STAGE(kA, vA, cA, sb); if (two) U64_STAGE(kB, vB, cB, sb + BUFSZ);
        LDS_BAR();
        U64_LOAD(kA, vA, cA, t - 2); U64_LOAD(kB, vB, cB, t - 3);
        compute(t, sb); if (two) compute(t - 1, sb + BUFSZ);
    }
#undef U64_LOAD
#undef U64_STAGE
    l += __shfl_xor(l, 32);
    const float inv = 1.0f / l;
    bf16* orow = mix + (rowbase + qw0 + r32) * MIXW + (MODE == 0 ? MX_FOX : MX_CHK) + h * 64 + 4 * hi;
#pragma unroll
    for (int db = 0; db < 2; ++db)
#pragma unroll
        for (int g = 0; g < 4; ++g) { u32x2 w; w.x = cvtpk(o[db][4 * g] * inv, o[db][4 * g + 1] * inv); w.y = cvtpk(o[db][4 * g + 2] * inv, o[db][4 * g + 3] * inv);
            *(u32x2*)(orow + 32 * db + 8 * g) = w; }
    __syncthreads();
}

template <int C>
__device__ __forceinline__ void diff_pass(const bf16* qkv, bf16* mix, float* park, int b, int h, int blk, float lam, float sl2, const float* gdiff, float outscale,
                                          LAS unsigned char* lds, int tid, int wave, int lane) {
    constexpr int VOFF = KT_BYTES, BUFSZ = VOFF + 16384;
    const int r32 = lane & 31, hi = lane >> 5;
    const size_t rowbase = (size_t)b * SEQ;
    const int Q0 = blk * 256, qw0 = Q0 + 32 * wave, cwv = qw0 >> 6, tend = 4 * (blk + 1);
    const int srow = tid >> 3, sch = tid & 7;
    const int vrow0 = tid >> 4, vch = tid & 15;
    const bf16* vg = qkv + (rowbase + vrow0) * NQKV + C_DV + h * 128 + vch * 8;
    const int kdst = srow * KROWB + sch * 16, vdst = VOFF + (vch >> 2) * 4096 + vrow0 * 64 + (vch & 3) * 16;
    const int vb = (4 * hi + ((lane & 15) >> 2)) * 64 + ((lane >> 4) & 1) * 32 + (lane & 3) * 8;
    const bf16* kg = qkv + (rowbase + srow) * NQKV + C_DK + h * 128 + C * 64 + sch * 8;
#define DF_LOAD(K, V0, V1, tt) do { if ((tt) >= 0) { const size_t go_ = (size_t)(tt) * 64 * NQKV; K = *(const u32x4*)(kg + go_); V0 = *(const u32x4*)(vg + go_); V1 = *(const u32x4*)(vg + go_ + (size_t)32 * NQKV); } } while (0)
#define DF_STAGE(K, V0, V1, buf) do { *(LAS u32x4*)((buf) + kdst) = K; *(LAS u32x4*)((buf) + vdst) = V0; *(LAS u32x4*)((buf) + vdst + 32 * 64) = V1; } while (0)
    u32x4 kA = {0u, 0u, 0u, 0u}, v0A = kA, v1A = kA, kB = kA, v0B = kA, v1B = kA;
    DF_LOAD(kA, v0A, v1A, tend - 1); DF_LOAD(kB, v0B, v1B, tend - 2);
    bf16x8 qr[4];
#pragma unroll
    for (int ks = 0; ks < 4; ++ks) qr[ks] = *(const bf16x8*)(qkv + (rowbase + qw0 + r32) * NQKV + C_DQ + h * 128 + C * 64 + ks * 16 + hi * 8);
    float m = -1e30f, l = 0.f;
    f32x16 o[4];
#pragma unroll
    for (int db = 0; db < 4; ++db)
#pragma unroll
        for (int r = 0; r < 16; ++r) o[db][r] = 0.f;
    f32x16 ab;
#pragma unroll
    for (int r = 0; r < 16; ++r) ab[r] = sl2 * (float)((r & 3) + 8 * (r >> 2) + 4 * hi);
    auto compute = [&](const int t, LAS unsigned char* const buf) __attribute__((always_inline)) {
        if (t <= cwv) {
            const int kv0 = 64 * t;
            f32x16 p0, p1;
            if (t < cwv) { const float d0 = sl2 * (float)(64 * (t - cwv)), d1 = d0 + 32.f * sl2;
#pragma unroll
                for (int r = 0; r < 16; ++r) { p0[r] = ab[r] + d0; p1[r] = ab[r] + d1; }
                qk_tile(p0, p1, (LAS const char*)buf, qr, r32, hi);
            } else { p0 = (f32x16){0.f, 0.f, 0.f, 0.f, 0.f, 0.f, 0.f, 0.f, 0.f, 0.f, 0.f, 0.f, 0.f, 0.f, 0.f, 0.f}; p1 = p0;
                qk_tile(p0, p1, (LAS const char*)buf, qr, r32, hi);
                const float ql = (float)(qw0 + r32 - kv0), base = ql - (float)(4 * hi);
#pragma unroll
                for (int r = 0; r < 16; ++r) { const float kl = (float)((r & 3) + 8 * (r >> 2)); p0[r] += sl2 * (ql - fabsf(base - kl)); p1[r] += sl2 * (ql - fabsf(base - kl - 32.f)); }
            }
            softmax_pv<4>(p0, p1, m, l, o, (LAS const char*)buf + VOFF, vb);
        }
    };
    int pi = 0;
    for (int t = tend - 1; t >= 0; t -= 2, pi ^= 1) {
        LAS unsigned char* const sb = lds + (pi ? 2 * BUFSZ : 0);
        DF_STAGE(kA, v0A, v1A, sb); DF_STAGE(kB, v0B, v1B, sb + BUFSZ);
        LDS_BAR();
        DF_LOAD(kA, v0A, v1A, t - 2); DF_LOAD(kB, v0B, v1B, t - 3);
        compute(t, sb); compute(t - 1, sb + BUFSZ);
    }
#undef DF_LOAD
#undef DF_STAGE
    l += __shfl_xor(l, 32);
    const float inv = 1.0f / l;
    if (C == 0) {
#pragma unroll
        for (int db = 0; db < 4; ++db)
#pragma unroll
            for (int r = 0; r < 16; ++r) park[(db * 16 + r) * NTHREADS] = o[db][r] * inv;
    } else {
        const float li = lam * inv;
        float ss = 0.f;
#pragma unroll
        for (int db = 0; db < 4; ++db) {
#pragma unroll
            for (int r = 0; r < 16; ++r) { const float v = park[(db * 16 + r) * NTHREADS] - o[db][r] * li; o[db][r] = v; ss += v * v; }
            asm volatile("" ::: "memory"); }
        ss += __shfl_xor(ss, 32);
        const float rn = outscale / sqrtf(ss * (1.f / 128.f) + RMS_EPS);
        bf16* orow = mix + (rowbase + qw0 + r32) * MIXW + MX_DIFF + h * 128 + 4 * hi;
#pragma unroll
        for (int db = 0; db < 4; ++db)
#pragma unroll
            for (int g = 0; g < 4; ++g) { const f32x4 gg = *(const f32x4*)(gdiff + 32 * db + 8 * g + 4 * hi);
                u32x2 w; w.x = cvtpk(o[db][4 * g] * rn * gg.x, o[db][4 * g + 1] * rn * gg.y); w.y = cvtpk(o[db][4 * g + 2] * rn * gg.z, o[db][4 * g + 3] * rn * gg.w);
                *(u32x2*)(orow + 32 * db + 8 * g) = w; }
    }
    __syncthreads();
}
__device__ __forceinline__ void attn_unit_diff2(const bf16* qkv, bf16* mix, int b, int h, int blk, float lam, float sl2, const float* gdiff, float outscale,
                                                LAS unsigned char* lds, int tid, int wave, int lane) {
    float* park = (float*)((unsigned char*)qkv - WS_QKV + WS_H) + (size_t)blockIdx.x * 64 * NTHREADS + tid;
    diff_pass<0>(qkv, mix, park, b, h, blk, lam, sl2, gdiff, outscale, lds, tid, wave, lane);
    int tid2 = threadIdx.x; asm volatile("" : "+v"(tid2) :: "memory"); __builtin_amdgcn_sched_barrier(0);
    float* park2 = (float*)((unsigned char*)qkv - WS_QKV + WS_H) + (size_t)blockIdx.x * 64 * NTHREADS + tid2;
    diff_pass<1>(qkv, mix, park2, b, h, blk, lam, sl2, gdiff, outscale, lds, tid2, __builtin_amdgcn_readfirstlane(tid2 >> 6), tid2 & 63);
}
#define SF(q) (0 << 5 | (q) << 1 | 0), (0 << 5 | (q) << 1 | 1)
#define SD(q) (1 << 5 | (q) << 1 | 0)
#define SC(q) (2 << 5 | (q) << 1 | 0), (2 << 5 | (q) << 1 | 1)
__device__ __forceinline__ int seg_code(int s) {
    constexpr unsigned char T[40] = { SD(7), SD(6), SD(5), SD(4), SD(3), SF(7), SD(2), SF(6), SF(5), SD(1), SF(4), SF(3), SD(0), SF(2),
        SC(7), SC(6), SC(5), SC(4), SC(3), SC(2), SC(1), SC(0), SF(1), SF(0) };
    return T[s];
}
__device__ __forceinline__ void phase_attn(const Args& a, int layer, unsigned* ctr, LAS unsigned char* lds, int tid0, int wave0, int lane0) {
    const bf16* qkv = (const bf16*)(a.ws + WS_QKV); bf16* mix = (bf16*)(a.ws + WS_MIX); const float* CUM = (const float*)(a.ws + WS_CUM);
    for (int i = tid0; i < 4 * 192; i += NTHREADS) ((LAS float*)(lds + LDS_TAB))[i] = a.in[6][(size_t)layer * 768 + i] * L2E;
    const float* dl = a.in[4] + (size_t)layer * 256;
    const float s01 = wave_sum(dl[lane0] * dl[64 + lane0]), s23 = wave_sum(dl[128 + lane0] * dl[192 + lane0]);
    const float lambda_init = 0.8f - 0.6f * expf(-0.3f * (float)layer);
    const float lam = expf(s01) - expf(s23) + lambda_init;
    const float* gdiff = a.in[5] + (size_t)layer * 128;
    LAS volatile unsigned* misc = (LAS volatile unsigned*)(lds + LDS_MISC);
    __syncthreads();
    for (;;) {
        if (threadIdx.x == 0) misc[0] = atomicAdd(ctr, 1u);
        __syncthreads();
        const unsigned idx = misc[0];
        int tidf = threadIdx.x; asm volatile("" : "+v"(tidf) :: "memory"); __builtin_amdgcn_sched_barrier(0);
        const int tid = tidf, lane = tidf & 63, wave = __builtin_amdgcn_readfirstlane(tidf >> 6);
        if (idx >= 1280u) break;
        const int code = seg_code((int)(idx >> 5)), kind = code >> 5, blk = (code >> 1) & 15, sub = (int)(idx & 31);
        if (kind == 1) { const int b = sub >> 1, h = sub & 1;
            attn_unit_diff2(qkv, mix, b, h, blk, lam, exp2f(-4.0f * (float)(h + 1)) * L2E, gdiff, 1.0f - lambda_init, lds, tid, wave, lane); }
        else { const int bh = (code & 1) * 32 + sub, b = bh >> 2, h = bh & 3;
            if (kind == 0) attn_unit64<0>(qkv, mix, CUM + (size_t)bh * SEQ, b, h, blk, lds, tid, wave, lane);
            else attn_unit64<2>(qkv, mix, nullptr, b, h, blk, lds, tid, wave, lane); }
    }
}
#define XB_TMO      128
#define XB_XCNT(j)  (256  + 64 * (j))
#define XB_XSUB(j)  (1280 + 64 * (j))
#define XB_XGEN(j)  (2304 + 64 * (j))
#define XB_TOP      3328
#define XB_TOPGEN   3392
#define XCD_BAR_WORDS 3456
#define XB_SPIN_CAP (1u << 18)

__device__ __forceinline__ unsigned xb_ld(unsigned* p)              { return __hip_atomic_load(p, __ATOMIC_RELAXED, __HIP_MEMORY_SCOPE_AGENT); }
__device__ __forceinline__ unsigned xb_add(unsigned* p, unsigned v) { return __hip_atomic_fetch_add(p, v, __ATOMIC_RELAXED, __HIP_MEMORY_SCOPE_AGENT); }
__device__ __forceinline__ unsigned xb_xcc_id() { return (unsigned)__builtin_amdgcn_s_getreg((3 << 11) | 20) & 0xFu; }
#define XB_SPIN(cond, bar) do { unsigned _sp = 0; while (cond) { __builtin_amdgcn_s_sleep(1); \
    if ((++_sp & 255u) == 0u) { if (xb_ld(&(bar)[XB_TMO])) break; if (_sp > XB_SPIN_CAP) { atomicAdd(&(bar)[XB_TMO], 1u); break; } } } } while (0)

struct XcdBarrier {
    unsigned* bar; unsigned x;
    volatile LAS unsigned* st;
};

__device__ __forceinline__ XcdBarrier xcd_barrier_post(unsigned* bar, volatile LAS unsigned* st) {
    XcdBarrier b; b.bar = bar; b.x = xb_xcc_id(); b.st = st;
    if (threadIdx.x == 0) (void)xb_add(&bar[XB_XCNT(b.x)], 1u);
    return b;
}
__device__ __forceinline__ void xcd_barrier_complete(unsigned* bar, unsigned x, unsigned& nloc, unsigned& nx) {
    const unsigned G = gridDim.x * gridDim.y * gridDim.z;
    unsigned sum, cnt, mine, sp = 0u;
    for (;;) {
        sum = 0u; cnt = 0u; mine = 0u;
#pragma unroll
        for (unsigned j = 0; j < 16; ++j) { const unsigned c = xb_ld(&bar[XB_XCNT(j)]); sum += c; cnt += (c > 0u) ? 1u : 0u; mine = (j == x) ? c : mine; }
        if (sum == G) break;
        __builtin_amdgcn_s_sleep(1);
        if ((++sp & 255u) == 0u) { if (xb_ld(&bar[XB_TMO])) break; if (sp > XB_SPIN_CAP) { atomicAdd(&bar[XB_TMO], 1u); break; } }
    }
    nloc = mine > 0u ? mine : 1u; nx = cnt > 0u ? cnt : 1u;
}

__device__ __forceinline__ void xcd_barrier(const XcdBarrier& b) {
    asm volatile("s_waitcnt vmcnt(0)" ::: "memory");
    __syncthreads();
    if (threadIdx.x == 0) {
        unsigned* bar = b.bar;
        __builtin_amdgcn_s_waitcnt(0);
        unsigned nloc = b.st[0], nx = b.st[1];
        if (nloc == 0u) { xcd_barrier_complete(bar, b.x, nloc, nx); b.st[0] = nloc; b.st[1] = nx; }
        const unsigned old = xb_add(&bar[XB_XSUB(b.x)], 1u);
        const unsigned gen = old / nloc;
        if (old + 1u == (gen + 1u) * nloc) {
            __builtin_amdgcn_fence(__ATOMIC_RELEASE, "agent");
            asm volatile("s_waitcnt vmcnt(0)" ::: "memory");
            const unsigned og = xb_add(&bar[XB_TOP], 1u);
            const unsigned tg = og / nx;
            if (og + 1u == (tg + 1u) * nx) xb_add(&bar[XB_TOPGEN], 1u);
            else XB_SPIN(xb_ld(&bar[XB_TOPGEN]) == tg, bar);
            __builtin_amdgcn_fence(__ATOMIC_ACQUIRE, "agent");
            xb_add(&bar[XB_XGEN(b.x)], 1u);
            asm volatile("s_waitcnt vmcnt(0)" ::: "memory");
        } else {
            XB_SPIN(xb_ld(&bar[XB_XGEN(b.x)]) == gen, bar);
            __builtin_amdgcn_fence(__ATOMIC_ACQUIRE, "agent");
            asm volatile("s_waitcnt vmcnt(0)" ::: "memory");
        }
    }
    __syncthreads();
}

#define GEMM_RUN(EPI, Aptr, Bptr, Mv, Nv, Kv, Eobj) GEMM_RUN2(EPI, Aptr, Bptr, Mv, Nv, Kv, Eobj, true, true)
#define GEMM_RUN2(EPI, Aptr, Bptr, Mv, Nv, Kv, Eobj, ALIGNV, SP2V) do { pg8::Gemm g_{(const pg8::bf16_t*)(Aptr), (const pg8::bf16_t*)(Bptr), (Mv), (Nv), (Kv)}; pg8::StaticOrder S_; S_.init((Mv), (Nv), (int)gridDim.x, (int)blockIdx.x); \
    pg8::gemm_phase<EPI, pg8::StaticOrder, ALIGNV, SP2V>(lds, g_, S_, Eobj); } while (0)

__global__ void __launch_bounds__(NTHREADS, 2) mk_fwd(Args a) {
    __shared__ __attribute__((aligned(16))) unsigned char lds_raw[LDS_BYTES];
    LAS unsigned char* lds = (LAS unsigned char*)lds_raw;
    cg::grid_group grid = cg::this_grid();
#define FRESH int tid = threadIdx.x; asm volatile("" : "+v"(tid)); const int lane = tid & 63, wave = __builtin_amdgcn_readfirstlane(tid >> 6); const int G = gridDim.x, gw = blockIdx.x * NWAVES + wave, NGW = G * NWAVES; (void)lane; (void)gw; (void)NGW; (void)G
    unsigned* ctl = (unsigned*)(a.ws + WS_CTL);
    unsigned* barw = ctl + 4096;
    volatile LAS unsigned* bst = (volatile LAS unsigned*)(lds + LDS_MISC + 64);
    if (threadIdx.x < 2) bst[threadIdx.x] = 0u;
    __syncthreads();
    if (a.out == nullptr) grid.sync();
    const XcdBarrier xbar = xcd_barrier_post(barw, bst);
#define GSYNC() xcd_barrier(xbar)
    bf16* H = (bf16*)(a.ws + WS_H); bf16* QKV = (bf16*)(a.ws + WS_QKV); bf16* MIX = (bf16*)(a.ws + WS_MIX); bf16* UV = (bf16*)(a.ws + WS_UV); bf16* ACT = (bf16*)(a.ws + WS_ACT); bf16* XB = (bf16*)(a.ws + WS_XB);
    float* FF = (float*)(a.ws + WS_FF); float* CUM = (float*)(a.ws + WS_CUM);
    { FRESH; phase_weights(a, lds, gw, NGW, wave, lane); }
    for (int l = 0; l < DEPTH; ++l) {
        if (l == 0) { FRESH; phase_norm<1, false>(a.in[0], a.in[1] + (size_t)l * DM, H, nullptr, a.in[2] + (size_t)l * DM * NIN_SRC, a.in[3] + l * 4, FF, lds, gw, NGW, tid, lane); }
        else { FRESH; phase_norm<1, true>(XB, a.in[1] + (size_t)l * DM, H, nullptr, a.in[2] + (size_t)l * DM * NIN_SRC, a.in[3] + l * 4, FF, lds, gw, NGW, tid, lane); }
        GSYNC();
        { FRESH; if (blockIdx.x < 64 && wave == 0) cumsum_seq(FF, CUM, blockIdx.x, lane); }
        { pg8::EpiBf16 E{(pg8::bf16_t*)QKV, NQKV}; GEMM_RUN(pg8::EpiBf16, H, a.ws + WS_WIN + l * SZ_WIN, MTOK, NQKV, DM, E); }
        GSYNC();
        { FRESH; phase_attn(a, l, ctl + 64 * l, lds, tid, wave, lane); }
        GSYNC();
        if (l == 0) { pg8::EpiResB<true> E{a.in[0], (pg8::bf16_t*)XB, DM}; GEMM_RUN(pg8::EpiResB<true>, MIX, a.ws + WS_WOUT + l * SZ_WOUT, MTOK, DM, MIXW, E); }
        else { pg8::EpiResB<false> E{XB, (pg8::bf16_t*)XB, DM}; GEMM_RUN(pg8::EpiResB<false>, MIX, a.ws + WS_WOUT + l * SZ_WOUT, MTOK, DM, MIXW, E); }
        GSYNC();
        { FRESH; phase_norm<0, true>(XB, a.in[8] + (size_t)l * DM, H, nullptr, nullptr, nullptr, nullptr, lds, gw, NGW, tid, lane); }
        GSYNC();
        { pg8::EpiConv E{(pg8::bf16_t*)ACT, (pg8::bf16_t*)UV, a.in[10] + (size_t)l * 3 * NFF2, a.in[11] + (size_t)l * NFF2}; GEMM_RUN(pg8::EpiConv, H, a.ws + WS_WFI + l * SZ_WFI, MTOK, NFF2, DM, E); }
        GSYNC();
        { FRESH; phase_fixup(UV, ACT, a.in[10] + (size_t)l * 3 * NFF2, a.in[11] + (size_t)l * NFF2, blockIdx.x * NTHREADS + tid, G * NTHREADS); }
        GSYNC();
        { pg8::EpiResB<false> E{XB, (pg8::bf16_t*)XB, DM}; GEMM_RUN(pg8::EpiResB<false>, ACT, a.ws + WS_WFO + l * SZ_WFO, MTOK, DM, DFF, E); }
        GSYNC();
    }
    { FRESH; phase_norm<2, true>(XB, a.in[13], nullptr, a.out, nullptr, nullptr, nullptr, lds, gw, NGW, tid, lane); }
}

extern "C" void kernel_launch(void* const* d_in, const int* in_sizes, int n_in, void* d_out, int out_size, void* d_ws, size_t ws_size, hipStream_t stream) {
    static int grid_blocks = 0;
    if (grid_blocks == 0) {
        if (n_in != 14 || out_size != MTOK * DM || ws_size < WS_END || in_sizes[2] != DEPTH * DM * NIN_SRC || in_sizes[7] != DEPTH * MIXW * DM || in_sizes[9] != DEPTH * DM * NFF2 || in_sizes[12] != DEPTH * DFF * DM || in_sizes[6] != DEPTH * 4 * 192 || in_sizes[5] != DEPTH * 128) { fprintf(stderr, "kernel_launch: unexpected sizes n_in %d out %d ws %zu\n", n_in, out_size, ws_size); grid_blocks = -1; return; }
        int dev = 0, cus = 0, per_cu = 0;
        (void)hipGetDevice(&dev);
        (void)hipDeviceGetAttribute(&cus, hipDeviceAttributeMultiprocessorCount, dev);
        (void)hipOccupancyMaxActiveBlocksPerMultiprocessor(&per_cu, (const void*)mk_fwd, NTHREADS, 0);
        if (per_cu < 1) { fprintf(stderr, "kernel_launch: occupancy query says %d blocks/CU\n", per_cu); per_cu = 1; }
        (void)hipGetLastError();
        grid_blocks = cus * 1;
        fprintf(stderr, "kernel_launch: cus %d per_cu %d grid %d\n", cus, per_cu, grid_blocks);
    }
    if (grid_blocks < 0) return;
    if (hipMemsetAsync((char*)d_ws + WS_CTL, 0, 65536, stream) != hipSuccess) { fprintf(stderr, "kernel_launch: memset of control words failed\n"); return; }
    Args a{};
    for (int i = 0; i < 14; ++i) a.in[i] = (const float*)d_in[i];
    a.out = (float*)d_out; a.ws = (unsigned char*)d_ws;
    void* args[] = {&a};
    hipError_t e = hipLaunchCooperativeKernel((const void*)mk_fwd, dim3(grid_blocks), dim3(NTHREADS), args, 0, stream);
    if (e != hipSuccess) fprintf(stderr, "cooperative launch failed: %s (grid %d)\n", hipGetErrorString(e), grid_blocks);
}
```

```cpp
#include <hip/hip_runtime.h>
#include <cstdio>
#include <cstdint>
#include <hip/hip_cooperative_groups.h>
namespace cg = cooperative_groups;
namespace pg8 {
#define PG8_LAS __attribute__((address_space(3)))
typedef unsigned short bf16_t;
typedef short bf16x8 __attribute__((ext_vector_type(8)));
typedef float f32x4 __attribute__((ext_vector_type(4)));
typedef unsigned u32x4 __attribute__((ext_vector_type(4)));
constexpr int BM = 256, BK = 64, HALF = 128, HTB = HALF * BK * 2  , STAGE_BYTES = 8 * HTB, NXCD = 8, WGM = 8;

__host__ __device__ __forceinline__ int lds_byte(int r, int c) { const int st = (r >> 4) * 2 + (c >> 5), rr = r & 15, cc = c & 31, ob = rr * 64 + cc * 2; return st * 1024 + (ob ^ (((ob >> 9) & 1) << 5)); }
__host__ __device__ __forceinline__ void stage_rc(int b, int& R, int& C) { const int st = b / 1024, sb = b % 1024, swz = sb ^ (((sb >> 9) & 1) << 5); R = (st >> 1) * 16 + swz / 64; C = (st & 1) * 32 + (swz % 64) / 2; }
__host__ __device__ __forceinline__ int perm32(int rho) { const int n = rho >> 4, i = rho & 15; return 8 * (i >> 2) + 4 * n + (i & 3); }

struct Unit { int pm, pn; };
struct Gemm { const bf16_t* A; const bf16_t* Bt; int M, N, K; };

struct StaticOrder {
    int nM, nN, nwg, G, c;
    __host__ __device__ void init(int M, int N, int G_, int c_) { nM = M / BM; nN = N / BM; nwg = nM * nN; G = G_; c = c_; }
    __host__ __device__ bool next(int i, Unit& u) const {
        const long L = (long)i * G + c; if (L >= nwg) return false;
        int wgid = (int)L; { const int q = nwg / NXCD, r = nwg % NXCD, xcd = wgid % NXCD, off = wgid / NXCD; wgid = (xcd < r ? xcd * (q + 1) : r * (q + 1) + (xcd - r) * q) + off; }
        const int nig = WGM * nN, gid = wgid / nig, fm = gid * WGM, gsz = (nM - fm) < WGM ? (nM - fm) : WGM;
        u.pm = fm + ((wgid % nig) % gsz); u.pn = (wgid % nig) / gsz; return true;
    }
    __device__ __forceinline__ void a_ready(const Unit&) const {}
    __device__ __forceinline__ void done(const Unit&) const {}
};

typedef float f32x2c __attribute__((ext_vector_type(2))); typedef __bf16 bf16x2c __attribute__((ext_vector_type(2)));
__device__ __forceinline__ unsigned cvt_pk_bf16(float lo, float hi) { f32x2c v = {lo, hi}; bf16x2c b = __builtin_convertvector(v, bf16x2c); return __builtin_bit_cast(unsigned, b); }
typedef float f32x2 __attribute__((ext_vector_type(2)));
struct EpiBf16 {
    static constexpr bool PERM = true, AFTER_DRAIN = false, APERM = false;
    bf16_t* O; int ldc;
    __device__ __forceinline__ void operator()(const f32x4 (&acc)[2][2][4][2], const Unit& u, int wr, int wc, int fr, int fq) const {
        const int row0 = u.pm * BM + wr * 64 + fr; const int col0 = u.pn * BM + wc * 32 + 8 * fq;
#pragma unroll
        for (int ai = 0; ai < 2; ++ai)
#pragma unroll
            for (int m = 0; m < 4; ++m) { bf16_t* rowp = O + (size_t)(row0 + ai * HALF + m * 16) * ldc + col0;
#pragma unroll
                for (int bj = 0; bj < 2; ++bj) { const f32x4 v0 = acc[ai][bj][m][0], v1 = acc[ai][bj][m][1];
                    u32x4 w; w.x = cvt_pk_bf16(v0[0], v0[1]); w.y = cvt_pk_bf16(v0[2], v0[3]); w.z = cvt_pk_bf16(v1[0], v1[1]); w.w = cvt_pk_bf16(v1[2], v1[3]);
                    *(u32x4*)(rowp + bj * HALF) = w; } }
    }
};
struct EpiRes {
    static constexpr bool PERM = false, AFTER_DRAIN = false, APERM = false;
    const float* base; float* out; int ldc; float scale;
    __device__ __forceinline__ void operator()(const f32x4 (&acc)[2][2][4][2], const Unit& u, int wr, int wc, int fr, int fq) const {
        const int col0 = u.pn * BM + wc * 32 + 4 * fq;
#pragma unroll
        for (int ai = 0; ai < 2; ++ai)
#pragma unroll
            for (int m = 0; m < 4; ++m) { const size_t off = (size_t)(u.pm * BM + ai * HALF + wr * 64 + m * 16 + fr) * ldc + col0;
#pragma unroll
                for (int bj = 0; bj < 2; ++bj)
#pragma unroll
                    for (int n = 0; n < 2; ++n) { const f32x4 bs = *(const f32x4*)(base + off + bj * HALF + n * 16); *(f32x4*)(out + off + bj * HALF + n * 16) = bs + acc[ai][bj][m][n] * scale; } }
    }
};

__device__ __forceinline__ f32x4 dpp_shr1(f32x4 v) { f32x4 r;
#pragma unroll
    for (int i = 0; i < 4; ++i) r[i] = __shfl_up(v[i], 1, 16);
    return r; }
__device__ __forceinline__ f32x4 silu_mul(f32x4 yu, f32x4 yg) { f32x4 o;
#pragma unroll
    for (int i = 0; i < 4; ++i) o[i] = yu[i] * yg[i] * __builtin_amdgcn_rcpf(1.0f + __builtin_amdgcn_exp2f(-1.4426950408889634f * yg[i]));
    return o; }
struct EpiConv {
    static constexpr bool PERM = false, AFTER_DRAIN = false, APERM = true;
    bf16_t* act; bf16_t* halo; const float* cw; const float* cb;
    __device__ __forceinline__ void operator()(const f32x4 (&acc)[2][2][4][2], const Unit& u, int wr, int wc, int fr, int fq) const {
        constexpr int DFFc = 2816, N2 = 5632;
        typedef unsigned u32x2e __attribute__((ext_vector_type(2)));
#pragma unroll
        for (int n = 0; n < 2; ++n) {
            const int cu = u.pn * 128 + wc * 32 + n * 16 + 4 * fq, cg = DFFc + cu;
            const f32x4 w0u = *(const f32x4*)(cw + cu), w1u = *(const f32x4*)(cw + N2 + cu), w2u = *(const f32x4*)(cw + 2 * N2 + cu), bu = *(const f32x4*)(cb + cu);
            const f32x4 w0g = *(const f32x4*)(cw + cg), w1g = *(const f32x4*)(cw + N2 + cg), w2g = *(const f32x4*)(cw + 2 * N2 + cg), bg = *(const f32x4*)(cb + cg);
#pragma unroll
            for (int ai = 0; ai < 2; ++ai) {
                const f32x4 U0 = acc[ai][0][0][n], U1 = acc[ai][0][1][n], U2 = acc[ai][0][2][n], U3 = acc[ai][0][3][n];
                const f32x4 G0 = acc[ai][1][0][n], G1 = acc[ai][1][1][n], G2 = acc[ai][1][2][n], G3 = acc[ai][1][3][n];
                const f32x4 Um1 = dpp_shr1(U3), Um2 = dpp_shr1(U2), Gm1 = dpp_shr1(G3), Gm2 = dpp_shr1(G2);
                const int row0 = u.pm * BM + ai * HALF + wr * 64 + 4 * fr;
                f32x4 o[4];
                o[0] = silu_mul(bu + w0u * Um2 + w1u * Um1 + w2u * U0, bg + w0g * Gm2 + w1g * Gm1 + w2g * G0);
                o[1] = silu_mul(bu + w0u * Um1 + w1u * U0 + w2u * U1, bg + w0g * Gm1 + w1g * G0 + w2g * G1);
                o[2] = silu_mul(bu + w0u * U0 + w1u * U1 + w2u * U2, bg + w0g * G0 + w1g * G1 + w2g * G2);
                o[3] = silu_mul(bu + w0u * U1 + w1u * U2 + w2u * U3, bg + w0g * G1 + w1g * G2 + w2g * G3);
#pragma unroll
                for (int m = 0; m < 4; ++m) if (fr != 0 || m >= 2) { u32x2e w; w.x = cvt_pk_bf16(o[m][0], o[m][1]); w.y = cvt_pk_bf16(o[m][2], o[m][3]);
                    *(u32x2e*)(act + (size_t)(row0 + m) * DFFc + cu) = w; }
                if (fr == 0 || fr == 15) { bf16_t* hp = halo + ((size_t)(row0 >> 6) * 4 + (fr == 0 ? 0 : 2)) * N2;
                    const f32x4 ua = fr == 0 ? U0 : U2, ub = fr == 0 ? U1 : U3, ga = fr == 0 ? G0 : G2, gb = fr == 0 ? G1 : G3;
                    u32x2e w; w.x = cvt_pk_bf16(ua[0], ua[1]); w.y = cvt_pk_bf16(ua[2], ua[3]); *(u32x2e*)(hp + cu) = w;
                    w.x = cvt_pk_bf16(ub[0], ub[1]); w.y = cvt_pk_bf16(ub[2], ub[3]); *(u32x2e*)(hp + N2 + cu) = w;
                    w.x = cvt_pk_bf16(ga[0], ga[1]); w.y = cvt_pk_bf16(ga[2], ga[3]); *(u32x2e*)(hp + cg) = w;
                    w.x = cvt_pk_bf16(gb[0], gb[1]); w.y = cvt_pk_bf16(gb[2], gb[3]); *(u32x2e*)(hp + N2 + cg) = w; }
            }
        }
    }
};

template <bool BASE_F32> struct EpiResB {
    static constexpr bool PERM = true, AFTER_DRAIN = false, APERM = false;
    const void* base; bf16_t* out; int ldc;
    __device__ __forceinline__ void operator()(const f32x4 (&acc)[2][2][4][2], const Unit& u, int wr, int wc, int fr, int fq) const {
        const int col0 = u.pn * BM + wc * 32 + 8 * fq;
#pragma unroll
        for (int ai = 0; ai < 2; ++ai)
#pragma unroll
            for (int m = 0; m < 4; ++m) { const size_t off = (size_t)(u.pm * BM + ai * HALF + wr * 64 + m * 16 + fr) * ldc + col0;
#pragma unroll
                for (int bj = 0; bj < 2; ++bj) { f32x4 b0, b1;
                    if (BASE_F32) { b0 = *(const f32x4*)((const float*)base + off + bj * HALF); b1 = *(const f32x4*)((const float*)base + off + bj * HALF + 4); }
                    else { const u32x4 r = *(const u32x4*)((const bf16_t*)base + off + bj * HALF);
                        b0[0] = __uint_as_float(r.x << 16); b0[1] = __uint_as_float(r.x & 0xffff0000u); b0[2] = __uint_as_float(r.y << 16); b0[3] = __uint_as_float(r.y & 0xffff0000u);
                        b1[0] = __uint_as_float(r.z << 16); b1[1] = __uint_as_float(r.z & 0xffff0000u); b1[2] = __uint_as_float(r.w << 16); b1[3] = __uint_as_float(r.w & 0xffff0000u); }
                    const f32x4 o0 = b0 + acc[ai][bj][m][0], o1 = b1 + acc[ai][bj][m][1];
                    u32x4 w; w.x = cvt_pk_bf16(o0[0], o0[1]); w.y = cvt_pk_bf16(o0[2], o0[3]); w.z = cvt_pk_bf16(o1[0], o1[1]); w.w = cvt_pk_bf16(o1[2], o1[3]);
                    *(u32x4*)(out + off + bj * HALF) = w; } }
    }
};

struct EpiBf16S {
    static constexpr bool PERM = true, AFTER_DRAIN = false, APERM = false;
    bf16_t* O; int ldc; const float* rs;
    __device__ __forceinline__ void operator()(const f32x4 (&acc)[2][2][4][2], const Unit& u, int wr, int wc, int fr, int fq) const {
        const int row0 = u.pm * BM + wr * 64 + fr; const int col0 = u.pn * BM + wc * 32 + 8 * fq;
#pragma unroll
        for (int ai = 0; ai < 2; ++ai)
#pragma unroll
            for (int m = 0; m < 4; ++m) { const int row = row0 + ai * HALF + m * 16; const float s = rs[row]; bf16_t* rowp = O + (size_t)row * ldc + col0;
#pragma unroll
                for (int bj = 0; bj < 2; ++bj) { const f32x4 v0 = acc[ai][bj][m][0] * s, v1 = acc[ai][bj][m][1] * s;
                    u32x4 w; w.x = cvt_pk_bf16(v0[0], v0[1]); w.y = cvt_pk_bf16(v0[2], v0[3]); w.z = cvt_pk_bf16(v1[0], v1[1]); w.w = cvt_pk_bf16(v1[2], v1[3]);
                    *(u32x4*)(rowp + bj * HALF) = w; } }
    }
};
template <class Epi, class Sched, bool ALIGN_EPI = false, bool SP2 = false>
__device__ __forceinline__ void gemm_phase(PG8_LAS unsigned char* lds, const Gemm g, const Sched& S, const Epi& E) {
    int tid_l = threadIdx.x; asm volatile("" : "+v"(tid_l)); const int tid = tid_l, wid = __builtin_amdgcn_readfirstlane(tid >> 6), lane = tid & 63, wr = wid >> 2, wc = wid & 3, fr = lane & 15, fq = lane >> 4;
    const int K = g.K, nt = K / BK;
    unsigned voffA[2], voffB[2];
#pragma unroll
    for (int i = 0; i < 2; ++i) { int R, C; stage_rc(tid * 16 + i * 8192, R, C); const int Rb = Epi::PERM ? ((R & ~31) + perm32(R & 31)) : R;
        const int Ra = Epi::APERM ? ((R & 64) + (R & 15) * 4 + ((R >> 4) & 3)) : R; voffA[i] = (unsigned)(Ra * K + C) * 2u; voffB[i] = (unsigned)(Rb * K + C) * 2u; }
    const size_t kstep = (size_t)(BK * 2);
    const size_t hstep = (size_t)HALF * K * 2;
    const size_t tstep = 2 * hstep;
    const unsigned ldsw = (unsigned)wid * 1024u;
    const int aoff = lds_byte(wr * 64 + fr, fq * 8), boff = lds_byte(wc * 32 + fr, fq * 8);
#define PG8_SA(b, h) (((b) * 2 + (h)) * HTB)
#define PG8_SB(b, h) ((4 + (b) * 2 + (h)) * HTB)
#define PG8_STAGE(bufoff, gbase, voff) do { _Pragma("unroll") for (int _i = 0; _i < 2; ++_i) \
        __builtin_amdgcn_global_load_lds((const unsigned*)((const char*)(gbase) + (voff)[_i]), (PG8_LAS unsigned*)(lds + (bufoff) + ldsw + _i * 8192), 16, 0, 0); } while (0)
#define PG8_LDA(dst, b, h) do { _Pragma("unroll") for (int m = 0; m < 4; ++m) _Pragma("unroll") for (int k = 0; k < 2; ++k) dst[m][k] = *(const PG8_LAS bf16x8*)(lds + PG8_SA(b, h) + aoff + m * 2048 + k * 1024); } while (0)
#define PG8_LDB(dst, b, h) do { _Pragma("unroll") for (int n = 0; n < 2; ++n) _Pragma("unroll") for (int k = 0; k < 2; ++k) dst[n][k] = *(const PG8_LAS bf16x8*)(lds + PG8_SB(b, h) + boff + n * 2048 + k * 1024); } while (0)
#define PG8_MMA(ai, bj, At, Bt) do { __builtin_amdgcn_s_setprio(1); _Pragma("unroll") for (int m = 0; m < 4; ++m) _Pragma("unroll") for (int n = 0; n < 2; ++n) _Pragma("unroll") for (int k = 0; k < 2; ++k) \
        acc[ai][bj][m][n] = __builtin_amdgcn_mfma_f32_16x16x32_bf16(Bt[n][k], At[m][k], acc[ai][bj][m][n], 0, 0, 0); __builtin_amdgcn_s_setprio(0); } while (0)
#define PG8_WAIT_V(n) asm volatile("s_waitcnt vmcnt(" #n ")" ::: "memory")
#define PG8_WAIT_L(n) asm volatile("s_waitcnt lgkmcnt(" #n ")" ::: "memory")
#define PG8_BAR __builtin_amdgcn_s_barrier()
#define PG8_SCHED __builtin_amdgcn_sched_barrier(0)
    Unit cur, nxt; int ui = 0;
    if (!S.next(0, cur)) return;
    f32x4 acc[2][2][4][2];
#pragma unroll
    for (int a = 0; a < 2; ++a)
#pragma unroll
        for (int b = 0; b < 2; ++b)
#pragma unroll
            for (int m = 0; m < 4; ++m)
#pragma unroll
                for (int n = 0; n < 2; ++n) acc[a][b][m][n] = (f32x4){0.f, 0.f, 0.f, 0.f};
    bf16x8 At[4][2], B0[2][2], B1[2][2];
    const char* cA = (const char*)g.A + (size_t)cur.pm * tstep; const char* cB = (const char*)g.Bt + (size_t)cur.pn * tstep;
    S.a_ready(cur);
    if constexpr (SP2) {
        PG8_STAGE(PG8_SB(0, 0), cB, voffB); PG8_STAGE(PG8_SB(0, 1), cB + hstep, voffB); PG8_STAGE(PG8_SA(0, 0), cA, voffA); PG8_STAGE(PG8_SA(0, 1), cA + hstep, voffA);
        if (wr == 1) PG8_BAR;
        PG8_WAIT_V(2); PG8_BAR;
        PG8_STAGE(PG8_SB(1, 0), cB + kstep, voffB); PG8_STAGE(PG8_SA(1, 0), cA + kstep, voffA); PG8_STAGE(PG8_SB(1, 1), cB + hstep + kstep, voffB);
        PG8_WAIT_V(6); PG8_BAR;
    } else {
        PG8_STAGE(PG8_SB(0, 0), cB, voffB); PG8_STAGE(PG8_SA(0, 0), cA, voffA); PG8_STAGE(PG8_SB(0, 1), cB + hstep, voffB); PG8_STAGE(PG8_SA(0, 1), cA + hstep, voffA);
        if (wr == 1) PG8_BAR;
        PG8_WAIT_V(4); PG8_BAR;
        PG8_STAGE(PG8_SB(1, 0), cB + kstep, voffB); PG8_STAGE(PG8_SA(1, 0), cA + kstep, voffA); PG8_STAGE(PG8_SB(1, 1), cB + hstep + kstep, voffB);
        PG8_WAIT_V(6); PG8_BAR;
    }
    for (;;) {
        const bool has_next = S.next(ui + 1, nxt);
        const char* nA = has_next ? (const char*)g.A + (size_t)nxt.pm * tstep : cA; const char* nB = has_next ? (const char*)g.Bt + (size_t)nxt.pn * tstep : cB;
        for (int t = 0; t < nt; t += 2) {
            const bool last = (t == nt - 2);
            const char* a1 = cA + (size_t)(t + 1) * kstep;
            const char* a2 = last ? nA : cA + (size_t)(t + 2) * kstep; const char* b2 = last ? nB : cB + (size_t)(t + 2) * kstep;
            const char* a3 = a2 + kstep; const char* b3 = b2 + kstep;
            if (last && has_next) S.a_ready(nxt);
            if constexpr (SP2) {
            PG8_LDB(B0, 0, 0); PG8_LDB(B1, 0, 1); PG8_SCHED; PG8_LDA(At, 0, 0); PG8_STAGE(PG8_SA(1, 1), a1 + hstep, voffA);
            PG8_WAIT_V(8); PG8_WAIT_L(0); PG8_BAR; PG8_MMA(0, 0, At, B0); PG8_MMA(0, 1, At, B1); PG8_BAR; PG8_SCHED;
            PG8_LDA(At, 0, 1); PG8_STAGE(PG8_SB(0, 0), b2, voffB); PG8_STAGE(PG8_SB(0, 1), b2 + hstep, voffB); PG8_STAGE(PG8_SA(0, 0), a2, voffA);
            PG8_WAIT_V(8); PG8_WAIT_L(0); PG8_BAR; PG8_MMA(1, 0, At, B0); PG8_MMA(1, 1, At, B1); PG8_BAR; PG8_SCHED;
            PG8_LDB(B0, 1, 0); PG8_LDB(B1, 1, 1); PG8_SCHED; PG8_LDA(At, 1, 0); PG8_STAGE(PG8_SA(0, 1), a2 + hstep, voffA);
            PG8_WAIT_V(8); PG8_WAIT_L(0); PG8_BAR; PG8_MMA(0, 0, At, B0); PG8_MMA(0, 1, At, B1); PG8_BAR; PG8_SCHED;
            PG8_LDA(At, 1, 1); PG8_STAGE(PG8_SB(1, 0), b3, voffB); PG8_STAGE(PG8_SB(1, 1), b3 + hstep, voffB); PG8_STAGE(PG8_SA(1, 0), a3, voffA);
            PG8_WAIT_V(8); PG8_WAIT_L(0); PG8_BAR; PG8_MMA(1, 0, At, B0); PG8_MMA(1, 1, At, B1); PG8_BAR; PG8_SCHED;
            } else {
            PG8_LDB(B0, 0, 0); PG8_SCHED; PG8_LDA(At, 0, 0); PG8_STAGE(PG8_SA(1, 1), a1 + hstep, voffA);
            PG8_WAIT_L(8); PG8_BAR; PG8_WAIT_L(0); PG8_MMA(0, 0, At, B0); PG8_BAR; PG8_SCHED;
            PG8_LDB(B1, 0, 1); PG8_STAGE(PG8_SB(0, 0), b2, voffB);
            PG8_BAR; PG8_WAIT_L(0); PG8_MMA(0, 1, At, B1); PG8_BAR;
            PG8_LDA(At, 0, 1); PG8_STAGE(PG8_SA(0, 0), a2, voffA);
            PG8_BAR; PG8_WAIT_L(0); PG8_MMA(1, 0, At, B0); PG8_BAR; PG8_SCHED;
            PG8_STAGE(PG8_SB(0, 1), b2 + hstep, voffB);
            PG8_WAIT_V(6); PG8_BAR; PG8_MMA(1, 1, At, B1); PG8_BAR;
            PG8_LDB(B0, 1, 0); PG8_SCHED; PG8_LDA(At, 1, 0); PG8_STAGE(PG8_SA(0, 1), a2 + hstep, voffA);
            PG8_WAIT_L(8); PG8_BAR; PG8_WAIT_L(0); PG8_MMA(0, 0, At, B0); PG8_BAR; PG8_SCHED;
            PG8_LDB(B1, 1, 1); PG8_STAGE(PG8_SB(1, 0), b3, voffB);
            PG8_BAR; PG8_WAIT_L(0); PG8_MMA(0, 1, At, B1); PG8_BAR;
            PG8_LDA(At, 1, 1); PG8_STAGE(PG8_SA(1, 0), a3, voffA);
            PG8_BAR; PG8_WAIT_L(0); PG8_MMA(1, 0, At, B0); PG8_BAR; PG8_SCHED;
            PG8_STAGE(PG8_SB(1, 1), b3 + hstep, voffB);
            PG8_WAIT_V(6); PG8_BAR; PG8_MMA(1, 1, At, B1); PG8_BAR;
            }
        }
        if constexpr (ALIGN_EPI) { if (wr == 0) PG8_BAR; }
        if constexpr (!Epi::AFTER_DRAIN) { E(acc, cur, wr, wc, fr, fq); S.done(cur); }
        if (!has_next) break;
#pragma unroll
        for (int a = 0; a < 2; ++a)
#pragma unroll
            for (int b = 0; b < 2; ++b)
#pragma unroll
                for (int m = 0; m < 4; ++m)
#pragma unroll
                    for (int n = 0; n < 2; ++n) acc[a][b][m][n] = (f32x4){0.f, 0.f, 0.f, 0.f};
        cur = nxt; cA = nA; cB = nB; ++ui;
        if constexpr (ALIGN_EPI) { if (wr == 1) PG8_BAR; }
    }
    PG8_WAIT_V(0);
    if constexpr (!ALIGN_EPI) { if (wr == 0) PG8_BAR; }
    PG8_BAR;
    if constexpr (Epi::AFTER_DRAIN) { E.fused(acc, cur, wr, wc, fr, fq, lds, wid, lane); S.done(cur); }
#undef PG8_SA
#undef PG8_SB
#undef PG8_STAGE
#undef PG8_LDA
#undef PG8_LDB
#undef PG8_MMA
#undef PG8_WAIT_V
#undef PG8_WAIT_L
#undef PG8_BAR
#undef PG8_SCHED
}
}
#define LAS __attribute__((address_space(3)))
typedef unsigned short bf16;
typedef short bf16x8 __attribute__((ext_vector_type(8)));
typedef short s16x4 __attribute__((ext_vector_type(4)));
typedef float f32x16 __attribute__((ext_vector_type(16)));
typedef float f32x4 __attribute__((ext_vector_type(4)));
typedef unsigned u32x4 __attribute__((ext_vector_type(4)));
typedef unsigned u32x2 __attribute__((ext_vector_type(2)));

constexpr int DM = 1024, BATCH = 16, SEQ = 2048, MTOK = BATCH * SEQ, DEPTH = 2;
constexpr int NIN_SRC = 2308, NQKV = 2304, MIXW = 768, DFF = 2816, NFF2 = 5632;
constexpr float RMS_EPS = 1e-6f, L2E = 1.4426950408889634f, QSCALE = 0.125f * 1.4426950408889634f;
constexpr int C_FQ = 0, C_FK = 256, C_FV = 512, C_DQ = 768, C_DK = 1024, C_DV = 1280, C_CQ = 1536, C_CK = 1792, C_CV = 2048;
constexpr int MX_FOX = 0, MX_DIFF = 256, MX_CHK = 512;
constexpr int NTHREADS = 512, NWAVES = 8;
constexpr size_t MiB = 1u << 20;
constexpr size_t WS_CTL = 0, WS_FF = 1 * MiB, WS_CUM = 1 * MiB + 512 * 1024;
constexpr size_t WS_WIN = 2 * MiB, WS_WOUT = 14 * MiB, WS_WFI = 18 * MiB, WS_WFO = 40 * MiB;
constexpr size_t SZ_WIN = 6 * MiB, SZ_WOUT = 2 * MiB, SZ_WFI = 11 * MiB, SZ_WFO = (size_t)DM * DFF * 2;
constexpr size_t WS_H = 52 * MiB, WS_QKV = 116 * MiB, WS_MIX = 308 * MiB, WS_UV = 116 * MiB, WS_ACT = 260 * MiB, WS_XB = 436 * MiB, WS_END = 500 * MiB;
static_assert(WS_WFO + 2 * SZ_WFO <= WS_H, "ws map");
constexpr int HALF_M = MTOK / 2;
constexpr int LDS_RING = 131072, LDS_WF = 131072, LDS_MISC = 147456, LDS_TAB = 147456 + 256, LDS_BYTES = 155648;

typedef float f32x2_t __attribute__((ext_vector_type(2))); typedef __bf16 bf16x2_t __attribute__((ext_vector_type(2)));
__device__ __forceinline__ unsigned cvtpk(float lo, float hi) { f32x2_t v = {lo, hi}; bf16x2_t b = __builtin_convertvector(v, bf16x2_t); return __builtin_bit_cast(unsigned, b); }
__device__ __forceinline__ float bf2f(unsigned short v) { return __uint_as_float((unsigned)v << 16); }
__device__ __forceinline__ float wave_sum(float v) {
#pragma unroll
    for (int o = 1; o < 64; o <<= 1) v += __shfl_xor(v, o);
    return v;
}
__device__ __forceinline__ float ex2(float v) { return __builtin_amdgcn_exp2f(v); }

struct Args { const float* in[14]; float* out; unsigned char* ws; };
struct WMeta { bf16* dst; int K; float scale; const float* gk; };
constexpr int W_I_IN = 16 * 72, W_I_OUT = 12 * 32, W_I_FI = 16 * 176, W_I_FO = 44 * 32, W_I_L = W_I_IN + W_I_OUT + W_I_FI + W_I_FO;
__device__ __forceinline__ void witem_load(const Args& a, int it, int lane, float (&wv)[32], WMeta& mt) {
    const int l = it / W_I_L; int r = it % W_I_L;
    const float* W; int K, Nsrc, nblk, mode; bf16* WT;
    if (r < W_I_IN) { W = a.in[2] + (size_t)l * DM * NIN_SRC; K = DM; Nsrc = NIN_SRC; nblk = 72; WT = (bf16*)(a.ws + WS_WIN + l * SZ_WIN); mode = 1; }
    else if ((r -= W_I_IN) < W_I_OUT) { W = a.in[7] + (size_t)l * MIXW * DM; K = MIXW; Nsrc = DM; nblk = 32; WT = (bf16*)(a.ws + WS_WOUT + l * SZ_WOUT); mode = 0; }
    else if ((r -= W_I_OUT) < W_I_FI) { W = a.in[9] + (size_t)l * DM * NFF2; K = DM; Nsrc = NFF2; nblk = 176; WT = (bf16*)(a.ws + WS_WFI + l * SZ_WFI); mode = 2; }
    else { r -= W_I_FI; W = a.in[12] + (size_t)l * DFF * DM; K = DFF; Nsrc = DM; nblk = 32; WT = (bf16*)(a.ws + WS_WFO + l * SZ_WFO); mode = 0; }
    const int kb = r / nblk, nb = r % nblk, k0 = 64 * kb, n0 = 32 * nb;
    int sc0 = n0; float scale = 1.f;
    if (mode == 2) sc0 = (n0 >> 8) * 128 + (n0 & 127) + ((n0 & 128) ? DFF : 0);
    if (mode == 1) { sc0 = n0 + (n0 >= 768 ? 4 : 0);
        if ((n0 >= C_FQ && n0 < C_FK) || (n0 >= C_DQ && n0 < C_DK) || (n0 >= C_CQ && n0 < C_CK)) scale = QSCALE; }
    const float* src = W + (size_t)(k0 + (lane >> 5)) * Nsrc + sc0 + (lane & 31);
#pragma unroll
    for (int i = 0; i < 32; ++i) wv[i] = src[(size_t)(2 * i) * Nsrc];
    mt.dst = WT + (size_t)n0 * K + k0; mt.K = K; mt.scale = scale; mt.gk = (mode == 1) ? a.in[1] + (size_t)l * DM + k0 : nullptr;
}
__device__ __forceinline__ void witem_store(const WMeta& mt, const float (&wv)[32], LAS float* scr, int lane) {
#pragma unroll
    for (int i = 0; i < 32; ++i) { const int kk = 2 * i + (lane >> 5); scr[kk * 33 + (lane & 31)] = wv[i] * (mt.gk ? mt.scale * mt.gk[kk] : mt.scale); }
    asm volatile("s_waitcnt lgkmcnt(0)" ::: "memory");
    const int c = lane & 7;
#pragma unroll
    for (int j = 0; j < 4; ++j) { const int n = (lane >> 3) + 8 * j; const LAS float* s = scr + (8 * c) * 33 + n;
        u32x4 o; o.x = cvtpk(s[0 * 33], s[1 * 33]); o.y = cvtpk(s[2 * 33], s[3 * 33]); o.z = cvtpk(s[4 * 33], s[5 * 33]); o.w = cvtpk(s[6 * 33], s[7 * 33]);
        *(u32x4*)(mt.dst + (size_t)n * mt.K + 8 * c) = o; }
}
__device__ __forceinline__ void phase_weights(const Args& a, LAS unsigned char* lds, int gw, int NGW, int wave, int lane) {
    LAS float* scr = (LAS float*)(lds + wave * 16896);
    for (int it = gw; it < DEPTH * W_I_L; it += 2 * NGW) {
        float wa[32], wb[32]; WMeta ma, mb; const bool two = it + NGW < DEPTH * W_I_L;
        witem_load(a, it, lane, wa, ma);
        if (two) witem_load(a, it + NGW, lane, wb, mb);
        witem_store(ma, wa, scr, lane);
        if (two) witem_store(mb, wb, scr + 64 * 33, lane);
        asm volatile("s_waitcnt lgkmcnt(0)" ::: "memory");
    }
}

template <bool XBF> struct RowLd;
template <> struct RowLd<false> { typedef f32x4 raw; static __device__ __forceinline__ raw ld(const void* x, size_t m, int lane, int j) { return *((const f32x4*)((const float*)x + m * DM) + lane + 64 * j); }
    static __device__ __forceinline__ f32x4 cv(raw r) { return r; } };
template <> struct RowLd<true> { typedef u32x2 raw; static __device__ __forceinline__ raw ld(const void* x, size_t m, int lane, int j) { return *((const u32x2*)((const bf16*)x + m * DM) + lane + 64 * j); }
    static __device__ __forceinline__ f32x4 cv(raw r) { f32x4 v; v.x = __uint_as_float(r.x << 16); v.y = __uint_as_float(r.x & 0xffff0000u); v.z = __uint_as_float(r.y << 16); v.w = __uint_as_float(r.y & 0xffff0000u); return v; } };
template <int MODE, bool XBF>
__device__ __forceinline__ void phase_norm(const void* x, const float* g, bf16* H, float* outf, const float* w_in_l, const float* b_fox, float* FF,
                                           LAS unsigned char* lds, int gw, int NGW, int tid, int lane) {
    LAS f32x4* wf = (LAS f32x4*)(lds + LDS_WF);
    if (MODE == 1) {
        __syncthreads();
        for (int k = tid; k < DM; k += NTHREADS) wf[k] = *(const f32x4*)(w_in_l + (size_t)k * NIN_SRC + 768);
        __syncthreads();
    }
    f32x4 gv[4];
#pragma unroll
    for (int j = 0; j < 4; ++j) gv[j] = *((const f32x4*)g + lane + 64 * j);
    f32x4 v[4]; typename RowLd<XBF>::raw vn[4];
    if (gw < MTOK) {
#pragma unroll
        for (int j = 0; j < 4; ++j) vn[j] = RowLd<XBF>::ld(x, (size_t)gw, lane, j); }
    for (int m = gw; m < MTOK; m += NGW) {
        float s = 0.f;
#pragma unroll
        for (int j = 0; j < 4; ++j) v[j] = RowLd<XBF>::cv(vn[j]);
        if (m + NGW < MTOK) {
#pragma unroll
            for (int j = 0; j < 4; ++j) vn[j] = RowLd<XBF>::ld(x, (size_t)(m + NGW), lane, j); }
#pragma unroll
        for (int j = 0; j < 4; ++j) s += (v[j].x * v[j].x + v[j].y * v[j].y) + (v[j].z * v[j].z + v[j].w * v[j].w);
        const float rstd = 1.0f / sqrtf(wave_sum(s) * (1.f / DM) + RMS_EPS);
        if (MODE == 1) {
            if (!XBF) { u32x2* o = (u32x2*)(H + (size_t)m * DM) + lane;
#pragma unroll
                for (int j = 0; j < 4; ++j) { u32x2 w; w.x = cvtpk(v[j].x, v[j].y); w.y = cvtpk(v[j].z, v[j].w); o[64 * j] = w; } }
            if (lane == 0) outf[m] = rstd;
        }
#pragma unroll
        for (int j = 0; j < 4; ++j) v[j] = v[j] * rstd * gv[j];
        if (MODE == 2) {
            f32x4* o = (f32x4*)(outf + (size_t)m * DM) + lane;
#pragma unroll
            for (int j = 0; j < 4; ++j) o[64 * j] = v[j];
        } else if (MODE == 0) {
            u32x2* o = (u32x2*)(H + (size_t)m * DM) + lane;
#pragma unroll
            for (int j = 0; j < 4; ++j) { u32x2 w; w.x = cvtpk(v[j].x, v[j].y); w.y = cvtpk(v[j].z, v[j].w); o[64 * j] = w; }
        }
        if (MODE == 1) {
            f32x4 d = {0.f, 0.f, 0.f, 0.f};
#pragma unroll
            for (int j = 0; j < 4; ++j) { const int k = 4 * lane + 256 * j;
                d += wf[k] * v[j].x; d += wf[k + 1] * v[j].y; d += wf[k + 2] * v[j].z; d += wf[k + 3] * v[j].w; }
            d.x = wave_sum(d.x); d.y = wave_sum(d.y); d.z = wave_sum(d.z); d.w = wave_sum(d.w);
            if (lane < 4) { float z = (lane == 0 ? d.x : lane == 1 ? d.y : lane == 2 ? d.z : d.w) + b_fox[lane];
                const float ls = fminf(z, 0.f) - log1pf(expf(-fabsf(z)));
                FF[(size_t)m * 4 + lane] = ls; }
        }
    }
}

__device__ __forceinline__ void cumsum_seq(const float* FF, float* CUM, int bh, int lane) {
    const int b = bh >> 2, h = bh & 3;
    const float* src = FF + ((size_t)b * SEQ + 32 * lane) * 4 + h;
    float v[32]; float s = 0.f;
#pragma unroll
    for (int i = 0; i < 32; ++i) { s += src[4 * i]; v[i] = s; }
    float inc = s;
#pragma unroll
    for (int o = 1; o < 64; o <<= 1) { const float t = __shfl_up(inc, o); if (lane >= o) inc += t; }
    const float excl = inc - s;
    float* dst = CUM + (size_t)bh * SEQ + 32 * lane;
#pragma unroll
    for (int i = 0; i < 32; i += 4) { f32x4 w = {v[i] + excl, v[i + 1] + excl, v[i + 2] + excl, v[i + 3] + excl}; *(f32x4*)(dst + i) = w; }
}

__device__ __forceinline__ void unpack8(const u32x4 a, float (&f)[8]) {
#pragma unroll
    for (int i = 0; i < 4; ++i) { f[2 * i] = __uint_as_float(a[i] << 16); f[2 * i + 1] = __uint_as_float(a[i] & 0xffff0000u); } }
__device__ __forceinline__ void phase_fixup(const bf16* HALO, bf16* ACT, const float* cw, const float* cb, int gt, int NGT) {
    constexpr int NCG = DFF / 8, NG = MTOK / 64;
    for (int it = gt; it < NG * 2 * NCG; it += NGT) {
        const int cg8 = it % NCG, rs = it / NCG, s = rs & 1, j = rs >> 1, c0 = cg8 * 8;
        const bool first = ((j * 64) % SEQ) == 0;
        const bf16* hj = HALO + (size_t)j * 4 * NFF2; const bf16* hp = hj - 4 * NFF2;
        const bf16* pt = hj + (size_t)s * NFF2;
        const bf16* p1 = (s == 0) ? hp + 3 * NFF2 : hj;
        const bf16* p2 = (s == 0) ? hp + 2 * NFF2 : hp + 3 * NFF2;
        const u32x4 z = {0u, 0u, 0u, 0u};
        float ut[8], u1[8], u2[8], gt_[8], g1[8], g2[8];
        unpack8(*(const u32x4*)(pt + c0), ut); unpack8(*(const u32x4*)(pt + DFF + c0), gt_);
        unpack8((s == 0 && first) ? z : *(const u32x4*)(p1 + c0), u1); unpack8((s == 0 && first) ? z : *(const u32x4*)(p1 + DFF + c0), g1);
        unpack8(first ? z : *(const u32x4*)(p2 + c0), u2); unpack8(first ? z : *(const u32x4*)(p2 + DFF + c0), g2);
        float o[8];
#pragma unroll
        for (int i = 0; i < 8; ++i) { const int c = c0 + i;
            const float yu = cb[c] + cw[c] * u2[i] + cw[NFF2 + c] * u1[i] + cw[2 * NFF2 + c] * ut[i];
            const float yg = cb[DFF + c] + cw[DFF + c] * g2[i] + cw[NFF2 + DFF + c] * g1[i] + cw[2 * NFF2 + DFF + c] * gt_[i];
            o[i] = yu * yg / (1.f + __expf(-yg)); }
        u32x4 w; w.x = cvtpk(o[0], o[1]); w.y = cvtpk(o[2], o[3]); w.z = cvtpk(o[4], o[5]); w.w = cvtpk(o[6], o[7]);
        *(u32x4*)(ACT + (size_t)(j * 64 + s) * DFF + c0) = w;
    }
}
__device__ __forceinline__ s16x4 vtr(LAS const char* p) { typedef short v4i16_t __attribute__((ext_vector_type(4))); return __builtin_bit_cast(s16x4, __builtin_amdgcn_ds_read_tr16_b64_v4i16((LAS v4i16_t*)p)); }
constexpr int KROWB = 144, KT_BYTES = 64 * KROWB;

__device__ __forceinline__ void qk_tile(f32x16& p0, f32x16& p1, LAS const char* kt, const bf16x8 (&qr)[4], int r32, int hi) {
    LAS const char* kb = kt + r32 * KROWB + hi * 16;
#pragma unroll
    for (int ks = 0; ks < 4; ++ks) {
        const bf16x8 a0 = *(LAS const bf16x8*)(kb + ks * 32), a1 = *(LAS const bf16x8*)(kb + 32 * KROWB + ks * 32);
        p0 = __builtin_amdgcn_mfma_f32_32x32x16_bf16(a0, qr[ks], p0, 0, 0, 0);
        p1 = __builtin_amdgcn_mfma_f32_32x32x16_bf16(a1, qr[ks], p1, 0, 0, 0);
    }
}
template <int NDB>
__device__ __forceinline__ void softmax_pv(f32x16& p0, f32x16& p1, float& m, float& l, f32x16 (&o)[NDB], LAS const char* vt, int vb) {
    float mx = fmaxf(p0[0], p1[0]);
#pragma unroll
    for (int r = 1; r < 16; ++r) mx = fmaxf(mx, fmaxf(p0[r], p1[r]));
    mx = fmaxf(mx, __shfl_xor(mx, 32));
    if (__builtin_amdgcn_ballot_w64(mx > m) != 0ull) {
        const float mn = fmaxf(m, mx);
        const float alpha = ex2(m - mn);
        m = mn; l *= alpha;
#pragma unroll
        for (int db = 0; db < NDB; ++db)
#pragma unroll
            for (int r = 0; r < 16; ++r) o[db][r] *= alpha;
    }
    const float mn = m;
    float rs = 0.f;
#pragma unroll
    for (int r = 0; r < 16; ++r) { p0[r] = ex2(p0[r] - mn); p1[r] = ex2(p1[r] - mn); rs += p0[r] + p1[r]; }
    l += rs;
    bf16x8 pf[4];
    { u32x4 w;
      w.x = cvtpk(p0[0], p0[1]); w.y = cvtpk(p0[2], p0[3]); w.z = cvtpk(p0[4], p0[5]); w.w = cvtpk(p0[6], p0[7]); pf[0] = __builtin_bit_cast(bf16x8, w);
      w.x = cvtpk(p0[8], p0[9]); w.y = cvtpk(p0[10], p0[11]); w.z = cvtpk(p0[12], p0[13]); w.w = cvtpk(p0[14], p0[15]); pf[1] = __builtin_bit_cast(bf16x8, w);
      w.x = cvtpk(p1[0], p1[1]); w.y = cvtpk(p1[2], p1[3]); w.z = cvtpk(p1[4], p1[5]); w.w = cvtpk(p1[6], p1[7]); pf[2] = __builtin_bit_cast(bf16x8, w);
      w.x = cvtpk(p1[8], p1[9]); w.y = cvtpk(p1[10], p1[11]); w.z = cvtpk(p1[12], p1[13]); w.w = cvtpk(p1[14], p1[15]); pf[3] = __builtin_bit_cast(bf16x8, w); }
#pragma unroll
    for (int kk = 0; kk < 4; ++kk)
#pragma unroll
        for (int db = 0; db < NDB; ++db) {
            const s16x4 lo = vtr(vt + vb + db * 4096 + kk * 1024), hh = vtr(vt + vb + db * 4096 + kk * 1024 + 512);
            const bf16x8 vf = {lo[0], lo[1], lo[2], lo[3], hh[0], hh[1], hh[2], hh[3]};
            o[db] = __builtin_amdgcn_mfma_f32_32x32x16_bf16(vf, pf[kk], o[db], 0, 0, 0);
        }
}

template <int MODE>
__device__ __forceinline__ void attn_unit64(const bf16* qkv, bf16* mix, const float* cum_bh, int b, int h, int blk, LAS unsigned char* lds, int tid, int wave, int lane) {
    constexpr int CUMOFF = KT_BYTES + 8192, BUFSZ = CUMOFF + 256;
    const int r32 = lane & 31, hi = lane >> 5;
    const size_t rowbase = (size_t)b * SEQ;
    const int Q0 = blk * 256, qw0 = Q0 + 32 * wave;
    const int CQ = (MODE == 0 ? C_FQ : C_CQ) + h * 64, CK = (MODE == 0 ? C_FK : C_CK) + h * 64, CV = (MODE == 0 ? C_FV : C_CV) + h * 64;
    const int c0 = 4 * blk, cw = c0 + (wave >> 1);
    int tbeg, tend, kvoff;
    if (MODE == 0) { tbeg = 0; tend = 4 * (blk + 1); kvoff = 0; }
    else { tbeg = (c0 >= 8) ? 0 : 8 - c0; tend = 12; kvoff = (c0 - 8) * 64; }
    const int srow = tid >> 3, sch = tid & 7;
    const bf16* kg = qkv + (rowbase + kvoff + srow) * NQKV + CK + sch * 8;
    const bf16* vg = qkv + (rowbase + kvoff + srow) * NQKV + CV + sch * 8;
    const int kdst = srow * KROWB + sch * 16, vdst = KT_BYTES + (sch >> 2) * 4096 + srow * 64 + (sch & 3) * 16;
    const float cref = (MODE == 0) ? cum_bh[Q0] : 0.f;
#define U64_LOAD(K, V, C, tt) do { if ((tt) >= tbeg) { K = *(const u32x4*)(kg + (size_t)(tt) * 64 * NQKV); V = *(const u32x4*)(vg + (size_t)(tt) * 64 * NQKV); \
        if (MODE == 0 && tid < 16) C = *(const f32x4*)(cum_bh + (tt) * 64 + 4 * tid); } } while (0)
#define U64_STAGE(K, V, C, buf) do { *(LAS u32x4*)((buf) + kdst) = K; *(LAS u32x4*)((buf) + vdst) = V; if (MODE == 0 && tid < 16) *(LAS f32x4*)((buf) + CUMOFF + tid * 16) = (cref - C) * L2E; } while (0)
#define LDS_BAR() asm volatile("s_waitcnt lgkmcnt(0)\n\ts_barrier" ::: "memory")
    u32x4 kA = {0u, 0u, 0u, 0u}, vA = kA, kB = kA, vB = kA; f32x4 cA = {0.f, 0.f, 0.f, 0.f}, cB = cA;
    U64_LOAD(kA, vA, cA, tend - 1); U64_LOAD(kB, vB, cB, tend - 2);
    bf16x8 qr[4];
#pragma unroll
    for (int ks = 0; ks < 4; ++ks) qr[ks] = *(const bf16x8*)(qkv + (rowbase + qw0 + r32) * NQKV + CQ + ks * 16 + hi * 8);
    float m = -1e30f, l = 0.f;
    f32x16 o[2];
#pragma unroll
    for (int db = 0; db < 2; ++db)
#pragma unroll
        for (int r = 0; r < 16; ++r) o[db][r] = 0.f;
    const int vb = (4 * hi + ((lane & 15) >> 2)) * 64 + ((lane >> 4) & 1) * 32 + (lane & 3) * 8;
    LAS const float* tab = (LAS const float*)(lds + LDS_TAB) + h * 192;
    auto compute = [&](const int t, LAS unsigned char* const buf) __attribute__((always_inline)) {
        const int kv0 = kvoff + 64 * t;
        bool doit;
        if (MODE == 0) doit = kv0 <= qw0 + 31; else { const int kc = c0 - 8 + t; doit = (kc >= cw - 8) && (kc <= cw); }
        if (doit) {
            f32x16 p0 = (f32x16){0.f, 0.f, 0.f, 0.f, 0.f, 0.f, 0.f, 0.f, 0.f, 0.f, 0.f, 0.f, 0.f, 0.f, 0.f, 0.f}, p1 = p0;
            if (MODE == 2 && cw - (c0 - 8 + t) >= 3) { const float bv = tab[191];
#pragma unroll
                for (int r = 0; r < 16; ++r) { p0[r] = bv; p1[r] = bv; } }
            if (MODE == 0) {
#pragma unroll
                for (int g = 0; g < 4; ++g) { const f32x4 ca = *(LAS const f32x4*)(buf + CUMOFF + (8 * g + 4 * hi) * 4), cb = *(LAS const f32x4*)(buf + CUMOFF + (32 + 8 * g + 4 * hi) * 4);
#pragma unroll
                    for (int i = 0; i < 4; ++i) { p0[4 * g + i] = ca[i]; p1[4 * g + i] = cb[i]; } }
            }
            qk_tile(p0, p1, (LAS const char*)buf, qr, r32, hi);
            if (MODE == 0) {
                if (kv0 + 63 > qw0) {
                    const int qa = qw0 + r32 - kv0 - 4 * hi;
#pragma unroll
                    for (int r = 0; r < 16; ++r) { const int kl = (r & 3) + 8 * (r >> 2); if (kl > qa) p0[r] = -INFINITY; if (kl + 32 > qa) p1[r] = -INFINITY; }
                }
            } else {
                const int dc = cw - (c0 - 8 + t);
                if (dc < 3) {
                    const int rel0 = qw0 + r32 - kv0 - 4 * hi + 63;
#pragma unroll
                    for (int r = 0; r < 16; ++r) { const int kl = (r & 3) + 8 * (r >> 2);
                        int i0 = rel0 - kl, i1 = rel0 - kl - 32; i0 = i0 < 0 ? 0 : (i0 > 191 ? 191 : i0); i1 = i1 < 0 ? 0 : (i1 > 191 ? 191 : i1);
                        p0[r] += tab[i0]; p1[r] += tab[i1]; }
                }
            }
            softmax_pv<2>(p0, p1, m, l, o, (LAS const char*)buf + KT_BYTES, vb);
        }
    };
    int pi = 0;
    for (int t = tend - 1; t >= tbeg; t -= 2, pi ^= 1) {
        LAS unsigned char* const sb = lds + (pi ? 2 * BUFSZ : 0); const bool two = (t - 1 >= tbeg);
        U64_STAGE(kA, vA, cA, sb); if (two) U64_STAGE(kB, vB, cB, sb + BUFSZ);
        LDS_BAR();
        U64_LOAD(kA, vA, cA, t - 2); U64_LOAD(kB, vB, cB, t - 3);
        compute(t, sb); if (two) compute(t - 1, sb + BUFSZ);
    }
#undef U64_LOAD
#undef U64_STAGE
    l += __shfl_xor(l, 32);
    const float inv = 1.0f / l;
    bf16* orow = mix + (rowbase + qw0 + r32) * MIXW + (MODE == 0 ? MX_FOX : MX_CHK) + h * 64 + 4 * hi;
#pragma unroll
    for (int db = 0; db < 2; ++db)
#pragma unroll
        for (int g = 0; g < 4; ++g) { u32x2 w; w.x = cvtpk(o[db][4 * g] * inv, o[db][4 * g + 1] * inv); w.y = cvtpk(o[db][4 * g + 2] * inv, o[db][4 * g + 3] * inv);
            *(u32x2*)(orow + 32 * db + 8 * g) = w; }
    __syncthreads();
}

template <int C>
__device__ __forceinline__ void diff_pass(const bf16* qkv, bf16* mix, float* park, int b, int h, int blk, float lam, float sl2, const float* gdiff, float outscale,
                                          LAS unsigned char* lds, int tid, int wave, int lane) {
    constexpr int VOFF = KT_BYTES, BUFSZ = VOFF + 16384;
    const int r32 = lane & 31, hi = lane >> 5;
    const size_t rowbase = (size_t)b * SEQ;
    const int Q0 = blk * 256, qw0 = Q0 + 32 * wave, cwv = qw0 >> 6, tend = 4 * (blk + 1);
    const int srow = tid >> 3, sch = tid & 7;
    const int vrow0 = tid >> 4, vch = tid & 15;
    const bf16* vg = qkv + (rowbase + vrow0) * NQKV + C_DV + h * 128 + vch * 8;
    const int kdst = srow * KROWB + sch * 16, vdst = VOFF + (vch >> 2) * 4096 + vrow0 * 64 + (vch & 3) * 16;
    const int vb = (4 * hi + ((lane & 15) >> 2)) * 64 + ((lane >> 4) & 1) * 32 + (lane & 3) * 8;
    const bf16* kg = qkv + (rowbase + srow) * NQKV + C_DK + h * 128 + C * 64 + sch * 8;
#define DF_LOAD(K, V0, V1, tt) do { if ((tt) >= 0) { const size_t go_ = (size_t)(tt) * 64 * NQKV; K = *(const u32x4*)(kg + go_); V0 = *(const u32x4*)(vg + go_); V1 = *(const u32x4*)(vg + go_ + (size_t)32 * NQKV); } } while (0)
#define DF_STAGE(K, V0, V1, buf) do { *(LAS u32x4*)((buf) + kdst) = K; *(LAS u32x4*)((buf) + vdst) = V0; *(LAS u32x4*)((buf) + vdst + 32 * 64) = V1; } while (0)
    u32x4 kA = {0u, 0u, 0u, 0u}, v0A = kA, v1A = kA, kB = kA, v0B = kA, v1B = kA;
    DF_LOAD(kA, v0A, v1A, tend - 1); DF_LOAD(kB, v0B, v1B, tend - 2);
    bf16x8 qr[4];
#pragma unroll
    for (int ks = 0; ks < 4; ++ks) qr[ks] = *(const bf16x8*)(qkv + (rowbase + qw0 + r32) * NQKV + C_DQ + h * 128 + C * 64 + ks * 16 + hi * 8);
    float m = -1e30f, l = 0.f;
    f32x16 o[4];
#pragma unroll
    for (int db = 0; db < 4; ++db)
#pragma unroll
        for (int r = 0; r < 16; ++r) o[db][r] = 0.f;
    f32x16 ab;
#pragma unroll
    for (int r = 0; r < 16; ++r) ab[r] = sl2 * (float)((r & 3) + 8 * (r >> 2) + 4 * hi);
    auto compute = [&](const int t, LAS unsigned char* const buf) __attribute__((always_inline)) {
        if (t <= cwv) {
            const int kv0 = 64 * t;
            f32x16 p0, p1;
            if (t < cwv) { const float d0 = sl2 * (float)(64 * (t - cwv)), d1 = d0 + 32.f * sl2;
#pragma unroll
                for (int r = 0; r < 16; ++r) { p0[r] = ab[r] + d0; p1[r] = ab[r] + d1; }
                qk_tile(p0, p1, (LAS const char*)buf, qr, r32, hi);
            } else { p0 = (f32x16){0.f, 0.f, 0.f, 0.f, 0.f, 0.f, 0.f, 0.f, 0.f, 0.f, 0.f, 0.f, 0.f, 0.f, 0.f, 0.f}; p1 = p0;
                qk_tile(p0, p1, (LAS const char*)buf, qr, r32, hi);
                const float ql = (float)(qw0 + r32 - kv0), base = ql - (float)(4 * hi);
#pragma unroll
                for (int r = 0; r < 16; ++r) { const float kl = (float)((r & 3) + 8 * (r >> 2)); p0[r] += sl2 * (ql - fabsf(base - kl)); p1[r] += sl2 * (ql - fabsf(base - kl - 32.f)); }
            }
            softmax_pv<4>(p0, p1, m, l, o, (LAS const char*)buf + VOFF, vb);
        }
    };
    int pi = 0;
    for (int t = tend - 1; t >= 0; t -= 2, pi ^= 1) {
        LAS unsigned char* const sb = lds + (pi ? 2 * BUFSZ : 0);
        DF_STAGE(kA, v0A, v1A, sb); DF_STAGE(kB, v0B, v1B, sb + BUFSZ);
        LDS_BAR();
        DF_LOAD(kA, v0A, v1A, t - 2); DF_LOAD(kB, v0B, v1B, t - 3);
        compute(t, sb); compute(t - 1, sb + BUFSZ);
    }
#undef DF_LOAD
#undef DF_STAGE
    l += __shfl_xor(l, 32);
    const float inv = 1.0f / l;
    if (C == 0) {
#pragma unroll
        for (int db = 0; db < 4; ++db)
#pragma unroll
            for (int r = 0; r < 16; ++r) park[(db * 16 + r) * NTHREADS] = o[db][r] * inv;
    } else {
        const float li = lam * inv;
        float ss = 0.f;
#pragma unroll
        for (int db = 0; db < 4; ++db) {
#pragma unroll
            for (int r = 0; r < 16; ++r) { const float v = park[(db * 16 + r) * NTHREADS] - o[db][r] * li; o[db][r] = v; ss += v * v; }
            asm volatile("" ::: "memory"); }
        ss += __shfl_xor(ss, 32);
        const float rn = outscale / sqrtf(ss * (1.f / 128.f) + RMS_EPS);
        bf16* orow = mix + (rowbase + qw0 + r32) * MIXW + MX_DIFF + h * 128 + 4 * hi;
#pragma unroll
        for (int db = 0; db < 4; ++db)
#pragma unroll
            for (int g = 0; g < 4; ++g) { const f32x4 gg = *(const f32x4*)(gdiff + 32 * db + 8 * g + 4 * hi);
                u32x2 w; w.x = cvtpk(o[db][4 * g] * rn * gg.x, o[db][4 * g + 1] * rn * gg.y); w.y = cvtpk(o[db][4 * g + 2] * rn * gg.z, o[db][4 * g + 3] * rn * gg.w);
                *(u32x2*)(orow + 32 * db + 8 * g) = w; }
    }
    __syncthreads();
}
__device__ __forceinline__ void attn_unit_diff2(const bf16* qkv, bf16* mix, int b, int h, int blk, float lam, float sl2, const float* gdiff, float outscale,
                                                LAS unsigned char* lds, int tid, int wave, int lane) {
    float* park = (float*)((unsigned char*)qkv - WS_QKV + WS_H) + (size_t)blockIdx.x * 64 * NTHREADS + tid;
    diff_pass<0>(qkv, mix, park, b, h, blk, lam, sl2, gdiff, outscale, lds, tid, wave, lane);
    int tid2 = threadIdx.x; asm volatile("" : "+v"(tid2) :: "memory"); __builtin_amdgcn_sched_barrier(0);
    float* park2 = (float*)((unsigned char*)qkv - WS_QKV + WS_H) + (size_t)blockIdx.x * 64 * NTHREADS + tid2;
    diff_pass<1>(qkv, mix, park2, b, h, blk, lam, sl2, gdiff, outscale, lds, tid2, __builtin_amdgcn_readfirstlane(tid2 >> 6), tid2 & 63);
}
#define SF(q) (0 << 5 | (q) << 1 | 0), (0 << 5 | (q) << 1 | 1)
#define SD(q) (1 << 5 | (q) << 1 | 0)
#define SC(q) (2 << 5 | (q) << 1 | 0), (2 << 5 | (q) << 1 | 1)
__device__ __forceinline__ int seg_code(int s) {
    constexpr unsigned char T[40] = { SD(7), SD(6), SD(5), SD(4), SD(3), SF(7), SD(2), SF(6), SF(5), SD(1), SF(4), SF(3), SD(0), SF(2),
        SC(7), SC(6), SC(5), SC(4), SC(3), SC(2), SC(1), SC(0), SF(1), SF(0) };
    return T[s];
}
__device__ __forceinline__ void phase_attn(const Args& a, int layer, unsigned* ctr, LAS unsigned char* lds, int tid0, int wave0, int lane0) {
    const bf16* qkv = (const bf16*)(a.ws + WS_QKV); bf16* mix = (bf16*)(a.ws + WS_MIX); const float* CUM = (const float*)(a.ws + WS_CUM);
    for (int i = tid0; i < 4 * 192; i += NTHREADS) ((LAS float*)(lds + LDS_TAB))[i] = a.in[6][(size_t)layer * 768 + i] * L2E;
    const float* dl = a.in[4] + (size_t)layer * 256;
    const float s01 = wave_sum(dl[lane0] * dl[64 + lane0]), s23 = wave_sum(dl[128 + lane0] * dl[192 + lane0]);
    const float lambda_init = 0.8f - 0.6f * expf(-0.3f * (float)layer);
    const float lam = expf(s01) - expf(s23) + lambda_init;
    const float* gdiff = a.in[5] + (size_t)layer * 128;
    LAS volatile unsigned* misc = (LAS volatile unsigned*)(lds + LDS_MISC);
    __syncthreads();
    for (;;) {
        if (threadIdx.x == 0) misc[0] = atomicAdd(ctr, 1u);
        __syncthreads();
        const unsigned idx = misc[0];
        int tidf = threadIdx.x; asm volatile("" : "+v"(tidf) :: "memory"); __builtin_amdgcn_sched_barrier(0);
        const int tid = tidf, lane = tidf & 63, wave = __builtin_amdgcn_readfirstlane(tidf >> 6);
        if (idx >= 1280u) break;
        const int code = seg_code((int)(idx >> 5)), kind = code >> 5, blk = (code >> 1) & 15, sub = (int)(idx & 31);
        if (kind == 1) { const int b = sub >> 1, h = sub & 1;
            attn_unit_diff2(qkv, mix, b, h, blk, lam, exp2f(-4.0f * (float)(h + 1)) * L2E, gdiff, 1.0f - lambda_init, lds, tid, wave, lane); }
        else { const int bh = (code & 1) * 32 + sub, b = bh >> 2, h = bh & 3;
            if (kind == 0) attn_unit64<0>(qkv, mix, CUM + (size_t)bh * SEQ, b, h, blk, lds, tid, wave, lane);
            else attn_unit64<2>(qkv, mix, nullptr, b, h, blk, lds, tid, wave, lane); }
    }
}
#define XB_TMO      128
#define XB_XCNT(j)  (256  + 64 * (j))
#define XB_XSUB(j)  (1280 + 64 * (j))
#define XB_XGEN(j)  (2304 + 64 * (j))
#define XB_TOP      3328
#define XB_TOPGEN   3392
#define XCD_BAR_WORDS 3456
#define XB_SPIN_CAP (1u << 18)

__device__ __forceinline__ unsigned xb_ld(unsigned* p)              { return __hip_atomic_load(p, __ATOMIC_RELAXED, __HIP_MEMORY_SCOPE_AGENT); }
__device__ __forceinline__ unsigned xb_add(unsigned* p, unsigned v) { return __hip_atomic_fetch_add(p, v, __ATOMIC_RELAXED, __HIP_MEMORY_SCOPE_AGENT); }
__device__ __forceinline__ unsigned xb_xcc_id() { return (unsigned)__builtin_amdgcn_s_getreg((3 << 11) | 20) & 0xFu; }
#define XB_SPIN(cond, bar) do { unsigned _sp = 0; while (cond) { __builtin_amdgcn_s_sleep(1); \
    if ((++_sp & 255u) == 0u) { if (xb_ld(&(bar)[XB_TMO])) break; if (_sp > XB_SPIN_CAP) { atomicAdd(&(bar)[XB_TMO], 1u); break; } } } } while (0)

struct XcdBarrier {
    unsigned* bar; unsigned x;
    volatile LAS unsigned* st;
};

__device__ __forceinline__ XcdBarrier xcd_barrier_post(unsigned* bar, volatile LAS unsigned* st) {
    XcdBarrier b; b.bar = bar; b.x = xb_xcc_id(); b.st = st;
    if (threadIdx.x == 0) (void)xb_add(&bar[XB_XCNT(b.x)], 1u);
    return b;
}
__device__ __forceinline__ void xcd_barrier_complete(unsigned* bar, unsigned x, unsigned& nloc, unsigned& nx) {
    const unsigned G = gridDim.x * gridDim.y * gridDim.z;
    unsigned sum, cnt, mine, sp = 0u;
    for (;;) {
        sum = 0u; cnt = 0u; mine = 0u;
#pragma unroll
        for (unsigned j = 0; j < 16; ++j) { const unsigned c = xb_ld(&bar[XB_XCNT(j)]); sum += c; cnt += (c > 0u) ? 1u : 0u; mine = (j == x) ? c : mine; }
        if (sum == G) break;
        __builtin_amdgcn_s_sleep(1);
        if ((++sp & 255u) == 0u) { if (xb_ld(&bar[XB_TMO])) break; if (sp > XB_SPIN_CAP) { atomicAdd(&bar[XB_TMO], 1u); break; } }
    }
    nloc = mine > 0u ? mine : 1u; nx = cnt > 0u ? cnt : 1u;
}

__device__ __forceinline__ void xcd_barrier(const XcdBarrier& b) {
    asm volatile("s_waitcnt vmcnt(0)" ::: "memory");
    __syncthreads();
    if (threadIdx.x == 0) {
        unsigned* bar = b.bar;
        __builtin_amdgcn_s_waitcnt(0);
        unsigned nloc = b.st[0], nx = b.st[1];
        if (nloc == 0u) { xcd_barrier_complete(bar, b.x, nloc, nx); b.st[0] = nloc; b.st[1] = nx; }
        const unsigned old = xb_add(&bar[XB_XSUB(b.x)], 1u);
        const unsigned gen = old / nloc;
        if (old + 1u == (gen + 1u) * nloc) {
            __builtin_amdgcn_fence(__ATOMIC_RELEASE, "agent");
            asm volatile("s_waitcnt vmcnt(0)" ::: "memory");
            const unsigned og = xb_add(&bar[XB_TOP], 1u);
            const unsigned tg = og / nx;
            if (og + 1u == (tg + 1u) * nx) xb_add(&bar[XB_TOPGEN], 1u);
            else XB_SPIN(xb_ld(&bar[XB_TOPGEN]) == tg, bar);
            __builtin_amdgcn_fence(__ATOMIC_ACQUIRE, "agent");
            xb_add(&bar[XB_XGEN(b.x)], 1u);
            asm volatile("s_waitcnt vmcnt(0)" ::: "memory");
        } else {
            XB_SPIN(xb_ld(&bar[XB_XGEN(b.x)]) == gen, bar);
            __builtin_amdgcn_fence(__ATOMIC_ACQUIRE, "agent");
            asm volatile("s_waitcnt vmcnt(0)" ::: "memory");
        }
    }
    __syncthreads();
}

#define GEMM_RUN(EPI, Aptr, Bptr, Mv, Nv, Kv, Eobj) GEMM_RUN2(EPI, Aptr, Bptr, Mv, Nv, Kv, Eobj, true, true)
#define GEMM_RUN2(EPI, Aptr, Bptr, Mv, Nv, Kv, Eobj, ALIGNV, SP2V) do { pg8::Gemm g_{(const pg8::bf16_t*)(Aptr), (const pg8::bf16_t*)(Bptr), (Mv), (Nv), (Kv)}; pg8::StaticOrder S_; S_.init((Mv), (Nv), (int)gridDim.x, (int)blockIdx.x); \
    pg8::gemm_phase<EPI, pg8::StaticOrder, ALIGNV, SP2V>(lds, g_, S_, Eobj); } while (0)

__global__ void __launch_bounds__(NTHREADS, 2) mk_fwd(Args a) {
    __shared__ __attribute__((aligned(16))) unsigned char lds_raw[LDS_BYTES];
    LAS unsigned char* lds = (LAS unsigned char*)lds_raw;
    cg::grid_group grid = cg::this_grid();
#define FRESH int tid = threadIdx.x; asm volatile("" : "+v"(tid)); const int lane = tid & 63, wave = __builtin_amdgcn_readfirstlane(tid >> 6); const int G = gridDim.x, gw = blockIdx.x * NWAVES + wave, NGW = G * NWAVES; (void)lane; (void)gw; (void)NGW; (void)G
    unsigned* ctl = (unsigned*)(a.ws + WS_CTL);
    unsigned* barw = ctl + 4096;
    volatile LAS unsigned* bst = (volatile LAS unsigned*)(lds + LDS_MISC + 64);
    if (threadIdx.x < 2) bst[threadIdx.x] = 0u;
    __syncthreads();
    if (a.out == nullptr) grid.sync();
    const XcdBarrier xbar = xcd_barrier_post(barw, bst);
#define GSYNC() xcd_barrier(xbar)
    bf16* H = (bf16*)(a.ws + WS_H); bf16* QKV = (bf16*)(a.ws + WS_QKV); bf16* MIX = (bf16*)(a.ws + WS_MIX); bf16* UV = (bf16*)(a.ws + WS_UV); bf16* ACT = (bf16*)(a.ws + WS_ACT); bf16* XB = (bf16*)(a.ws + WS_XB); float* RSTD = (float*)(a.ws + WS_CTL + 65536);
    float* FF = (float*)(a.ws + WS_FF); float* CUM = (float*)(a.ws + WS_CUM);
    { FRESH; phase_weights(a, lds, gw, NGW, wave, lane); }
    for (int l = 0; l < DEPTH; ++l) {
        if (l == 0) { FRESH; phase_norm<1, false>(a.in[0], a.in[1] + (size_t)l * DM, XB, RSTD, a.in[2] + (size_t)l * DM * NIN_SRC, a.in[3] + l * 4, FF, lds, gw, NGW, tid, lane); }
        else { FRESH; phase_norm<1, true>(XB, a.in[1] + (size_t)l * DM, nullptr, RSTD, a.in[2] + (size_t)l * DM * NIN_SRC, a.in[3] + l * 4, FF, lds, gw, NGW, tid, lane); }
        GSYNC();
        { FRESH; if (blockIdx.x < 64 && wave == 0) cumsum_seq(FF, CUM, blockIdx.x, lane); }
        { pg8::EpiBf16S E{(pg8::bf16_t*)QKV, NQKV, RSTD}; GEMM_RUN(pg8::EpiBf16S, XB, a.ws + WS_WIN + l * SZ_WIN, MTOK, NQKV, DM, E); }
        GSYNC();
        { FRESH; phase_attn(a, l, ctl + 64 * l, lds, tid, wave, lane); }
        GSYNC();
        { pg8::EpiResB<false> E{XB, (pg8::bf16_t*)XB, DM}; GEMM_RUN(pg8::EpiResB<false>, MIX, a.ws + WS_WOUT + l * SZ_WOUT, MTOK, DM, MIXW, E); }
        GSYNC();
        { FRESH; phase_norm<0, true>(XB, a.in[8] + (size_t)l * DM, H, nullptr, nullptr, nullptr, nullptr, lds, gw, NGW, tid, lane); }
        GSYNC();
        { pg8::EpiConv E{(pg8::bf16_t*)ACT, (pg8::bf16_t*)UV, a.in[10] + (size_t)l * 3 * NFF2, a.in[11] + (size_t)l * NFF2}; GEMM_RUN(pg8::EpiConv, H, a.ws + WS_WFI + l * SZ_WFI, MTOK, NFF2, DM, E); }
        GSYNC();
        { FRESH; phase_fixup(UV, ACT, a.in[10] + (size_t)l * 3 * NFF2, a.in[11] + (size_t)l * NFF2, blockIdx.x * NTHREADS + tid, G * NTHREADS); }
        GSYNC();
        { pg8::EpiResB<false> E{XB, (pg8::bf16_t*)XB, DM}; GEMM_RUN(pg8::EpiResB<false>, ACT, a.ws + WS_WFO + l * SZ_WFO, MTOK, DM, DFF, E); }
        GSYNC();
    }
    { FRESH; phase_norm<2, true>(XB, a.in[13], nullptr, a.out, nullptr, nullptr, nullptr, lds, gw, NGW, tid, lane); }
}

extern "C" void kernel_launch(void* const* d_in, const int* in_sizes, int n_in, void* d_out, int out_size, void* d_ws, size_t ws_size, hipStream_t stream) {
    static int grid_blocks = 0;
    if (grid_blocks == 0) {
        if (n_in != 14 || out_size != MTOK * DM || ws_size < WS_END || in_sizes[2] != DEPTH * DM * NIN_SRC || in_sizes[7] != DEPTH * MIXW * DM || in_sizes[9] != DEPTH * DM * NFF2 || in_sizes[12] != DEPTH * DFF * DM || in_sizes[6] != DEPTH * 4 * 192 || in_sizes[5] != DEPTH * 128) { fprintf(stderr, "kernel_launch: unexpected sizes n_in %d out %d ws %zu\n", n_in, out_size, ws_size); grid_blocks = -1; return; }
        int dev = 0, cus = 0, per_cu = 0;
        (void)hipGetDevice(&dev);
        (void)hipDeviceGetAttribute(&cus, hipDeviceAttributeMultiprocessorCount, dev);
        (void)hipOccupancyMaxActiveBlocksPerMultiprocessor(&per_cu, (const void*)mk_fwd, NTHREADS, 0);
        if (per_cu < 1) { fprintf(stderr, "kernel_launch: occupancy query says %d blocks/CU\n", per_cu); per_cu = 1; }
        (void)hipGetLastError();
        grid_blocks = cus * 1;
        fprintf(stderr, "kernel_launch: cus %d per_cu %d grid %d\n", cus, per_cu, grid_blocks);
    }
    if (grid_blocks < 0) return;
    if (hipMemsetAsync((char*)d_ws + WS_CTL, 0, 65536, stream) != hipSuccess) { fprintf(stderr, "kernel_launch: memset of control words failed\n"); return; }
    Args a{};
    for (int i = 0; i < 14; ++i) a.in[i] = (const float*)d_in[i];
    a.out = (float*)d_out; a.ws = (unsigned char*)d_ws;
    void* args[] = {&a};
    hipError_t e = hipLaunchCooperativeKernel((const void*)mk_fwd, dim3(grid_blocks), dim3(NTHREADS), args, 0, stream);
    if (e != hipSuccess) fprintf(stderr, "cooperative launch failed: %s (grid %d)\n", hipGetErrorString(e), grid_blocks);
}
```

```cpp
#include <hip/hip_runtime.h>
#include <cstdio>
#include <cstdint>
#include <hip/hip_cooperative_groups.h>
namespace cg = cooperative_groups;
namespace pg8 {
#define PG8_LAS __attribute__((address_space(3)))
typedef unsigned short bf16_t;
typedef short bf16x8 __attribute__((ext_vector_type(8)));
typedef float f32x4 __attribute__((ext_vector_type(4)));
typedef unsigned u32x4 __attribute__((ext_vector_type(4)));
constexpr int BM = 256, BK = 64, HALF = 128, HTB = HALF * BK * 2  , STAGE_BYTES = 8 * HTB, NXCD = 8, WGM = 8;

__host__ __device__ __forceinline__ int lds_byte(int r, int c) { const int st = (r >> 4) * 2 + (c >> 5), rr = r & 15, cc = c & 31, ob = rr * 64 + cc * 2; return st * 1024 + (ob ^ (((ob >> 9) & 1) << 5)); }
__host__ __device__ __forceinline__ void stage_rc(int b, int& R, int& C) { const int st = b / 1024, sb = b % 1024, swz = sb ^ (((sb >> 9) & 1) << 5); R = (st >> 1) * 16 + swz / 64; C = (st & 1) * 32 + (swz % 64) / 2; }
__host__ __device__ __forceinline__ int perm32(int rho) { const int n = rho >> 4, i = rho & 15; return 8 * (i >> 2) + 4 * n + (i & 3); }

struct Unit { int pm, pn; };
struct Gemm { const bf16_t* A; const bf16_t* Bt; int M, N, K; };

struct StaticOrder {
    int nM, nN, nwg, G, c;
    __host__ __device__ void init(int M, int N, int G_, int c_) { nM = M / BM; nN = N / BM; nwg = nM * nN; G = G_; c = c_; }
    __host__ __device__ bool next(int i, Unit& u) const {
        const long L = (long)i * G + c; if (L >= nwg) return false;
        int wgid = (int)L; { const int q = nwg / NXCD, r = nwg % NXCD, xcd = wgid % NXCD, off = wgid / NXCD; wgid = (xcd < r ? xcd * (q + 1) : r * (q + 1) + (xcd - r) * q) + off; }
        const int nig = WGM * nN, gid = wgid / nig, fm = gid * WGM, gsz = (nM - fm) < WGM ? (nM - fm) : WGM;
        u.pm = fm + ((wgid % nig) % gsz); u.pn = (wgid % nig) / gsz; return true;
    }
    __device__ __forceinline__ void a_ready(const Unit&) const {}
    __device__ __forceinline__ void done(const Unit&) const {}
};

typedef float f32x2c __attribute__((ext_vector_type(2))); typedef __bf16 bf16x2c __attribute__((ext_vector_type(2)));
__device__ __forceinline__ unsigned cvt_pk_bf16(float lo, float hi) { f32x2c v = {lo, hi}; bf16x2c b = __builtin_convertvector(v, bf16x2c); return __builtin_bit_cast(unsigned, b); }
typedef float f32x2 __attribute__((ext_vector_type(2)));
struct EpiBf16 {
    static constexpr bool PERM = true, AFTER_DRAIN = false, APERM = false;
    bf16_t* O; int ldc;
    __device__ __forceinline__ void operator()(const f32x4 (&acc)[2][2][4][2], const Unit& u, int wr, int wc, int fr, int fq) const {
        const int row0 = u.pm * BM + wr * 64 + fr; const int col0 = u.pn * BM + wc * 32 + 8 * fq;
#pragma unroll
        for (int ai = 0; ai < 2; ++ai)
#pragma unroll
            for (int m = 0; m < 4; ++m) { bf16_t* rowp = O + (size_t)(row0 + ai * HALF + m * 16) * ldc + col0;
#pragma unroll
                for (int bj = 0; bj < 2; ++bj) { const f32x4 v0 = acc[ai][bj][m][0], v1 = acc[ai][bj][m][1];
                    u32x4 w; w.x = cvt_pk_bf16(v0[0], v0[1]); w.y = cvt_pk_bf16(v0[2], v0[3]); w.z = cvt_pk_bf16(v1[0], v1[1]); w.w = cvt_pk_bf16(v1[2], v1[3]);
                    *(u32x4*)(rowp + bj * HALF) = w; } }
    }
};
struct EpiRes {
    static constexpr bool PERM = false, AFTER_DRAIN = false, APERM = false;
    const float* base; float* out; int ldc; float scale;
    __device__ __forceinline__ void operator()(const f32x4 (&acc)[2][2][4][2], const Unit& u, int wr, int wc, int fr, int fq) const {
        const int col0 = u.pn * BM + wc * 32 + 4 * fq;
#pragma unroll
        for (int ai = 0; ai < 2; ++ai)
#pragma unroll
            for (int m = 0; m < 4; ++m) { const size_t off = (size_t)(u.pm * BM + ai * HALF + wr * 64 + m * 16 + fr) * ldc + col0;
#pragma unroll
                for (int bj = 0; bj < 2; ++bj)
#pragma unroll
                    for (int n = 0; n < 2; ++n) { const f32x4 bs = *(const f32x4*)(base + off + bj * HALF + n * 16); *(f32x4*)(out + off + bj * HALF + n * 16) = bs + acc[ai][bj][m][n] * scale; } }
    }
};

__device__ __forceinline__ f32x4 dpp_shr1(f32x4 v) { f32x4 r;
#pragma unroll
    for (int i = 0; i < 4; ++i) r[i] = __shfl_up(v[i], 1, 16);
    return r; }
__device__ __forceinline__ f32x4 silu_mul(f32x4 yu, f32x4 yg) { f32x4 o;
#pragma unroll
    for (int i = 0; i < 4; ++i) o[i] = yu[i] * yg[i] * __builtin_amdgcn_rcpf(1.0f + __builtin_amdgcn_exp2f(-1.4426950408889634f * yg[i]));
    return o; }
struct EpiConv {
    static constexpr bool PERM = false, AFTER_DRAIN = false, APERM = true;
    bf16_t* act; bf16_t* halo; const float* cw; const float* cb; const float* rstd;
    typedef unsigned u32x2e __attribute__((ext_vector_type(2)));
    __device__ __forceinline__ void conv4(f32x4 (&y)[4], const f32x4 (&a4)[4][2], int n, const f32x4 rs, const f32x4 w0, const f32x4 w1, const f32x4 w2, const f32x4 b, int col, int fr, bf16_t* hp) const {
        constexpr int N2 = 5632;
        const f32x4 X0 = a4[0][n] * rs[0], X1 = a4[1][n] * rs[1], X2 = a4[2][n] * rs[2], X3 = a4[3][n] * rs[3];
        const f32x4 Xm1 = dpp_shr1(X3), Xm2 = dpp_shr1(X2);
        y[0] = b + w0 * Xm2 + w1 * Xm1 + w2 * X0;
        y[1] = b + w0 * Xm1 + w1 * X0 + w2 * X1;
        y[2] = b + w0 * X0 + w1 * X1 + w2 * X2;
        y[3] = b + w0 * X1 + w1 * X2 + w2 * X3;
        if (fr == 0 || fr == 15) { const f32x4 xa = fr == 0 ? X0 : X2, xb = fr == 0 ? X1 : X3;
            u32x2e w; w.x = cvt_pk_bf16(xa[0], xa[1]); w.y = cvt_pk_bf16(xa[2], xa[3]); *(u32x2e*)(hp + col) = w;
            w.x = cvt_pk_bf16(xb[0], xb[1]); w.y = cvt_pk_bf16(xb[2], xb[3]); *(u32x2e*)(hp + N2 + col) = w; }
    }
    __device__ __forceinline__ void operator()(const f32x4 (&acc)[2][2][4][2], const Unit& u, int wr, int wc, int fr, int fq) const {
        constexpr int DFFc = 2816, N2 = 5632;
#pragma unroll
        for (int n = 0; n < 2; ++n) {
            const int cu = u.pn * 128 + wc * 32 + n * 16 + 4 * fq, cg = DFFc + cu;
            const f32x4 w0u = *(const f32x4*)(cw + cu), w1u = *(const f32x4*)(cw + N2 + cu), w2u = *(const f32x4*)(cw + 2 * N2 + cu), bu = *(const f32x4*)(cb + cu);
            const f32x4 w0g = *(const f32x4*)(cw + cg), w1g = *(const f32x4*)(cw + N2 + cg), w2g = *(const f32x4*)(cw + 2 * N2 + cg), bg = *(const f32x4*)(cb + cg);
#pragma unroll
            for (int ai = 0; ai < 2; ++ai) {
                const int row0 = u.pm * BM + ai * HALF + wr * 64 + 4 * fr;
                const f32x4 rs = *(const f32x4*)(rstd + row0);
                bf16_t* hp = halo + ((size_t)(row0 >> 6) * 4 + (fr == 0 ? 0 : 2)) * N2;
                f32x4 yu[4], yg[4];
                conv4(yu, acc[ai][0], n, rs, w0u, w1u, w2u, bu, cu, fr, hp);
                conv4(yg, acc[ai][1], n, rs, w0g, w1g, w2g, bg, cg, fr, hp);
#pragma unroll
                for (int m = 0; m < 4; ++m) if (fr != 0 || m >= 2) { const f32x4 o = silu_mul(yu[m], yg[m]); u32x2e w; w.x = cvt_pk_bf16(o[0], o[1]); w.y = cvt_pk_bf16(o[2], o[3]);
                    *(u32x2e*)(act + (size_t)(row0 + m) * DFFc + cu) = w; }
            }
        }
    }
};

template <bool BASE_F32> struct EpiResB {
    static constexpr bool PERM = true, AFTER_DRAIN = false, APERM = false;
    const void* base; bf16_t* out; int ldc;
    __device__ __forceinline__ void operator()(const f32x4 (&acc)[2][2][4][2], const Unit& u, int wr, int wc, int fr, int fq) const {
        const int col0 = u.pn * BM + wc * 32 + 8 * fq;
#pragma unroll
        for (int ai = 0; ai < 2; ++ai)
#pragma unroll
            for (int m = 0; m < 4; ++m) { const size_t off = (size_t)(u.pm * BM + ai * HALF + wr * 64 + m * 16 + fr) * ldc + col0;
#pragma unroll
                for (int bj = 0; bj < 2; ++bj) { f32x4 b0, b1;
                    if (BASE_F32) { b0 = *(const f32x4*)((const float*)base + off + bj * HALF); b1 = *(const f32x4*)((const float*)base + off + bj * HALF + 4); }
                    else { const u32x4 r = *(const u32x4*)((const bf16_t*)base + off + bj * HALF);
                        b0[0] = __uint_as_float(r.x << 16); b0[1] = __uint_as_float(r.x & 0xffff0000u); b0[2] = __uint_as_float(r.y << 16); b0[3] = __uint_as_float(r.y & 0xffff0000u);
                        b1[0] = __uint_as_float(r.z << 16); b1[1] = __uint_as_float(r.z & 0xffff0000u); b1[2] = __uint_as_float(r.w << 16); b1[3] = __uint_as_float(r.w & 0xffff0000u); }
                    const f32x4 o0 = b0 + acc[ai][bj][m][0], o1 = b1 + acc[ai][bj][m][1];
                    u32x4 w; w.x = cvt_pk_bf16(o0[0], o0[1]); w.y = cvt_pk_bf16(o0[2], o0[3]); w.z = cvt_pk_bf16(o1[0], o1[1]); w.w = cvt_pk_bf16(o1[2], o1[3]);
                    *(u32x4*)(out + off + bj * HALF) = w; } }
    }
};

struct EpiBf16S {
    static constexpr bool PERM = true, AFTER_DRAIN = false, APERM = false;
    bf16_t* O; int ldc; const float* rs;
    __device__ __forceinline__ void operator()(const f32x4 (&acc)[2][2][4][2], const Unit& u, int wr, int wc, int fr, int fq) const {
        const int row0 = u.pm * BM + wr * 64 + fr; const int col0 = u.pn * BM + wc * 32 + 8 * fq;
#pragma unroll
        for (int ai = 0; ai < 2; ++ai)
#pragma unroll
            for (int m = 0; m < 4; ++m) { const int row = row0 + ai * HALF + m * 16; const float s = rs[row]; bf16_t* rowp = O + (size_t)row * ldc + col0;
#pragma unroll
                for (int bj = 0; bj < 2; ++bj) { const f32x4 v0 = acc[ai][bj][m][0] * s, v1 = acc[ai][bj][m][1] * s;
                    u32x4 w; w.x = cvt_pk_bf16(v0[0], v0[1]); w.y = cvt_pk_bf16(v0[2], v0[3]); w.z = cvt_pk_bf16(v1[0], v1[1]); w.w = cvt_pk_bf16(v1[2], v1[3]);
                    *(u32x4*)(rowp + bj * HALF) = w; } }
    }
};
template <class Epi, class Sched, bool ALIGN_EPI = false, bool SP2 = false>
__device__ __forceinline__ void gemm_phase(PG8_LAS unsigned char* lds, const Gemm g, const Sched& S, const Epi& E) {
    int tid_l = threadIdx.x; asm volatile("" : "+v"(tid_l)); const int tid = tid_l, wid = __builtin_amdgcn_readfirstlane(tid >> 6), lane = tid & 63, wr = wid >> 2, wc = wid & 3, fr = lane & 15, fq = lane >> 4;
    const int K = g.K, nt = K / BK;
    unsigned voffA[2], voffB[2];
#pragma unroll
    for (int i = 0; i < 2; ++i) { int R, C; stage_rc(tid * 16 + i * 8192, R, C); const int Rb = Epi::PERM ? ((R & ~31) + perm32(R & 31)) : R;
        const int Ra = Epi::APERM ? ((R & 64) + (R & 15) * 4 + ((R >> 4) & 3)) : R; voffA[i] = (unsigned)(Ra * K + C) * 2u; voffB[i] = (unsigned)(Rb * K + C) * 2u; }
    const size_t kstep = (size_t)(BK * 2);
    const size_t hstep = (size_t)HALF * K * 2;
    const size_t tstep = 2 * hstep;
    const unsigned ldsw = (unsigned)wid * 1024u;
    const int aoff = lds_byte(wr * 64 + fr, fq * 8), boff = lds_byte(wc * 32 + fr, fq * 8);
#define PG8_SA(b, h) (((b) * 2 + (h)) * HTB)
#define PG8_SB(b, h) ((4 + (b) * 2 + (h)) * HTB)
#define PG8_STAGE(bufoff, gbase, voff) do { _Pragma("unroll") for (int _i = 0; _i < 2; ++_i) \
        __builtin_amdgcn_global_load_lds((const unsigned*)((const char*)(gbase) + (voff)[_i]), (PG8_LAS unsigned*)(lds + (bufoff) + ldsw + _i * 8192), 16, 0, 0); } while (0)
#define PG8_LDA(dst, b, h) do { _Pragma("unroll") for (int m = 0; m < 4; ++m) _Pragma("unroll") for (int k = 0; k < 2; ++k) dst[m][k] = *(const PG8_LAS bf16x8*)(lds + PG8_SA(b, h) + aoff + m * 2048 + k * 1024); } while (0)
#define PG8_LDB(dst, b, h) do { _Pragma("unroll") for (int n = 0; n < 2; ++n) _Pragma("unroll") for (int k = 0; k < 2; ++k) dst[n][k] = *(const PG8_LAS bf16x8*)(lds + PG8_SB(b, h) + boff + n * 2048 + k * 1024); } while (0)
#define PG8_MMA(ai, bj, At, Bt) do { __builtin_amdgcn_s_setprio(1); _Pragma("unroll") for (int m = 0; m < 4; ++m) _Pragma("unroll") for (int n = 0; n < 2; ++n) _Pragma("unroll") for (int k = 0; k < 2; ++k) \
        acc[ai][bj][m][n] = __builtin_amdgcn_mfma_f32_16x16x32_bf16(Bt[n][k], At[m][k], acc[ai][bj][m][n], 0, 0, 0); __builtin_amdgcn_s_setprio(0); } while (0)
#define PG8_WAIT_V(n) asm volatile("s_waitcnt vmcnt(" #n ")" ::: "memory")
#define PG8_WAIT_L(n) asm volatile("s_waitcnt lgkmcnt(" #n ")" ::: "memory")
#define PG8_BAR __builtin_amdgcn_s_barrier()
#define PG8_SCHED __builtin_amdgcn_sched_barrier(0)
    Unit cur, nxt; int ui = 0;
    if (!S.next(0, cur)) return;
    f32x4 acc[2][2][4][2];
#pragma unroll
    for (int a = 0; a < 2; ++a)
#pragma unroll
        for (int b = 0; b < 2; ++b)
#pragma unroll
            for (int m = 0; m < 4; ++m)
#pragma unroll
                for (int n = 0; n < 2; ++n) acc[a][b][m][n] = (f32x4){0.f, 0.f, 0.f, 0.f};
    bf16x8 At[4][2], B0[2][2], B1[2][2];
    const char* cA = (const char*)g.A + (size_t)cur.pm * tstep; const char* cB = (const char*)g.Bt + (size_t)cur.pn * tstep;
    S.a_ready(cur);
    if constexpr (SP2) {
        PG8_STAGE(PG8_SB(0, 0), cB, voffB); PG8_STAGE(PG8_SB(0, 1), cB + hstep, voffB); PG8_STAGE(PG8_SA(0, 0), cA, voffA); PG8_STAGE(PG8_SA(0, 1), cA + hstep, voffA);
        if (wr == 1) PG8_BAR;
        PG8_WAIT_V(2); PG8_BAR;
        PG8_STAGE(PG8_SB(1, 0), cB + kstep, voffB); PG8_STAGE(PG8_SA(1, 0), cA + kstep, voffA); PG8_STAGE(PG8_SB(1, 1), cB + hstep + kstep, voffB);
        PG8_WAIT_V(6); PG8_BAR;
    } else {
        PG8_STAGE(PG8_SB(0, 0), cB, voffB); PG8_STAGE(PG8_SA(0, 0), cA, voffA); PG8_STAGE(PG8_SB(0, 1), cB + hstep, voffB); PG8_STAGE(PG8_SA(0, 1), cA + hstep, voffA);
        if (wr == 1) PG8_BAR;
        PG8_WAIT_V(4); PG8_BAR;
        PG8_STAGE(PG8_SB(1, 0), cB + kstep, voffB); PG8_STAGE(PG8_SA(1, 0), cA + kstep, voffA); PG8_STAGE(PG8_SB(1, 1), cB + hstep + kstep, voffB);
        PG8_WAIT_V(6); PG8_BAR;
    }
    for (;;) {
        const bool has_next = S.next(ui + 1, nxt);
        const char* nA = has_next ? (const char*)g.A + (size_t)nxt.pm * tstep : cA; const char* nB = has_next ? (const char*)g.Bt + (size_t)nxt.pn * tstep : cB;
        for (int t = 0; t < nt; t += 2) {
            const bool last = (t == nt - 2);
            const char* a1 = cA + (size_t)(t + 1) * kstep;
            const char* a2 = last ? nA : cA + (size_t)(t + 2) * kstep; const char* b2 = last ? nB : cB + (size_t)(t + 2) * kstep;
            const char* a3 = a2 + kstep; const char* b3 = b2 + kstep;
            if (last && has_next) S.a_ready(nxt);
            if constexpr (SP2) {
            PG8_LDB(B0, 0, 0); PG8_LDB(B1, 0, 1); PG8_SCHED; PG8_LDA(At, 0, 0); PG8_STAGE(PG8_SA(1, 1), a1 + hstep, voffA);
            PG8_WAIT_V(8); PG8_WAIT_L(0); PG8_BAR; PG8_MMA(0, 0, At, B0); PG8_MMA(0, 1, At, B1); PG8_BAR; PG8_SCHED;
            PG8_LDA(At, 0, 1); PG8_STAGE(PG8_SB(0, 0), b2, voffB); PG8_STAGE(PG8_SB(0, 1), b2 + hstep, voffB); PG8_STAGE(PG8_SA(0, 0), a2, voffA);
            PG8_WAIT_V(8); PG8_WAIT_L(0); PG8_BAR; PG8_MMA(1, 0, At, B0); PG8_MMA(1, 1, At, B1); PG8_BAR; PG8_SCHED;
            PG8_LDB(B0, 1, 0); PG8_LDB(B1, 1, 1); PG8_SCHED; PG8_LDA(At, 1, 0); PG8_STAGE(PG8_SA(0, 1), a2 + hstep, voffA);
            PG8_WAIT_V(8); PG8_WAIT_L(0); PG8_BAR; PG8_MMA(0, 0, At, B0); PG8_MMA(0, 1, At, B1); PG8_BAR; PG8_SCHED;
            PG8_LDA(At, 1, 1); PG8_STAGE(PG8_SB(1, 0), b3, voffB); PG8_STAGE(PG8_SB(1, 1), b3 + hstep, voffB); PG8_STAGE(PG8_SA(1, 0), a3, voffA);
            PG8_WAIT_V(8); PG8_WAIT_L(0); PG8_BAR; PG8_MMA(1, 0, At, B0); PG8_MMA(1, 1, At, B1); PG8_BAR; PG8_SCHED;
            } else {
            PG8_LDB(B0, 0, 0); PG8_SCHED; PG8_LDA(At, 0, 0); PG8_STAGE(PG8_SA(1, 1), a1 + hstep, voffA);
            PG8_WAIT_L(8); PG8_BAR; PG8_WAIT_L(0); PG8_MMA(0, 0, At, B0); PG8_BAR; PG8_SCHED;
            PG8_LDB(B1, 0, 1); PG8_STAGE(PG8_SB(0, 0), b2, voffB);
            PG8_BAR; PG8_WAIT_L(0); PG8_MMA(0, 1, At, B1); PG8_BAR;
            PG8_LDA(At, 0, 1); PG8_STAGE(PG8_SA(0, 0), a2, voffA);
            PG8_BAR; PG8_WAIT_L(0); PG8_MMA(1, 0, At, B0); PG8_BAR; PG8_SCHED;
            PG8_STAGE(PG8_SB(0, 1), b2 + hstep, voffB);
            PG8_WAIT_V(6); PG8_BAR; PG8_MMA(1, 1, At, B1); PG8_BAR;
            PG8_LDB(B0, 1, 0); PG8_SCHED; PG8_LDA(At, 1, 0); PG8_STAGE(PG8_SA(0, 1), a2 + hstep, voffA);
            PG8_WAIT_L(8); PG8_BAR; PG8_WAIT_L(0); PG8_MMA(0, 0, At, B0); PG8_BAR; PG8_SCHED;
            PG8_LDB(B1, 1, 1); PG8_STAGE(PG8_SB(1, 0), b3, voffB);
            PG8_BAR; PG8_WAIT_L(0); PG8_MMA(0, 1, At, B1); PG8_BAR;
            PG8_LDA(At, 1, 1); PG8_STAGE(PG8_SA(1, 0), a3, voffA);
            PG8_BAR; PG8_WAIT_L(0); PG8_MMA(1, 0, At, B0); PG8_BAR; PG8_SCHED;
            PG8_STAGE(PG8_SB(1, 1), b3 + hstep, voffB);
            PG8_WAIT_V(6); PG8_BAR; PG8_MMA(1, 1, At, B1); PG8_BAR;
            }
        }
        if constexpr (ALIGN_EPI) { if (wr == 0) PG8_BAR; }
        if constexpr (!Epi::AFTER_DRAIN) { E(acc, cur, wr, wc, fr, fq); S.done(cur); }
        if (!has_next) break;
#pragma unroll
        for (int a = 0; a < 2; ++a)
#pragma unroll
            for (int b = 0; b < 2; ++b)
#pragma unroll
                for (int m = 0; m < 4; ++m)
#pragma unroll
                    for (int n = 0; n < 2; ++n) acc[a][b][m][n] = (f32x4){0.f, 0.f, 0.f, 0.f};
        cur = nxt; cA = nA; cB = nB; ++ui;
        if constexpr (ALIGN_EPI) { if (wr == 1) PG8_BAR; }
    }
    PG8_WAIT_V(0);
    if constexpr (!ALIGN_EPI) { if (wr == 0) PG8_BAR; }
    PG8_BAR;
    if constexpr (Epi::AFTER_DRAIN) { E.fused(acc, cur, wr, wc, fr, fq, lds, wid, lane); S.done(cur); }
#undef PG8_SA
#undef PG8_SB
#undef PG8_STAGE
#undef PG8_LDA
#undef PG8_LDB
#undef PG8_MMA
#undef PG8_WAIT_V
#undef PG8_WAIT_L
#undef PG8_BAR
#undef PG8_SCHED
}
}
#define LAS __attribute__((address_space(3)))
typedef unsigned short bf16;
typedef short bf16x8 __attribute__((ext_vector_type(8)));
typedef short s16x4 __attribute__((ext_vector_type(4)));
typedef float f32x16 __attribute__((ext_vector_type(16)));
typedef float f32x4 __attribute__((ext_vector_type(4)));
typedef unsigned u32x4 __attribute__((ext_vector_type(4)));
typedef unsigned u32x2 __attribute__((ext_vector_type(2)));

constexpr int DM = 1024, BATCH = 16, SEQ = 2048, MTOK = BATCH * SEQ, DEPTH = 2;
constexpr int NIN_SRC = 2308, NQKV = 2304, MIXW = 768, DFF = 2816, NFF2 = 5632;
constexpr float RMS_EPS = 1e-6f, L2E = 1.4426950408889634f, QSCALE = 0.125f * 1.4426950408889634f;
constexpr int C_FQ = 0, C_FK = 256, C_FV = 512, C_DQ = 768, C_DK = 1024, C_DV = 1280, C_CQ = 1536, C_CK = 1792, C_CV = 2048;
constexpr int MX_FOX = 0, MX_DIFF = 256, MX_CHK = 512;
constexpr int NTHREADS = 512, NWAVES = 8;
constexpr size_t MiB = 1u << 20;
constexpr size_t WS_CTL = 0, WS_FF = 1 * MiB, WS_CUM = 1 * MiB + 512 * 1024;
constexpr size_t WS_WIN = 2 * MiB, WS_WOUT = 14 * MiB, WS_WFI = 18 * MiB, WS_WFO = 40 * MiB;
constexpr size_t SZ_WIN = 6 * MiB, SZ_WOUT = 2 * MiB, SZ_WFI = 11 * MiB, SZ_WFO = (size_t)DM * DFF * 2;
constexpr size_t WS_H = 52 * MiB, WS_QKV = 116 * MiB, WS_MIX = 308 * MiB, WS_UV = 116 * MiB, WS_ACT = 260 * MiB, WS_XB = 436 * MiB, WS_END = 500 * MiB;
static_assert(WS_WFO + 2 * SZ_WFO <= WS_H, "ws map");
constexpr int HALF_M = MTOK / 2;
constexpr int LDS_RING = 131072, LDS_WF = 131072, LDS_MISC = 147456, LDS_TAB = 147456 + 256, LDS_BYTES = 155648;

typedef float f32x2_t __attribute__((ext_vector_type(2))); typedef __bf16 bf16x2_t __attribute__((ext_vector_type(2)));
__device__ __forceinline__ unsigned cvtpk(float lo, float hi) { f32x2_t v = {lo, hi}; bf16x2_t b = __builtin_convertvector(v, bf16x2_t); return __builtin_bit_cast(unsigned, b); }
__device__ __forceinline__ float bf2f(unsigned short v) { return __uint_as_float((unsigned)v << 16); }
__device__ __forceinline__ float wave_sum(float v) {
#pragma unroll
    for (int o = 1; o < 64; o <<= 1) v += __shfl_xor(v, o);
    return v;
}
__device__ __forceinline__ float ex2(float v) { return __builtin_amdgcn_exp2f(v); }

struct Args { const float* in[14]; float* out; unsigned char* ws; };
struct WMeta { bf16* dst; int K; float scale; const float* gk; };
constexpr int W_I_IN = 16 * 72, W_I_OUT = 12 * 32, W_I_FI = 16 * 176, W_I_FO = 44 * 32, W_I_L = W_I_IN + W_I_OUT + W_I_FI + W_I_FO;
__device__ __forceinline__ void witem_load(const Args& a, int it, int lane, float (&wv)[32], WMeta& mt) {
    const int l = it / W_I_L; int r = it % W_I_L;
    const float* W; int K, Nsrc, nblk, mode; bf16* WT;
    if (r < W_I_IN) { W = a.in[2] + (size_t)l * DM * NIN_SRC; K = DM; Nsrc = NIN_SRC; nblk = 72; WT = (bf16*)(a.ws + WS_WIN + l * SZ_WIN); mode = 1; }
    else if ((r -= W_I_IN) < W_I_OUT) { W = a.in[7] + (size_t)l * MIXW * DM; K = MIXW; Nsrc = DM; nblk = 32; WT = (bf16*)(a.ws + WS_WOUT + l * SZ_WOUT); mode = 0; }
    else if ((r -= W_I_OUT) < W_I_FI) { W = a.in[9] + (size_t)l * DM * NFF2; K = DM; Nsrc = NFF2; nblk = 176; WT = (bf16*)(a.ws + WS_WFI + l * SZ_WFI); mode = 2; }
    else { r -= W_I_FI; W = a.in[12] + (size_t)l * DFF * DM; K = DFF; Nsrc = DM; nblk = 32; WT = (bf16*)(a.ws + WS_WFO + l * SZ_WFO); mode = 0; }
    const int kb = r / nblk, nb = r % nblk, k0 = 64 * kb, n0 = 32 * nb;
    int sc0 = n0; float scale = 1.f;
    if (mode == 2) sc0 = (n0 >> 8) * 128 + (n0 & 127) + ((n0 & 128) ? DFF : 0);
    if (mode == 1) { sc0 = n0 + (n0 >= 768 ? 4 : 0);
        if ((n0 >= C_FQ && n0 < C_FK) || (n0 >= C_DQ && n0 < C_DK) || (n0 >= C_CQ && n0 < C_CK)) scale = QSCALE; }
    const float* src = W + (size_t)(k0 + (lane >> 5)) * Nsrc + sc0 + (lane & 31);
#pragma unroll
    for (int i = 0; i < 32; ++i) wv[i] = src[(size_t)(2 * i) * Nsrc];
    mt.dst = WT + (size_t)n0 * K + k0; mt.K = K; mt.scale = scale; mt.gk = (mode == 1) ? a.in[1] + (size_t)l * DM + k0 : (mode == 2) ? a.in[8] + (size_t)l * DM + k0 : nullptr;
}
__device__ __forceinline__ void witem_store(const WMeta& mt, const float (&wv)[32], LAS float* scr, int lane) {
#pragma unroll
    for (int i = 0; i < 32; ++i) { const int kk = 2 * i + (lane >> 5); scr[kk * 33 + (lane & 31)] = wv[i] * (mt.gk ? mt.scale * mt.gk[kk] : mt.scale); }
    asm volatile("s_waitcnt lgkmcnt(0)" ::: "memory");
    const int c = lane & 7;
#pragma unroll
    for (int j = 0; j < 4; ++j) { const int n = (lane >> 3) + 8 * j; const LAS float* s = scr + (8 * c) * 33 + n;
        u32x4 o; o.x = cvtpk(s[0 * 33], s[1 * 33]); o.y = cvtpk(s[2 * 33], s[3 * 33]); o.z = cvtpk(s[4 * 33], s[5 * 33]); o.w = cvtpk(s[6 * 33], s[7 * 33]);
        *(u32x4*)(mt.dst + (size_t)n * mt.K + 8 * c) = o; }
}
__device__ __forceinline__ void phase_weights(const Args& a, LAS unsigned char* lds, int gw, int NGW, int wave, int lane) {
    LAS float* scr = (LAS float*)(lds + wave * 16896);
    for (int it = gw; it < DEPTH * W_I_L; it += 2 * NGW) {
        float wa[32], wb[32]; WMeta ma, mb; const bool two = it + NGW < DEPTH * W_I_L;
        witem_load(a, it, lane, wa, ma);
        if (two) witem_load(a, it + NGW, lane, wb, mb);
        witem_store(ma, wa, scr, lane);
        if (two) witem_store(mb, wb, scr + 64 * 33, lane);
        asm volatile("s_waitcnt lgkmcnt(0)" ::: "memory");
    }
}

template <bool XBF> struct RowLd;
template <> struct RowLd<false> { typedef f32x4 raw; static __device__ __forceinline__ raw ld(const void* x, size_t m, int lane, int j) { return *((const f32x4*)((const float*)x + m * DM) + lane + 64 * j); }
    static __device__ __forceinline__ f32x4 cv(raw r) { return r; } };
template <> struct RowLd<true> { typedef u32x2 raw; static __device__ __forceinline__ raw ld(const void* x, size_t m, int lane, int j) { return *((const u32x2*)((const bf16*)x + m * DM) + lane + 64 * j); }
    static __device__ __forceinline__ f32x4 cv(raw r) { f32x4 v; v.x = __uint_as_float(r.x << 16); v.y = __uint_as_float(r.x & 0xffff0000u); v.z = __uint_as_float(r.y << 16); v.w = __uint_as_float(r.y & 0xffff0000u); return v; } };
template <int MODE, bool XBF>
__device__ __forceinline__ void phase_norm(const void* x, const float* g, bf16* H, float* outf, const float* w_in_l, const float* b_fox, float* FF,
                                           LAS unsigned char* lds, int gw, int NGW, int tid, int lane) {
    LAS f32x4* wf = (LAS f32x4*)(lds + LDS_WF);
    if (MODE == 1) {
        __syncthreads();
        for (int k = tid; k < DM; k += NTHREADS) wf[k] = *(const f32x4*)(w_in_l + (size_t)k * NIN_SRC + 768);
        __syncthreads();
    }
    f32x4 gv[4];
#pragma unroll
    for (int j = 0; j < 4; ++j) gv[j] = *((const f32x4*)g + lane + 64 * j);
    f32x4 v[4]; typename RowLd<XBF>::raw vn[4];
    if (gw < MTOK) {
#pragma unroll
        for (int j = 0; j < 4; ++j) vn[j] = RowLd<XBF>::ld(x, (size_t)gw, lane, j); }
    for (int m = gw; m < MTOK; m += NGW) {
        float s = 0.f;
#pragma unroll
        for (int j = 0; j < 4; ++j) v[j] = RowLd<XBF>::cv(vn[j]);
        if (m + NGW < MTOK) {
#pragma unroll
            for (int j = 0; j < 4; ++j) vn[j] = RowLd<XBF>::ld(x, (size_t)(m + NGW), lane, j); }
#pragma unroll
        for (int j = 0; j < 4; ++j) s += (v[j].x * v[j].x + v[j].y * v[j].y) + (v[j].z * v[j].z + v[j].w * v[j].w);
        const float rstd = 1.0f / sqrtf(wave_sum(s) * (1.f / DM) + RMS_EPS);
        if (MODE == 3) { if (lane == 0) outf[m] = rstd; continue; }
        if (MODE == 1) {
            if (!XBF) { u32x2* o = (u32x2*)(H + (size_t)m * DM) + lane;
#pragma unroll
                for (int j = 0; j < 4; ++j) { u32x2 w; w.x = cvtpk(v[j].x, v[j].y); w.y = cvtpk(v[j].z, v[j].w); o[64 * j] = w; } }
            if (lane == 0) outf[m] = rstd;
        }
#pragma unroll
        for (int j = 0; j < 4; ++j) v[j] = v[j] * rstd * gv[j];
        if (MODE == 2) {
            f32x4* o = (f32x4*)(outf + (size_t)m * DM) + lane;
#pragma unroll
            for (int j = 0; j < 4; ++j) o[64 * j] = v[j];
        } else if (MODE == 0) {
            u32x2* o = (u32x2*)(H + (size_t)m * DM) + lane;
#pragma unroll
            for (int j = 0; j < 4; ++j) { u32x2 w; w.x = cvtpk(v[j].x, v[j].y); w.y = cvtpk(v[j].z, v[j].w); o[64 * j] = w; }
        }
        if (MODE == 1) {
            f32x4 d = {0.f, 0.f, 0.f, 0.f};
#pragma unroll
            for (int j = 0; j < 4; ++j) { const int k = 4 * lane + 256 * j;
                d += wf[k] * v[j].x; d += wf[k + 1] * v[j].y; d += wf[k + 2] * v[j].z; d += wf[k + 3] * v[j].w; }
            d.x = wave_sum(d.x); d.y = wave_sum(d.y); d.z = wave_sum(d.z); d.w = wave_sum(d.w);
            if (lane < 4) { float z = (lane == 0 ? d.x : lane == 1 ? d.y : lane == 2 ? d.z : d.w) + b_fox[lane];
                const float ls = fminf(z, 0.f) - log1pf(expf(-fabsf(z)));
                FF[(size_t)m * 4 + lane] = ls; }
        }
    }
}

__device__ __forceinline__ void cumsum_seq(const float* FF, float* CUM, int bh, int lane) {
    const int b = bh >> 2, h = bh & 3;
    const float* src = FF + ((size_t)b * SEQ + 32 * lane) * 4 + h;
    float v[32]; float s = 0.f;
#pragma unroll
    for (int i = 0; i < 32; ++i) { s += src[4 * i]; v[i] = s; }
    float inc = s;
#pragma unroll
    for (int o = 1; o < 64; o <<= 1) { const float t = __shfl_up(inc, o); if (lane >= o) inc += t; }
    const float excl = inc - s;
    float* dst = CUM + (size_t)bh * SEQ + 32 * lane;
#pragma unroll
    for (int i = 0; i < 32; i += 4) { f32x4 w = {v[i] + excl, v[i + 1] + excl, v[i + 2] + excl, v[i + 3] + excl}; *(f32x4*)(dst + i) = w; }
}

__device__ __forceinline__ void unpack8(const u32x4 a, float (&f)[8]) {
#pragma unroll
    for (int i = 0; i < 4; ++i) { f[2 * i] = __uint_as_float(a[i] << 16); f[2 * i + 1] = __uint_as_float(a[i] & 0xffff0000u); } }
__device__ __forceinline__ void phase_fixup(const bf16* HALO, bf16* ACT, const float* cw, const float* cb, int gt, int NGT) {
    constexpr int NCG = DFF / 8, NG = MTOK / 64;
    for (int it = gt; it < NG * 2 * NCG; it += NGT) {
        const int cg8 = it % NCG, rs = it / NCG, s = rs & 1, j = rs >> 1, c0 = cg8 * 8;
        const bool first = ((j * 64) % SEQ) == 0;
        const bf16* hj = HALO + (size_t)j * 4 * NFF2; const bf16* hp = hj - 4 * NFF2;
        const bf16* pt = hj + (size_t)s * NFF2;
        const bf16* p1 = (s == 0) ? hp + 3 * NFF2 : hj;
        const bf16* p2 = (s == 0) ? hp + 2 * NFF2 : hp + 3 * NFF2;
        const u32x4 z = {0u, 0u, 0u, 0u};
        float ut[8], u1[8], u2[8], gt_[8], g1[8], g2[8];
        unpack8(*(const u32x4*)(pt + c0), ut); unpack8(*(const u32x4*)(pt + DFF + c0), gt_);
        unpack8((s == 0 && first) ? z : *(const u32x4*)(p1 + c0), u1); unpack8((s == 0 && first) ? z : *(const u32x4*)(p1 + DFF + c0), g1);
        unpack8(first ? z : *(const u32x4*)(p2 + c0), u2); unpack8(first ? z : *(const u32x4*)(p2 + DFF + c0), g2);
        float o[8];
#pragma unroll
        for (int i = 0; i < 8; ++i) { const int c = c0 + i;
            const float yu = cb[c] + cw[c] * u2[i] + cw[NFF2 + c] * u1[i] + cw[2 * NFF2 + c] * ut[i];
            const float yg = cb[DFF + c] + cw[DFF + c] * g2[i] + cw[NFF2 + DFF + c] * g1[i] + cw[2 * NFF2 + DFF + c] * gt_[i];
            o[i] = yu * yg / (1.f + __expf(-yg)); }
        u32x4 w; w.x = cvtpk(o[0], o[1]); w.y = cvtpk(o[2], o[3]); w.z = cvtpk(o[4], o[5]); w.w = cvtpk(o[6], o[7]);
        *(u32x4*)(ACT + (size_t)(j * 64 + s) * DFF + c0) = w;
    }
}
__device__ __forceinline__ s16x4 vtr(LAS const char* p) { typedef short v4i16_t __attribute__((ext_vector_type(4))); return __builtin_bit_cast(s16x4, __builtin_amdgcn_ds_read_tr16_b64_v4i16((LAS v4i16_t*)p)); }
constexpr int KROWB = 144, KT_BYTES = 64 * KROWB;

__device__ __forceinline__ void qk_tile(f32x16& p0, f32x16& p1, LAS const char* kt, const bf16x8 (&qr)[4], int r32, int hi) {
    LAS const char* kb = kt + r32 * KROWB + hi * 16;
#pragma unroll
    for (int ks = 0; ks < 4; ++ks) {
        const bf16x8 a0 = *(LAS const bf16x8*)(kb + ks * 32), a1 = *(LAS const bf16x8*)(kb + 32 * KROWB + ks * 32);
        p0 = __builtin_amdgcn_mfma_f32_32x32x16_bf16(a0, qr[ks], p0, 0, 0, 0);
        p1 = __builtin_amdgcn_mfma_f32_32x32x16_bf16(a1, qr[ks], p1, 0, 0, 0);
    }
}
template <int NDB>
__device__ __forceinline__ void softmax_pv(f32x16& p0, f32x16& p1, float& m, float& l, f32x16 (&o)[NDB], LAS const char* vt, int vb) {
    float mx = fmaxf(p0[0], p1[0]);
#pragma unroll
    for (int r = 1; r < 16; ++r) mx = fmaxf(mx, fmaxf(p0[r], p1[r]));
    mx = fmaxf(mx, __shfl_xor(mx, 32));
    if (__builtin_amdgcn_ballot_w64(mx > m) != 0ull) {
        const float mn = fmaxf(m, mx);
        const float alpha = ex2(m - mn);
        m = mn; l *= alpha;
#pragma unroll
        for (int db = 0; db < NDB; ++db)
#pragma unroll
            for (int r = 0; r < 16; ++r) o[db][r] *= alpha;
    }
    const float mn = m;
    float rs = 0.f;
#pragma unroll
    for (int r = 0; r < 16; ++r) { p0[r] = ex2(p0[r] - mn); p1[r] = ex2(p1[r] - mn); rs += p0[r] + p1[r]; }
    l += rs;
    bf16x8 pf[4];
    { u32x4 w;
      w.x = cvtpk(p0[0], p0[1]); w.y = cvtpk(p0[2], p0[3]); w.z = cvtpk(p0[4], p0[5]); w.w = cvtpk(p0[6], p0[7]); pf[0] = __builtin_bit_cast(bf16x8, w);
      w.x = cvtpk(p0[8], p0[9]); w.y = cvtpk(p0[10], p0[11]); w.z = cvtpk(p0[12], p0[13]); w.w = cvtpk(p0[14], p0[15]); pf[1] = __builtin_bit_cast(bf16x8, w);
      w.x = cvtpk(p1[0], p1[1]); w.y = cvtpk(p1[2], p1[3]); w.z = cvtpk(p1[4], p1[5]); w.w = cvtpk(p1[6], p1[7]); pf[2] = __builtin_bit_cast(bf16x8, w);
      w.x = cvtpk(p1[8], p1[9]); w.y = cvtpk(p1[10], p1[11]); w.z = cvtpk(p1[12], p1[13]); w.w = cvtpk(p1[14], p1[15]); pf[3] = __builtin_bit_cast(bf16x8, w); }
#pragma unroll
    for (int kk = 0; kk < 4; ++kk)
#pragma unroll
        for (int db = 0; db < NDB; ++db) {
            const s16x4 lo = vtr(vt + vb + db * 4096 + kk * 1024), hh = vtr(vt + vb + db * 4096 + kk * 1024 + 512);
            const bf16x8 vf = {lo[0], lo[1], lo[2], lo[3], hh[0], hh[1], hh[2], hh[3]};
            o[db] = __builtin_amdgcn_mfma_f32_32x32x16_bf16(vf, pf[kk], o[db], 0, 0, 0);
        }
}

template <int MODE>
__device__ __forceinline__ void attn_unit64(const bf16* qkv, bf16* mix, const float* cum_bh, int b, int h, int blk, LAS unsigned char* lds, int tid, int wave, int lane) {
    constexpr int CUMOFF = KT_BYTES + 8192, BUFSZ = CUMOFF + 256;
    const int r32 = lane & 31, hi = lane >> 5;
    const size_t rowbase = (size_t)b * SEQ;
    const int Q0 = blk * 256, qw0 = Q0 + 32 * wave;
    const int CQ = (MODE == 0 ? C_FQ : C_CQ) + h * 64, CK = (MODE == 0 ? C_FK : C_CK) + h * 64, CV = (MODE == 0 ? C_FV : C_CV) + h * 64;
    const int c0 = 4 * blk, cw = c0 + (wave >> 1);
    int tbeg, tend, kvoff;
    if (MODE == 0) { tbeg = 0; tend = 4 * (blk + 1); kvoff = 0; }
    else { tbeg = (c0 >= 8) ? 0 : 8 - c0; tend = 12; kvoff = (c0 - 8) * 64; }
    const int srow = tid >> 3, sch = tid & 7;
    const bf16* kg = qkv + (rowbase + kvoff + srow) * NQKV + CK + sch * 8;
    const bf16* vg = qkv + (rowbase + kvoff + srow) * NQKV + CV + sch * 8;
    const int kdst = srow * KROWB + sch * 16, vdst = KT_BYTES + (sch >> 2) * 4096 + srow * 64 + (sch & 3) * 16;
    const float cref = (MODE == 0) ? cum_bh[Q0] : 0.f;
#define U64_LOAD(K, V, C, tt) do { if ((tt) >= tbeg) { K = *(const u32x4*)(kg + (size_t)(tt) * 64 * NQKV); V = *(const u32x4*)(vg + (size_t)(tt) * 64 * NQKV); \
        if (MODE == 0 && tid < 16) C = *(const f32x4*)(cum_bh + (tt) * 64 + 4 * tid); } } while (0)
#define U64_STAGE(K, V, C, buf) do { *(LAS u32x4*)((buf) + kdst) = K; *(LAS u32x4*)((buf) + vdst) = V; if (MODE == 0 && tid < 16) *(LAS f32x4*)((buf) + CUMOFF + tid * 16) = (cref - C) * L2E; } while (0)
#define LDS_BAR() asm volatile("s_waitcnt lgkmcnt(0)\n\ts_barrier" ::: "memory")
    u32x4 kA = {0u, 0u, 0u, 0u}, vA = kA, kB = kA, vB = kA; f32x4 cA = {0.f, 0.f, 0.f, 0.f}, cB = cA;
    U64_LOAD(kA, vA, cA, tend - 1); U64_LOAD(kB, vB, cB, tend - 2);
    bf16x8 qr[4];
#pragma unroll
    for (int ks = 0; ks < 4; ++ks) qr[ks] = *(const bf16x8*)(qkv + (rowbase + qw0 + r32) * NQKV + CQ + ks * 16 + hi * 8);
    float m = -1e30f, l = 0.f;
    f32x16 o[2];
#pragma unroll
    for (int db = 0; db < 2; ++db)
#pragma unroll
        for (int r = 0; r < 16; ++r) o[db][r] = 0.f;
    const int vb = (4 * hi + ((lane & 15) >> 2)) * 64 + ((lane >> 4) & 1) * 32 + (lane & 3) * 8;
    LAS const float* tab = (LAS const float*)(lds + LDS_TAB) + h * 192;
    auto compute = [&](const int t, LAS unsigned char* const buf) __attribute__((always_inline)) {
        const int kv0 = kvoff + 64 * t;
        bool doit;
        if (MODE == 0) doit = kv0 <= qw0 + 31; else { const int kc = c0 - 8 + t; doit = (kc >= cw - 8) && (kc <= cw); }
        if (doit) {
            f32x16 p0 = (f32x16){0.f, 0.f, 0.f, 0.f, 0.f, 0.f, 0.f, 0.f, 0.f, 0.f, 0.f, 0.f, 0.f, 0.f, 0.f, 0.f}, p1 = p0;
            if (MODE == 2 && cw - (c0 - 8 + t) >= 3) { const float bv = tab[191];
#pragma unroll
                for (int r = 0; r < 16; ++r) { p0[r] = bv; p1[r] = bv; } }
            if (MODE == 0) {
#pragma unroll
                for (int g = 0; g < 4; ++g) { const f32x4 ca = *(LAS const f32x4*)(buf + CUMOFF + (8 * g + 4 * hi) * 4), cb = *(LAS const f32x4*)(buf + CUMOFF + (32 + 8 * g + 4 * hi) * 4);
#pragma unroll
                    for (int i = 0; i < 4; ++i) { p0[4 * g + i] = ca[i]; p1[4 * g + i] = cb[i]; } }
            }
            qk_tile(p0, p1, (LAS const char*)buf, qr, r32, hi);
            if (MODE == 0) {
                if (kv0 + 63 > qw0) {
                    const int qa = qw0 + r32 - kv0 - 4 * hi;
#pragma unroll
                    for (int r = 0; r < 16; ++r) { const int kl = (r & 3) + 8 * (r >> 2); if (kl > qa) p0[r] = -INFINITY; if (kl + 32 > qa) p1[r] = -INFINITY; }
                }
            } else {
                const int dc = cw - (c0 - 8 + t);
                if (dc < 3) {
                    const int rel0 = qw0 + r32 - kv0 - 4 * hi + 63;
#pragma unroll
                    for (int r = 0; r < 16; ++r) { const int kl = (r & 3) + 8 * (r >> 2);
                        int i0 = rel0 - kl, i1 = rel0 - kl - 32; i0 = i0 < 0 ? 0 : (i0 > 191 ? 191 : i0); i1 = i1 < 0 ? 0 : (i1 > 191 ? 191 : i1);
                        p0[r] += tab[i0]; p1[r] += tab[i1]; }
                }
            }
            softmax_pv<2>(p0, p1, m, l, o, (LAS const char*)buf + KT_BYTES, vb);
        }
    };
    int pi = 0;
    for (int t = tend - 1; t >= tbeg; t -= 2, pi ^= 1) {
        LAS unsigned char* const sb = lds + (pi ? 2 * BUFSZ : 0); const bool two = (t - 1 >= tbeg);
        U64_STAGE(kA, vA, cA, sb); if (two) U64_STAGE(kB, vB, cB, sb + BUFSZ);
        LDS_BAR();
        U64_LOAD(kA, vA, cA, t - 2); U64_LOAD(kB, vB, cB, t - 3);
        compute(t, sb); if (two) compute(t - 1, sb + BUFSZ);
    }
#undef U64_LOAD
#undef U64_STAGE
    l += __shfl_xor(l, 32);
    const float inv = 1.0f / l;
    bf16* orow = mix + (rowbase + qw0 + r32) * MIXW + (MODE == 0 ? MX_FOX : MX_CHK) + h * 64 + 4 * hi;
#pragma unroll
    for (int db = 0; db < 2; ++db)
#pragma unroll
        for (int g = 0; g < 4; ++g) { u32x2 w; w.x = cvtpk(o[db][4 * g] * inv, o[db][4 * g + 1] * inv); w.y = cvtpk(o[db][4 * g + 2] * inv, o[db][4 * g + 3] * inv);
            *(u32x2*)(orow + 32 * db + 8 * g) = w; }
    __syncthreads();
}

template <int C>
__device__ __forceinline__ void diff_pass(const bf16* qkv, bf16* mix, float* park, int b, int h, int blk, float lam, float sl2, const float* gdiff, float outscale,
                                          LAS unsigned char* lds, int tid, int wave, int lane) {
    constexpr int VOFF = KT_BYTES, BUFSZ = VOFF + 16384;
    const int r32 = lane & 31, hi = lane >> 5;
    const size_t rowbase = (size_t)b * SEQ;
    const int Q0 = blk * 256, qw0 = Q0 + 32 * wave, cwv = qw0 >> 6, tend = 4 * (blk + 1);
    const int srow = tid >> 3, sch = tid & 7;
    const int vrow0 = tid >> 4, vch = tid & 15;
    const bf16* vg = qkv + (rowbase + vrow0) * NQKV + C_DV + h * 128 + vch * 8;
    const int kdst = srow * KROWB + sch * 16, vdst = VOFF + (vch >> 2) * 4096 + vrow0 * 64 + (vch & 3) * 16;
    const int vb = (4 * hi + ((lane & 15) >> 2)) * 64 + ((lane >> 4) & 1) * 32 + (lane & 3) * 8;
    const bf16* kg = qkv + (rowbase + srow) * NQKV + C_DK + h * 128 + C * 64 + sch * 8;
#define DF_LOAD(K, V0, V1, tt) do { if ((tt) >= 0) { const size_t go_ = (size_t)(tt) * 64 * NQKV; K = *(const u32x4*)(kg + go_); V0 = *(const u32x4*)(vg + go_); V1 = *(const u32x4*)(vg + go_ + (size_t)32 * NQKV); } } while (0)
#define DF_STAGE(K, V0, V1, buf) do { *(LAS u32x4*)((buf) + kdst) = K; *(LAS u32x4*)((buf) + vdst) = V0; *(LAS u32x4*)((buf) + vdst + 32 * 64) = V1; } while (0)
    u32x4 kA = {0u, 0u, 0u, 0u}, v0A = kA, v1A = kA, kB = kA, v0B = kA, v1B = kA;
    DF_LOAD(kA, v0A, v1A, tend - 1); DF_LOAD(kB, v0B, v1B, tend - 2);
    bf16x8 qr[4];
#pragma unroll
    for (int ks = 0; ks < 4; ++ks) qr[ks] = *(const bf16x8*)(qkv + (rowbase + qw0 + r32) * NQKV + C_DQ + h * 128 + C * 64 + ks * 16 + hi * 8);
    float m = -1e30f, l = 0.f;
    f32x16 o[4];
#pragma unroll
    for (int db = 0; db < 4; ++db)
#pragma unroll
        for (int r = 0; r < 16; ++r) o[db][r] = 0.f;
    f32x16 ab;
#pragma unroll
    for (int r = 0; r < 16; ++r) ab[r] = sl2 * (float)((r & 3) + 8 * (r >> 2) + 4 * hi);
    auto compute = [&](const int t, LAS unsigned char* const buf) __attribute__((always_inline)) {
        if (t <= cwv) {
            const int kv0 = 64 * t;
            f32x16 p0, p1;
            if (t < cwv) { const float d0 = sl2 * (float)(64 * (t - cwv)), d1 = d0 + 32.f * sl2;
#pragma unroll
                for (int r = 0; r < 16; ++r) { p0[r] = ab[r] + d0; p1[r] = ab[r] + d1; }
                qk_tile(p0, p1, (LAS const char*)buf, qr, r32, hi);
            } else { p0 = (f32x16){0.f, 0.f, 0.f, 0.f, 0.f, 0.f, 0.f, 0.f, 0.f, 0.f, 0.f, 0.f, 0.f, 0.f, 0.f, 0.f}; p1 = p0;
                qk_tile(p0, p1, (LAS const char*)buf, qr, r32, hi);
                const float ql = (float)(qw0 + r32 - kv0), base = ql - (float)(4 * hi);
#pragma unroll
                for (int r = 0; r < 16; ++r) { const float kl = (float)((r & 3) + 8 * (r >> 2)); p0[r] += sl2 * (ql - fabsf(base - kl)); p1[r] += sl2 * (ql - fabsf(base - kl - 32.f)); }
            }
            softmax_pv<4>(p0, p1, m, l, o, (LAS const char*)buf + VOFF, vb);
        }
    };
    int pi = 0;
    for (int t = tend - 1; t >= 0; t -= 2, pi ^= 1) {
        LAS unsigned char* const sb = lds + (pi ? 2 * BUFSZ : 0);
        DF_STAGE(kA, v0A, v1A, sb); DF_STAGE(kB, v0B, v1B, sb + BUFSZ);
        LDS_BAR();
        DF_LOAD(kA, v0A, v1A, t - 2); DF_LOAD(kB, v0B, v1B, t - 3);
        compute(t, sb); compute(t - 1, sb + BUFSZ);
    }
#undef DF_LOAD
#undef DF_STAGE
    l += __shfl_xor(l, 32);
    const float inv = 1.0f / l;
    if (C == 0) {
#pragma unroll
        for (int db = 0; db < 4; ++db)
#pragma unroll
            for (int r = 0; r < 16; ++r) park[(db * 16 + r) * NTHREADS] = o[db][r] * inv;
    } else {
        const float li = lam * inv;
        float ss = 0.f;
#pragma unroll
        for (int db = 0; db < 4; ++db) {
#pragma unroll
            for (int r = 0; r < 16; ++r) { const float v = park[(db * 16 + r) * NTHREADS] - o[db][r] * li; o[db][r] = v; ss += v * v; }
            asm volatile("" ::: "memory"); }
        ss += __shfl_xor(ss, 32);
        const float rn = outscale / sqrtf(ss * (1.f / 128.f) + RMS_EPS);
        bf16* orow = mix + (rowbase + qw0 + r32) * MIXW + MX_DIFF + h * 128 + 4 * hi;
#pragma unroll
        for (int db = 0; db < 4; ++db)
#pragma unroll
            for (int g = 0; g < 4; ++g) { const f32x4 gg = *(const f32x4*)(gdiff + 32 * db + 8 * g + 4 * hi);
                u32x2 w; w.x = cvtpk(o[db][4 * g] * rn * gg.x, o[db][4 * g + 1] * rn * gg.y); w.y = cvtpk(o[db][4 * g + 2] * rn * gg.z, o[db][4 * g + 3] * rn * gg.w);
                *(u32x2*)(orow + 32 * db + 8 * g) = w; }
    }
    __syncthreads();
}
__device__ __forceinline__ void attn_unit_diff2(const bf16* qkv, bf16* mix, int b, int h, int blk, float lam, float sl2, const float* gdiff, float outscale,
                                                LAS unsigned char* lds, int tid, int wave, int lane) {
    float* park = (float*)((unsigned char*)qkv - WS_QKV + WS_H) + (size_t)blockIdx.x * 64 * NTHREADS + tid;
    diff_pass<0>(qkv, mix, park, b, h, blk, lam, sl2, gdiff, outscale, lds, tid, wave, lane);
    int tid2 = threadIdx.x; asm volatile("" : "+v"(tid2) :: "memory"); __builtin_amdgcn_sched_barrier(0);
    float* park2 = (float*)((unsigned char*)qkv - WS_QKV + WS_H) + (size_t)blockIdx.x * 64 * NTHREADS + tid2;
    diff_pass<1>(qkv, mix, park2, b, h, blk, lam, sl2, gdiff, outscale, lds, tid2, __builtin_amdgcn_readfirstlane(tid2 >> 6), tid2 & 63);
}
#define SF(q) (0 << 5 | (q) << 1 | 0), (0 << 5 | (q) << 1 | 1)
#define SD(q) (1 << 5 | (q) << 1 | 0)
#define SC(q) (2 << 5 | (q) << 1 | 0), (2 << 5 | (q) << 1 | 1)
__device__ __forceinline__ int seg_code(int s) {
    constexpr unsigned char T[40] = { SD(7), SD(6), SD(5), SD(4), SD(3), SF(7), SD(2), SF(6), SF(5), SD(1), SF(4), SF(3), SD(0), SF(2),
        SC(7), SC(6), SC(5), SC(4), SC(3), SC(2), SC(1), SC(0), SF(1), SF(0) };
    return T[s];
}
__device__ __forceinline__ void phase_attn(const Args& a, int layer, unsigned* ctr, LAS unsigned char* lds, int tid0, int wave0, int lane0) {
    const bf16* qkv = (const bf16*)(a.ws + WS_QKV); bf16* mix = (bf16*)(a.ws + WS_MIX); const float* CUM = (const float*)(a.ws + WS_CUM);
    for (int i = tid0; i < 4 * 192; i += NTHREADS) ((LAS float*)(lds + LDS_TAB))[i] = a.in[6][(size_t)layer * 768 + i] * L2E;
    const float* dl = a.in[4] + (size_t)layer * 256;
    const float s01 = wave_sum(dl[lane0] * dl[64 + lane0]), s23 = wave_sum(dl[128 + lane0] * dl[192 + lane0]);
    const float lambda_init = 0.8f - 0.6f * expf(-0.3f * (float)layer);
    const float lam = expf(s01) - expf(s23) + lambda_init;
    const float* gdiff = a.in[5] + (size_t)layer * 128;
    LAS volatile unsigned* misc = (LAS volatile unsigned*)(lds + LDS_MISC);
    __syncthreads();
    for (;;) {
        if (threadIdx.x == 0) misc[0] = atomicAdd(ctr, 1u);
        __syncthreads();
        const unsigned idx = misc[0];
        int tidf = threadIdx.x; asm volatile("" : "+v"(tidf) :: "memory"); __builtin_amdgcn_sched_barrier(0);
        const int tid = tidf, lane = tidf & 63, wave = __builtin_amdgcn_readfirstlane(tidf >> 6);
        if (idx >= 1280u) break;
        const int code = seg_code((int)(idx >> 5)), kind = code >> 5, blk = (code >> 1) & 15, sub = (int)(idx & 31);
        if (kind == 1) { const int b = sub >> 1, h = sub & 1;
            attn_unit_diff2(qkv, mix, b, h, blk, lam, exp2f(-4.0f * (float)(h + 1)) * L2E, gdiff, 1.0f - lambda_init, lds, tid, wave, lane); }
        else { const int bh = (code & 1) * 32 + sub, b = bh >> 2, h = bh & 3;
            if (kind == 0) attn_unit64<0>(qkv, mix, CUM + (size_t)bh * SEQ, b, h, blk, lds, tid, wave, lane);
            else attn_unit64<2>(qkv, mix, nullptr, b, h, blk, lds, tid, wave, lane); }
    }
}
#define XB_TMO      128
#define XB_XCNT(j)  (256  + 64 * (j))
#define XB_XSUB(j)  (1280 + 64 * (j))
#define XB_XGEN(j)  (2304 + 64 * (j))
#define XB_TOP      3328
#define XB_TOPGEN   3392
#define XCD_BAR_WORDS 3456
#define XB_SPIN_CAP (1u << 18)

__device__ __forceinline__ unsigned xb_ld(unsigned* p)              { return __hip_atomic_load(p, __ATOMIC_RELAXED, __HIP_MEMORY_SCOPE_AGENT); }
__device__ __forceinline__ unsigned xb_add(unsigned* p, unsigned v) { return __hip_atomic_fetch_add(p, v, __ATOMIC_RELAXED, __HIP_MEMORY_SCOPE_AGENT); }
__device__ __forceinline__ unsigned xb_xcc_id() { return (unsigned)__builtin_amdgcn_s_getreg((3 << 11) | 20) & 0xFu; }
#define XB_SPIN(cond, bar) do { unsigned _sp = 0; while (cond) { __builtin_amdgcn_s_sleep(1); \
    if ((++_sp & 255u) == 0u) { if (xb_ld(&(bar)[XB_TMO])) break; if (_sp > XB_SPIN_CAP) { atomicAdd(&(bar)[XB_TMO], 1u); break; } } } } while (0)

struct XcdBarrier {
    unsigned* bar; unsigned x;
    volatile LAS unsigned* st;
};

__device__ __forceinline__ XcdBarrier xcd_barrier_post(unsigned* bar, volatile LAS unsigned* st) {
    XcdBarrier b; b.bar = bar; b.x = xb_xcc_id(); b.st = st;
    if (threadIdx.x == 0) (void)xb_add(&bar[XB_XCNT(b.x)], 1u);
    return b;
}
__device__ __forceinline__ void xcd_barrier_complete(unsigned* bar, unsigned x, unsigned& nloc, unsigned& nx) {
    const unsigned G = gridDim.x * gridDim.y * gridDim.z;
    unsigned sum, cnt, mine, sp = 0u;
    for (;;) {
        sum = 0u; cnt = 0u; mine = 0u;
#pragma unroll
        for (unsigned j = 0; j < 16; ++j) { const unsigned c = xb_ld(&bar[XB_XCNT(j)]); sum += c; cnt += (c > 0u) ? 1u : 0u; mine = (j == x) ? c : mine; }
        if (sum == G) break;
        __builtin_amdgcn_s_sleep(1);
        if ((++sp & 255u) == 0u) { if (xb_ld(&bar[XB_TMO])) break; if (sp > XB_SPIN_CAP) { atomicAdd(&bar[XB_TMO], 1u); break; } }
    }
    nloc = mine > 0u ? mine : 1u; nx = cnt > 0u ? cnt : 1u;
}

__device__ __forceinline__ void xcd_barrier(const XcdBarrier& b) {
    asm volatile("s_waitcnt vmcnt(0)" ::: "memory");
    __syncthreads();
    if (threadIdx.x == 0) {
        unsigned* bar = b.bar;
        __builtin_amdgcn_s_waitcnt(0);
        unsigned nloc = b.st[0], nx = b.st[1];
        if (nloc == 0u) { xcd_barrier_complete(bar, b.x, nloc, nx); b.st[0] = nloc; b.st[1] = nx; }
        const unsigned old = xb_add(&bar[XB_XSUB(b.x)], 1u);
        const unsigned gen = old / nloc;
        if (old + 1u == (gen + 1u) * nloc) {
            __builtin_amdgcn_fence(__ATOMIC_RELEASE, "agent");
            asm volatile("s_waitcnt vmcnt(0)" ::: "memory");
            const unsigned og = xb_add(&bar[XB_TOP], 1u);
            const unsigned tg = og / nx;
            if (og + 1u == (tg + 1u) * nx) xb_add(&bar[XB_TOPGEN], 1u);
            else XB_SPIN(xb_ld(&bar[XB_TOPGEN]) == tg, bar);
            __builtin_amdgcn_fence(__ATOMIC_ACQUIRE, "agent");
            xb_add(&bar[XB_XGEN(b.x)], 1u);
            asm volatile("s_waitcnt vmcnt(0)" ::: "memory");
        } else {
            XB_SPIN(xb_ld(&bar[XB_XGEN(b.x)]) == gen, bar);
            __builtin_amdgcn_fence(__ATOMIC_ACQUIRE, "agent");
            asm volatile("s_waitcnt vmcnt(0)" ::: "memory");
        }
    }
    __syncthreads();
}

#define GEMM_RUN(EPI, Aptr, Bptr, Mv, Nv, Kv, Eobj) GEMM_RUN2(EPI, Aptr, Bptr, Mv, Nv, Kv, Eobj, true, true)
#define GEMM_RUN2(EPI, Aptr, Bptr, Mv, Nv, Kv, Eobj, ALIGNV, SP2V) do { pg8::Gemm g_{(const pg8::bf16_t*)(Aptr), (const pg8::bf16_t*)(Bptr), (Mv), (Nv), (Kv)}; pg8::StaticOrder S_; S_.init((Mv), (Nv), (int)gridDim.x, (int)blockIdx.x); \
    pg8::gemm_phase<EPI, pg8::StaticOrder, ALIGNV, SP2V>(lds, g_, S_, Eobj); } while (0)

__global__ void __launch_bounds__(NTHREADS, 2) mk_fwd(Args a) {
    __shared__ __attribute__((aligned(16))) unsigned char lds_raw[LDS_BYTES];
    LAS unsigned char* lds = (LAS unsigned char*)lds_raw;
    cg::grid_group grid = cg::this_grid();
#define FRESH int tid = threadIdx.x; asm volatile("" : "+v"(tid)); const int lane = tid & 63, wave = __builtin_amdgcn_readfirstlane(tid >> 6); const int G = gridDim.x, gw = blockIdx.x * NWAVES + wave, NGW = G * NWAVES; (void)lane; (void)gw; (void)NGW; (void)G
    unsigned* ctl = (unsigned*)(a.ws + WS_CTL);
    unsigned* barw = ctl + 4096;
    volatile LAS unsigned* bst = (volatile LAS unsigned*)(lds + LDS_MISC + 64);
    if (threadIdx.x < 2) bst[threadIdx.x] = 0u;
    __syncthreads();
    if (a.out == nullptr) grid.sync();
    const XcdBarrier xbar = xcd_barrier_post(barw, bst);
#define GSYNC() xcd_barrier(xbar)
    bf16* H = (bf16*)(a.ws + WS_H); bf16* QKV = (bf16*)(a.ws + WS_QKV); bf16* MIX = (bf16*)(a.ws + WS_MIX); bf16* UV = (bf16*)(a.ws + WS_UV); bf16* ACT = (bf16*)(a.ws + WS_ACT); bf16* XB = (bf16*)(a.ws + WS_XB); float* RSTD = (float*)(a.ws + WS_CTL + 65536);
    float* FF = (float*)(a.ws + WS_FF); float* CUM = (float*)(a.ws + WS_CUM);
    { FRESH; phase_weights(a, lds, gw, NGW, wave, lane); }
    for (int l = 0; l < DEPTH; ++l) {
        if (l == 0) { FRESH; phase_norm<1, false>(a.in[0], a.in[1] + (size_t)l * DM, XB, RSTD, a.in[2] + (size_t)l * DM * NIN_SRC, a.in[3] + l * 4, FF, lds, gw, NGW, tid, lane); }
        else { FRESH; phase_norm<1, true>(XB, a.in[1] + (size_t)l * DM, nullptr, RSTD, a.in[2] + (size_t)l * DM * NIN_SRC, a.in[3] + l * 4, FF, lds, gw, NGW, tid, lane); }
        GSYNC();
        { FRESH; if (blockIdx.x < 64 && wave == 0) cumsum_seq(FF, CUM, blockIdx.x, lane); }
        { pg8::EpiBf16S E{(pg8::bf16_t*)QKV, NQKV, RSTD}; GEMM_RUN(pg8::EpiBf16S, XB, a.ws + WS_WIN + l * SZ_WIN, MTOK, NQKV, DM, E); }
        GSYNC();
        { FRESH; phase_attn(a, l, ctl + 64 * l, lds, tid, wave, lane); }
        GSYNC();
        { pg8::EpiResB<false> E{XB, (pg8::bf16_t*)XB, DM}; GEMM_RUN(pg8::EpiResB<false>, MIX, a.ws + WS_WOUT + l * SZ_WOUT, MTOK, DM, MIXW, E); }
        GSYNC();
        { FRESH; phase_norm<3, true>(XB, a.in[8] + (size_t)l * DM, nullptr, RSTD, nullptr, nullptr, nullptr, lds, gw, NGW, tid, lane); }
        GSYNC();
        { pg8::EpiConv E{(pg8::bf16_t*)ACT, (pg8::bf16_t*)UV, a.in[10] + (size_t)l * 3 * NFF2, a.in[11] + (size_t)l * NFF2, RSTD}; GEMM_RUN(pg8::EpiConv, XB, a.ws + WS_WFI + l * SZ_WFI, MTOK, NFF2, DM, E); }
        GSYNC();
        { FRESH; phase_fixup(UV, ACT, a.in[10] + (size_t)l * 3 * NFF2, a.in[11] + (size_t)l * NFF2, blockIdx.x * NTHREADS + tid, G * NTHREADS); }
        GSYNC();
        { pg8::EpiResB<false> E{XB, (pg8::bf16_t*)XB, DM}; GEMM_RUN(pg8::EpiResB<false>, ACT, a.ws + WS_WFO + l * SZ_WFO, MTOK, DM, DFF, E); }
        GSYNC();
    }
    { FRESH; phase_norm<2, true>(XB, a.in[13], nullptr, a.out, nullptr, nullptr, nullptr, lds, gw, NGW, tid, lane); }
}

extern "C" void kernel_launch(void* const* d_in, const int* in_sizes, int n_in, void* d_out, int out_size, void* d_ws, size_t ws_size, hipStream_t stream) {
    static int grid_blocks = 0;
    if (grid_blocks == 0) {
        if (n_in != 14 || out_size != MTOK * DM || ws_size < WS_END || in_sizes[2] != DEPTH * DM * NIN_SRC || in_sizes[7] != DEPTH * MIXW * DM || in_sizes[9] != DEPTH * DM * NFF2 || in_sizes[12] != DEPTH * DFF * DM || in_sizes[6] != DEPTH * 4 * 192 || in_sizes[5] != DEPTH * 128) { fprintf(stderr, "kernel_launch: unexpected sizes n_in %d out %d ws %zu\n", n_in, out_size, ws_size); grid_blocks = -1; return; }
        int dev = 0, cus = 0, per_cu = 0;
        (void)hipGetDevice(&dev);
        (void)hipDeviceGetAttribute(&cus, hipDeviceAttributeMultiprocessorCount, dev);
        (void)hipOccupancyMaxActiveBlocksPerMultiprocessor(&per_cu, (const void*)mk_fwd, NTHREADS, 0);
        if (per_cu < 1) { fprintf(stderr, "kernel_launch: occupancy query says %d blocks/CU\n", per_cu); per_cu = 1; }
        (void)hipGetLastError();
        grid_blocks = cus * 1;
        fprintf(stderr, "kernel_launch: cus %d per_cu %d grid %d\n", cus, per_cu, grid_blocks);
    }
    if (grid_blocks < 0) return;
    if (hipMemsetAsync((char*)d_ws + WS_CTL, 0, 65536, stream) != hipSuccess) { fprintf(stderr, "kernel_launch: memset of control words failed\n"); return; }
    Args a{};
    for (int i = 0; i < 14; ++i) a.in[i] = (const float*)d_in[i];
    a.out = (float*)d_out; a.ws = (unsigned char*)d_ws;
    void* args[] = {&a};
    hipError_t e = hipLaunchCooperativeKernel((const void*)mk_fwd, dim3(grid_blocks), dim3(NTHREADS), args, 0, stream);
    if (e != hipSuccess) fprintf(stderr, "cooperative launch failed: %s (grid %d)\n", hipGetErrorString(e), grid_blocks);
}
```

```cpp
#include <hip/hip_runtime.h>
#include <cstdio>
#include <cstdint>
#include <hip/hip_cooperative_groups.h>
namespace cg = cooperative_groups;
namespace pg8 {
#define PG8_LAS __attribute__((address_space(3)))
typedef unsigned short bf16_t;
typedef short bf16x8 __attribute__((ext_vector_type(8)));
typedef float f32x4 __attribute__((ext_vector_type(4)));
typedef unsigned u32x4 __attribute__((ext_vector_type(4)));
constexpr int BM = 256, BK = 64, HALF = 128, HTB = HALF * BK * 2  , STAGE_BYTES = 8 * HTB, NXCD = 8, WGM = 8;

__host__ __device__ __forceinline__ int lds_byte(int r, int c) { const int st = (r >> 4) * 2 + (c >> 5), rr = r & 15, cc = c & 31, ob = rr * 64 + cc * 2; return st * 1024 + (ob ^ (((ob >> 9) & 1) << 5)); }
__host__ __device__ __forceinline__ void stage_rc(int b, int& R, int& C) { const int st = b / 1024, sb = b % 1024, swz = sb ^ (((sb >> 9) & 1) << 5); R = (st >> 1) * 16 + swz / 64; C = (st & 1) * 32 + (swz % 64) / 2; }
__host__ __device__ __forceinline__ int perm32(int rho) { const int n = rho >> 4, i = rho & 15; return 8 * (i >> 2) + 4 * n + (i & 3); }

struct Unit { int pm, pn; };
struct Gemm { const bf16_t* A; const bf16_t* Bt; int M, N, K; };

struct StaticOrder {
    int nM, nN, nwg, G, c;
    __host__ __device__ void init(int M, int N, int G_, int c_) { nM = M / BM; nN = N / BM; nwg = nM * nN; G = G_; c = c_; }
    __host__ __device__ bool next(int i, Unit& u) const {
        const long L = (long)i * G + c; if (L >= nwg) return false;
        int wgid = (int)L; { const int q = nwg / NXCD, r = nwg % NXCD, xcd = wgid % NXCD, off = wgid / NXCD; wgid = (xcd < r ? xcd * (q + 1) : r * (q + 1) + (xcd - r) * q) + off; }
        const int nig = WGM * nN, gid = wgid / nig, fm = gid * WGM, gsz = (nM - fm) < WGM ? (nM - fm) : WGM;
        u.pm = fm + ((wgid % nig) % gsz); u.pn = (wgid % nig) / gsz; return true;
    }
    __device__ __forceinline__ void a_ready(const Unit&) const {}
    __device__ __forceinline__ void done(const Unit&) const {}
};

typedef float f32x2c __attribute__((ext_vector_type(2))); typedef __bf16 bf16x2c __attribute__((ext_vector_type(2)));
__device__ __forceinline__ unsigned cvt_pk_bf16(float lo, float hi) { f32x2c v = {lo, hi}; bf16x2c b = __builtin_convertvector(v, bf16x2c); return __builtin_bit_cast(unsigned, b); }
typedef float f32x2 __attribute__((ext_vector_type(2)));
struct EpiBf16 {
    static constexpr bool PERM = true, AFTER_DRAIN = false, APERM = false;
    bf16_t* O; int ldc;
    __device__ __forceinline__ void operator()(const f32x4 (&acc)[2][2][4][2], const Unit& u, int wr, int wc, int fr, int fq) const {
        const int row0 = u.pm * BM + wr * 64 + fr; const int col0 = u.pn * BM + wc * 32 + 8 * fq;
#pragma unroll
        for (int ai = 0; ai < 2; ++ai)
#pragma unroll
            for (int m = 0; m < 4; ++m) { bf16_t* rowp = O + (size_t)(row0 + ai * HALF + m * 16) * ldc + col0;
#pragma unroll
                for (int bj = 0; bj < 2; ++bj) { const f32x4 v0 = acc[ai][bj][m][0], v1 = acc[ai][bj][m][1];
                    u32x4 w; w.x = cvt_pk_bf16(v0[0], v0[1]); w.y = cvt_pk_bf16(v0[2], v0[3]); w.z = cvt_pk_bf16(v1[0], v1[1]); w.w = cvt_pk_bf16(v1[2], v1[3]);
                    *(u32x4*)(rowp + bj * HALF) = w; } }
    }
};
struct EpiRes {
    static constexpr bool PERM = false, AFTER_DRAIN = false, APERM = false;
    const float* base; float* out; int ldc; float scale;
    __device__ __forceinline__ void operator()(const f32x4 (&acc)[2][2][4][2], const Unit& u, int wr, int wc, int fr, int fq) const {
        const int col0 = u.pn * BM + wc * 32 + 4 * fq;
#pragma unroll
        for (int ai = 0; ai < 2; ++ai)
#pragma unroll
            for (int m = 0; m < 4; ++m) { const size_t off = (size_t)(u.pm * BM + ai * HALF + wr * 64 + m * 16 + fr) * ldc + col0;
#pragma unroll
                for (int bj = 0; bj < 2; ++bj)
#pragma unroll
                    for (int n = 0; n < 2; ++n) { const f32x4 bs = *(const f32x4*)(base + off + bj * HALF + n * 16); *(f32x4*)(out + off + bj * HALF + n * 16) = bs + acc[ai][bj][m][n] * scale; } }
    }
};

__device__ __forceinline__ f32x4 dpp_shr1(f32x4 v) { f32x4 r;
#pragma unroll
    for (int i = 0; i < 4; ++i) r[i] = __shfl_up(v[i], 1, 16);
    return r; }
__device__ __forceinline__ f32x4 silu_mul(f32x4 yu, f32x4 yg) { f32x4 o;
#pragma unroll
    for (int i = 0; i < 4; ++i) o[i] = yu[i] * yg[i] * __builtin_amdgcn_rcpf(1.0f + __builtin_amdgcn_exp2f(-1.4426950408889634f * yg[i]));
    return o; }
struct EpiConv {
    static constexpr bool PERM = false, AFTER_DRAIN = false, APERM = true;
    bf16_t* act; bf16_t* halo; const float* cw; const float* cb; const float* rstd;
    typedef unsigned u32x2e __attribute__((ext_vector_type(2)));
    __device__ __forceinline__ void conv4(f32x4 (&y)[4], const f32x4 (&a4)[4][2], int n, const f32x4 rs, const f32x4 w0, const f32x4 w1, const f32x4 w2, const f32x4 b, int col, int fr, bf16_t* hp) const {
        constexpr int N2 = 5632;
        const f32x4 X0 = a4[0][n] * rs[0], X1 = a4[1][n] * rs[1], X2 = a4[2][n] * rs[2], X3 = a4[3][n] * rs[3];
        const f32x4 Xm1 = dpp_shr1(X3), Xm2 = dpp_shr1(X2);
        y[0] = b + w0 * Xm2 + w1 * Xm1 + w2 * X0;
        y[1] = b + w0 * Xm1 + w1 * X0 + w2 * X1;
        y[2] = b + w0 * X0 + w1 * X1 + w2 * X2;
        y[3] = b + w0 * X1 + w1 * X2 + w2 * X3;
        if (fr == 0 || fr == 15) { const f32x4 xa = fr == 0 ? X0 : X2, xb = fr == 0 ? X1 : X3;
            u32x2e w; w.x = cvt_pk_bf16(xa[0], xa[1]); w.y = cvt_pk_bf16(xa[2], xa[3]); *(u32x2e*)(hp + col) = w;
            w.x = cvt_pk_bf16(xb[0], xb[1]); w.y = cvt_pk_bf16(xb[2], xb[3]); *(u32x2e*)(hp + N2 + col) = w; }
    }
    __device__ __forceinline__ void operator()(const f32x4 (&acc)[2][2][4][2], const Unit& u, int wr, int wc, int fr, int fq) const {
        constexpr int DFFc = 2816, N2 = 5632;
#pragma unroll
        for (int n = 0; n < 2; ++n) {
            const int cu = u.pn * 128 + wc * 32 + n * 16 + 4 * fq, cg = DFFc + cu;
            const f32x4 w0u = *(const f32x4*)(cw + cu), w1u = *(const f32x4*)(cw + N2 + cu), w2u = *(const f32x4*)(cw + 2 * N2 + cu), bu = *(const f32x4*)(cb + cu);
            const f32x4 w0g = *(const f32x4*)(cw + cg), w1g = *(const f32x4*)(cw + N2 + cg), w2g = *(const f32x4*)(cw + 2 * N2 + cg), bg = *(const f32x4*)(cb + cg);
#pragma unroll
            for (int ai = 0; ai < 2; ++ai) {
                const int row0 = u.pm * BM + ai * HALF + wr * 64 + 4 * fr;
                const f32x4 rs = *(const f32x4*)(rstd + row0);
                bf16_t* hp = halo + ((size_t)(row0 >> 6) * 4 + (fr == 0 ? 0 : 2)) * N2;
                f32x4 yu[4], yg[4];
                conv4(yu, acc[ai][0], n, rs, w0u, w1u, w2u, bu, cu, fr, hp);
                conv4(yg, acc[ai][1], n, rs, w0g, w1g, w2g, bg, cg, fr, hp);
#pragma unroll
                for (int m = 0; m < 4; ++m) if (fr != 0 || m >= 2) { const f32x4 o = silu_mul(yu[m], yg[m]); u32x2e w; w.x = cvt_pk_bf16(o[0], o[1]); w.y = cvt_pk_bf16(o[2], o[3]);
                    *(u32x2e*)(act + (size_t)(row0 + m) * DFFc + cu) = w; }
            }
        }
    }
};

template <bool BASE_F32> struct EpiResB {
    static constexpr bool PERM = true, AFTER_DRAIN = false, APERM = false;
    const void* base; bf16_t* out; int ldc;
    __device__ __forceinline__ void operator()(const f32x4 (&acc)[2][2][4][2], const Unit& u, int wr, int wc, int fr, int fq) const {
        const int col0 = u.pn * BM + wc * 32 + 8 * fq;
#pragma unroll
        for (int ai = 0; ai < 2; ++ai)
#pragma unroll
            for (int m = 0; m < 4; ++m) { const size_t off = (size_t)(u.pm * BM + ai * HALF + wr * 64 + m * 16 + fr) * ldc + col0;
#pragma unroll
                for (int bj = 0; bj < 2; ++bj) { f32x4 b0, b1;
                    if (BASE_F32) { b0 = *(const f32x4*)((const float*)base + off + bj * HALF); b1 = *(const f32x4*)((const float*)base + off + bj * HALF + 4); }
                    else { const u32x4 r = *(const u32x4*)((const bf16_t*)base + off + bj * HALF);
                        b0[0] = __uint_as_float(r.x << 16); b0[1] = __uint_as_float(r.x & 0xffff0000u); b0[2] = __uint_as_float(r.y << 16); b0[3] = __uint_as_float(r.y & 0xffff0000u);
                        b1[0] = __uint_as_float(r.z << 16); b1[1] = __uint_as_float(r.z & 0xffff0000u); b1[2] = __uint_as_float(r.w << 16); b1[3] = __uint_as_float(r.w & 0xffff0000u); }
                    const f32x4 o0 = b0 + acc[ai][bj][m][0], o1 = b1 + acc[ai][bj][m][1];
                    u32x4 w; w.x = cvt_pk_bf16(o0[0], o0[1]); w.y = cvt_pk_bf16(o0[2], o0[3]); w.z = cvt_pk_bf16(o1[0], o1[1]); w.w = cvt_pk_bf16(o1[2], o1[3]);
                    *(u32x4*)(out + off + bj * HALF) = w; } }
    }
};

struct EpiBf16S {
    static constexpr bool PERM = true, AFTER_DRAIN = false, APERM = false;
    bf16_t* O; int ldc; const float* rs;
    __device__ __forceinline__ void operator()(const f32x4 (&acc)[2][2][4][2], const Unit& u, int wr, int wc, int fr, int fq) const {
        const int row0 = u.pm * BM + wr * 64 + fr; const int col0 = u.pn * BM + wc * 32 + 8 * fq;
#pragma unroll
        for (int ai = 0; ai < 2; ++ai)
#pragma unroll
            for (int m = 0; m < 4; ++m) { const int row = row0 + ai * HALF + m * 16; const float s = rs[row]; bf16_t* rowp = O + (size_t)row * ldc + col0;
#pragma unroll
                for (int bj = 0; bj < 2; ++bj) { const f32x4 v0 = acc[ai][bj][m][0] * s, v1 = acc[ai][bj][m][1] * s;
                    u32x4 w; w.x = cvt_pk_bf16(v0[0], v0[1]); w.y = cvt_pk_bf16(v0[2], v0[3]); w.z = cvt_pk_bf16(v1[0], v1[1]); w.w = cvt_pk_bf16(v1[2], v1[3]);
                    *(u32x4*)(rowp + bj * HALF) = w; } }
    }
};

template <bool BASE_F32> struct EpiResBS {
    static constexpr bool PERM = true, AFTER_DRAIN = false, APERM = false;
    const void* base; bf16_t* out; int ldc; float* part;
    __device__ __forceinline__ void operator()(const f32x4 (&acc)[2][2][4][2], const Unit& u, int wr, int wc, int fr, int fq) const {
        const int col0 = u.pn * BM + wc * 32 + 8 * fq;
#pragma unroll
        for (int ai = 0; ai < 2; ++ai)
#pragma unroll
            for (int m = 0; m < 4; ++m) { const int row = u.pm * BM + ai * HALF + wr * 64 + m * 16 + fr; const size_t off = (size_t)row * ldc + col0; float ss = 0.f;
#pragma unroll
                for (int bj = 0; bj < 2; ++bj) { f32x4 b0, b1;
                    if (BASE_F32) { b0 = *(const f32x4*)((const float*)base + off + bj * HALF); b1 = *(const f32x4*)((const float*)base + off + bj * HALF + 4); }
                    else { const u32x4 r = *(const u32x4*)((const bf16_t*)base + off + bj * HALF);
                        b0[0] = __uint_as_float(r.x << 16); b0[1] = __uint_as_float(r.x & 0xffff0000u); b0[2] = __uint_as_float(r.y << 16); b0[3] = __uint_as_float(r.y & 0xffff0000u);
                        b1[0] = __uint_as_float(r.z << 16); b1[1] = __uint_as_float(r.z & 0xffff0000u); b1[2] = __uint_as_float(r.w << 16); b1[3] = __uint_as_float(r.w & 0xffff0000u); }
                    const f32x4 o0 = b0 + acc[ai][bj][m][0], o1 = b1 + acc[ai][bj][m][1];
                    ss += (o0[0] * o0[0] + o0[1] * o0[1]) + (o0[2] * o0[2] + o0[3] * o0[3]) + (o1[0] * o1[0] + o1[1] * o1[1]) + (o1[2] * o1[2] + o1[3] * o1[3]);
                    u32x4 w; w.x = cvt_pk_bf16(o0[0], o0[1]); w.y = cvt_pk_bf16(o0[2], o0[3]); w.z = cvt_pk_bf16(o1[0], o1[1]); w.w = cvt_pk_bf16(o1[2], o1[3]);
                    *(u32x4*)(out + off + bj * HALF) = w; }
                ss += __shfl_xor(ss, 16); ss += __shfl_xor(ss, 32);
                if (fq == 0) part[(size_t)row * 16 + u.pn * 4 + wc] = ss; }
    }
};
template <class Epi, class Sched, bool ALIGN_EPI = false, bool SP2 = false>
__device__ __forceinline__ void gemm_phase(PG8_LAS unsigned char* lds, const Gemm g, const Sched& S, const Epi& E) {
    int tid_l = threadIdx.x; asm volatile("" : "+v"(tid_l)); const int tid = tid_l, wid = __builtin_amdgcn_readfirstlane(tid >> 6), lane = tid & 63, wr = wid >> 2, wc = wid & 3, fr = lane & 15, fq = lane >> 4;
    const int K = g.K, nt = K / BK;
    unsigned voffA[2], voffB[2];
#pragma unroll
    for (int i = 0; i < 2; ++i) { int R, C; stage_rc(tid * 16 + i * 8192, R, C); const int Rb = Epi::PERM ? ((R & ~31) + perm32(R & 31)) : R;
        const int Ra = Epi::APERM ? ((R & 64) + (R & 15) * 4 + ((R >> 4) & 3)) : R; voffA[i] = (unsigned)(Ra * K + C) * 2u; voffB[i] = (unsigned)(Rb * K + C) * 2u; }
    const size_t kstep = (size_t)(BK * 2);
    const size_t hstep = (size_t)HALF * K * 2;
    const size_t tstep = 2 * hstep;
    const unsigned ldsw = (unsigned)wid * 1024u;
    const int aoff = lds_byte(wr * 64 + fr, fq * 8), boff = lds_byte(wc * 32 + fr, fq * 8);
#define PG8_SA(b, h) (((b) * 2 + (h)) * HTB)
#define PG8_SB(b, h) ((4 + (b) * 2 + (h)) * HTB)
#define PG8_STAGE(bufoff, gbase, voff) do { _Pragma("unroll") for (int _i = 0; _i < 2; ++_i) \
        __builtin_amdgcn_global_load_lds((const unsigned*)((const char*)(gbase) + (voff)[_i]), (PG8_LAS unsigned*)(lds + (bufoff) + ldsw + _i * 8192), 16, 0, 0); } while (0)
#define PG8_LDA(dst, b, h) do { _Pragma("unroll") for (int m = 0; m < 4; ++m) _Pragma("unroll") for (int k = 0; k < 2; ++k) dst[m][k] = *(const PG8_LAS bf16x8*)(lds + PG8_SA(b, h) + aoff + m * 2048 + k * 1024); } while (0)
#define PG8_LDB(dst, b, h) do { _Pragma("unroll") for (int n = 0; n < 2; ++n) _Pragma("unroll") for (int k = 0; k < 2; ++k) dst[n][k] = *(const PG8_LAS bf16x8*)(lds + PG8_SB(b, h) + boff + n * 2048 + k * 1024); } while (0)
#define PG8_MMA(ai, bj, At, Bt) do { __builtin_amdgcn_s_setprio(1); _Pragma("unroll") for (int m = 0; m < 4; ++m) _Pragma("unroll") for (int n = 0; n < 2; ++n) _Pragma("unroll") for (int k = 0; k < 2; ++k) \
        acc[ai][bj][m][n] = __builtin_amdgcn_mfma_f32_16x16x32_bf16(Bt[n][k], At[m][k], acc[ai][bj][m][n], 0, 0, 0); __builtin_amdgcn_s_setprio(0); } while (0)
#define PG8_WAIT_V(n) asm volatile("s_waitcnt vmcnt(" #n ")" ::: "memory")
#define PG8_WAIT_L(n) asm volatile("s_waitcnt lgkmcnt(" #n ")" ::: "memory")
#define PG8_BAR __builtin_amdgcn_s_barrier()
#define PG8_SCHED __builtin_amdgcn_sched_barrier(0)
    Unit cur, nxt; int ui = 0;
    if (!S.next(0, cur)) return;
    f32x4 acc[2][2][4][2];
#pragma unroll
    for (int a = 0; a < 2; ++a)
#pragma unroll
        for (int b = 0; b < 2; ++b)
#pragma unroll
            for (int m = 0; m < 4; ++m)
#pragma unroll
                for (int n = 0; n < 2; ++n) acc[a][b][m][n] = (f32x4){0.f, 0.f, 0.f, 0.f};
    bf16x8 At[4][2], B0[2][2], B1[2][2];
    const char* cA = (const char*)g.A + (size_t)cur.pm * tstep; const char* cB = (const char*)g.Bt + (size_t)cur.pn * tstep;
    S.a_ready(cur);
    if constexpr (SP2) {
        PG8_STAGE(PG8_SB(0, 0), cB, voffB); PG8_STAGE(PG8_SB(0, 1), cB + hstep, voffB); PG8_STAGE(PG8_SA(0, 0), cA, voffA); PG8_STAGE(PG8_SA(0, 1), cA + hstep, voffA);
        if (wr == 1) PG8_BAR;
        PG8_WAIT_V(2); PG8_BAR;
        PG8_STAGE(PG8_SB(1, 0), cB + kstep, voffB); PG8_STAGE(PG8_SA(1, 0), cA + kstep, voffA); PG8_STAGE(PG8_SB(1, 1), cB + hstep + kstep, voffB);
        PG8_WAIT_V(6); PG8_BAR;
    } else {
        PG8_STAGE(PG8_SB(0, 0), cB, voffB); PG8_STAGE(PG8_SA(0, 0), cA, voffA); PG8_STAGE(PG8_SB(0, 1), cB + hstep, voffB); PG8_STAGE(PG8_SA(0, 1), cA + hstep, voffA);
        if (wr == 1) PG8_BAR;
        PG8_WAIT_V(4); PG8_BAR;
        PG8_STAGE(PG8_SB(1, 0), cB + kstep, voffB); PG8_STAGE(PG8_SA(1, 0), cA + kstep, voffA); PG8_STAGE(PG8_SB(1, 1), cB + hstep + kstep, voffB);
        PG8_WAIT_V(6); PG8_BAR;
    }
    for (;;) {
        const bool has_next = S.next(ui + 1, nxt);
        const char* nA = has_next ? (const char*)g.A + (size_t)nxt.pm * tstep : cA; const char* nB = has_next ? (const char*)g.Bt + (size_t)nxt.pn * tstep : cB;
        for (int t = 0; t < nt; t += 2) {
            const bool last = (t == nt - 2);
            const char* a1 = cA + (size_t)(t + 1) * kstep;
            const char* a2 = last ? nA : cA + (size_t)(t + 2) * kstep; const char* b2 = last ? nB : cB + (size_t)(t + 2) * kstep;
            const char* a3 = a2 + kstep; const char* b3 = b2 + kstep;
            if (last && has_next) S.a_ready(nxt);
            if constexpr (SP2) {
            PG8_LDB(B0, 0, 0); PG8_LDB(B1, 0, 1); PG8_SCHED; PG8_LDA(At, 0, 0); PG8_STAGE(PG8_SA(1, 1), a1 + hstep, voffA);
            PG8_WAIT_V(8); PG8_WAIT_L(0); PG8_BAR; PG8_MMA(0, 0, At, B0); PG8_MMA(0, 1, At, B1); PG8_BAR; PG8_SCHED;
            PG8_LDA(At, 0, 1); PG8_STAGE(PG8_SB(0, 0), b2, voffB); PG8_STAGE(PG8_SB(0, 1), b2 + hstep, voffB); PG8_STAGE(PG8_SA(0, 0), a2, voffA);
            PG8_WAIT_V(8); PG8_WAIT_L(0); PG8_BAR; PG8_MMA(1, 0, At, B0); PG8_MMA(1, 1, At, B1); PG8_BAR; PG8_SCHED;
            PG8_LDB(B0, 1, 0); PG8_LDB(B1, 1, 1); PG8_SCHED; PG8_LDA(At, 1, 0); PG8_STAGE(PG8_SA(0, 1), a2 + hstep, voffA);
            PG8_WAIT_V(8); PG8_WAIT_L(0); PG8_BAR; PG8_MMA(0, 0, At, B0); PG8_MMA(0, 1, At, B1); PG8_BAR; PG8_SCHED;
            PG8_LDA(At, 1, 1); PG8_STAGE(PG8_SB(1, 0), b3, voffB); PG8_STAGE(PG8_SB(1, 1), b3 + hstep, voffB); PG8_STAGE(PG8_SA(1, 0), a3, voffA);
            PG8_WAIT_V(8); PG8_WAIT_L(0); PG8_BAR; PG8_MMA(1, 0, At, B0); PG8_MMA(1, 1, At, B1); PG8_BAR; PG8_SCHED;
            } else {
            PG8_LDB(B0, 0, 0); PG8_SCHED; PG8_LDA(At, 0, 0); PG8_STAGE(PG8_SA(1, 1), a1 + hstep, voffA);
            PG8_WAIT_L(8); PG8_BAR; PG8_WAIT_L(0); PG8_MMA(0, 0, At, B0); PG8_BAR; PG8_SCHED;
            PG8_LDB(B1, 0, 1); PG8_STAGE(PG8_SB(0, 0), b2, voffB);
            PG8_BAR; PG8_WAIT_L(0); PG8_MMA(0, 1, At, B1); PG8_BAR;
            PG8_LDA(At, 0, 1); PG8_STAGE(PG8_SA(0, 0), a2, voffA);
            PG8_BAR; PG8_WAIT_L(0); PG8_MMA(1, 0, At, B0); PG8_BAR; PG8_SCHED;
            PG8_STAGE(PG8_SB(0, 1), b2 + hstep, voffB);
            PG8_WAIT_V(6); PG8_BAR; PG8_MMA(1, 1, At, B1); PG8_BAR;
            PG8_LDB(B0, 1, 0); PG8_SCHED; PG8_LDA(At, 1, 0); PG8_STAGE(PG8_SA(0, 1), a2 + hstep, voffA);
            PG8_WAIT_L(8); PG8_BAR; PG8_WAIT_L(0); PG8_MMA(0, 0, At, B0); PG8_BAR; PG8_SCHED;
            PG8_LDB(B1, 1, 1); PG8_STAGE(PG8_SB(1, 0), b3, voffB);
            PG8_BAR; PG8_WAIT_L(0); PG8_MMA(0, 1, At, B1); PG8_BAR;
            PG8_LDA(At, 1, 1); PG8_STAGE(PG8_SA(1, 0), a3, voffA);
            PG8_BAR; PG8_WAIT_L(0); PG8_MMA(1, 0, At, B0); PG8_BAR; PG8_SCHED;
            PG8_STAGE(PG8_SB(1, 1), b3 + hstep, voffB);
            PG8_WAIT_V(6); PG8_BAR; PG8_MMA(1, 1, At, B1); PG8_BAR;
            }
        }
        if constexpr (ALIGN_EPI) { if (wr == 0) PG8_BAR; }
        if constexpr (!Epi::AFTER_DRAIN) { E(acc, cur, wr, wc, fr, fq); S.done(cur); }
        if (!has_next) break;
#pragma unroll
        for (int a = 0; a < 2; ++a)
#pragma unroll
            for (int b = 0; b < 2; ++b)
#pragma unroll
                for (int m = 0; m < 4; ++m)
#pragma unroll
                    for (int n = 0; n < 2; ++n) acc[a][b][m][n] = (f32x4){0.f, 0.f, 0.f, 0.f};
        cur = nxt; cA = nA; cB = nB; ++ui;
        if constexpr (ALIGN_EPI) { if (wr == 1) PG8_BAR; }
    }
    PG8_WAIT_V(0);
    if constexpr (!ALIGN_EPI) { if (wr == 0) PG8_BAR; }
    PG8_BAR;
    if constexpr (Epi::AFTER_DRAIN) { E.fused(acc, cur, wr, wc, fr, fq, lds, wid, lane); S.done(cur); }
#undef PG8_SA
#undef PG8_SB
#undef PG8_STAGE
#undef PG8_LDA
#undef PG8_LDB
#undef PG8_MMA
#undef PG8_WAIT_V
#undef PG8_WAIT_L
#undef PG8_BAR
#undef PG8_SCHED
}
}
#define LAS __attribute__((address_space(3)))
typedef unsigned short bf16;
typedef short bf16x8 __attribute__((ext_vector_type(8)));
typedef short s16x4 __attribute__((ext_vector_type(4)));
typedef float f32x16 __attribute__((ext_vector_type(16)));
typedef float f32x4 __attribute__((ext_vector_type(4)));
typedef unsigned u32x4 __attribute__((ext_vector_type(4)));
typedef unsigned u32x2 __attribute__((ext_vector_type(2)));

constexpr int DM = 1024, BATCH = 16, SEQ = 2048, MTOK = BATCH * SEQ, DEPTH = 2;
constexpr int NIN_SRC = 2308, NQKV = 2304, MIXW = 768, DFF = 2816, NFF2 = 5632;
constexpr float RMS_EPS = 1e-6f, L2E = 1.4426950408889634f, QSCALE = 0.125f * 1.4426950408889634f;
constexpr int C_FQ = 0, C_FK = 256, C_FV = 512, C_DQ = 768, C_DK = 1024, C_DV = 1280, C_CQ = 1536, C_CK = 1792, C_CV = 2048;
constexpr int MX_FOX = 0, MX_DIFF = 256, MX_CHK = 512;
constexpr int NTHREADS = 512, NWAVES = 8;
constexpr size_t MiB = 1u << 20;
constexpr size_t WS_CTL = 0, WS_FF = 1 * MiB, WS_CUM = 1 * MiB + 512 * 1024;
constexpr size_t WS_WIN = 2 * MiB, WS_WOUT = 14 * MiB, WS_WFI = 18 * MiB, WS_WFO = 40 * MiB;
constexpr size_t SZ_WIN = 6 * MiB, SZ_WOUT = 2 * MiB, SZ_WFI = 11 * MiB, SZ_WFO = (size_t)DM * DFF * 2;
constexpr size_t WS_H = 52 * MiB, WS_QKV = 116 * MiB, WS_MIX = 308 * MiB, WS_UV = 116 * MiB, WS_ACT = 260 * MiB, WS_XB = 436 * MiB, WS_END = 500 * MiB;
static_assert(WS_WFO + 2 * SZ_WFO <= WS_H, "ws map");
constexpr int HALF_M = MTOK / 2;
constexpr int LDS_RING = 131072, LDS_WF = 131072, LDS_MISC = 147456, LDS_TAB = 147456 + 256, LDS_BYTES = 155648;

typedef float f32x2_t __attribute__((ext_vector_type(2))); typedef __bf16 bf16x2_t __attribute__((ext_vector_type(2)));
__device__ __forceinline__ unsigned cvtpk(float lo, float hi) { f32x2_t v = {lo, hi}; bf16x2_t b = __builtin_convertvector(v, bf16x2_t); return __builtin_bit_cast(unsigned, b); }
__device__ __forceinline__ float bf2f(unsigned short v) { return __uint_as_float((unsigned)v << 16); }
__device__ __forceinline__ float wave_sum(float v) {
#pragma unroll
    for (int o = 1; o < 64; o <<= 1) v += __shfl_xor(v, o);
    return v;
}
__device__ __forceinline__ float ex2(float v) { return __builtin_amdgcn_exp2f(v); }

struct Args { const float* in[14]; float* out; unsigned char* ws; };
struct WMeta { bf16* dst; int K; float scale; const float* gk; };
constexpr int W_I_IN = 16 * 72, W_I_OUT = 12 * 32, W_I_FI = 16 * 176, W_I_FO = 44 * 32, W_I_L = W_I_IN + W_I_OUT + W_I_FI + W_I_FO;
__device__ __forceinline__ void witem_load(const Args& a, int it, int lane, float (&wv)[32], WMeta& mt) {
    const int l = it / W_I_L; int r = it % W_I_L;
    const float* W; int K, Nsrc, nblk, mode; bf16* WT;
    if (r < W_I_IN) { W = a.in[2] + (size_t)l * DM * NIN_SRC; K = DM; Nsrc = NIN_SRC; nblk = 72; WT = (bf16*)(a.ws + WS_WIN + l * SZ_WIN); mode = 1; }
    else if ((r -= W_I_IN) < W_I_OUT) { W = a.in[7] + (size_t)l * MIXW * DM; K = MIXW; Nsrc = DM; nblk = 32; WT = (bf16*)(a.ws + WS_WOUT + l * SZ_WOUT); mode = 0; }
    else if ((r -= W_I_OUT) < W_I_FI) { W = a.in[9] + (size_t)l * DM * NFF2; K = DM; Nsrc = NFF2; nblk = 176; WT = (bf16*)(a.ws + WS_WFI + l * SZ_WFI); mode = 2; }
    else { r -= W_I_FI; W = a.in[12] + (size_t)l * DFF * DM; K = DFF; Nsrc = DM; nblk = 32; WT = (bf16*)(a.ws + WS_WFO + l * SZ_WFO); mode = 0; }
    const int kb = r / nblk, nb = r % nblk, k0 = 64 * kb, n0 = 32 * nb;
    int sc0 = n0; float scale = 1.f;
    if (mode == 2) sc0 = (n0 >> 8) * 128 + (n0 & 127) + ((n0 & 128) ? DFF : 0);
    if (mode == 1) { sc0 = n0 + (n0 >= 768 ? 4 : 0);
        if ((n0 >= C_FQ && n0 < C_FK) || (n0 >= C_DQ && n0 < C_DK) || (n0 >= C_CQ && n0 < C_CK)) scale = QSCALE; }
    const float* src = W + (size_t)(k0 + (lane >> 5)) * Nsrc + sc0 + (lane & 31);
#pragma unroll
    for (int i = 0; i < 32; ++i) wv[i] = src[(size_t)(2 * i) * Nsrc];
    mt.dst = WT + (size_t)n0 * K + k0; mt.K = K; mt.scale = scale; mt.gk = (mode == 1) ? a.in[1] + (size_t)l * DM + k0 : (mode == 2) ? a.in[8] + (size_t)l * DM + k0 : nullptr;
}
__device__ __forceinline__ void witem_store(const WMeta& mt, const float (&wv)[32], LAS float* scr, int lane) {
#pragma unroll
    for (int i = 0; i < 32; ++i) { const int kk = 2 * i + (lane >> 5); scr[kk * 33 + (lane & 31)] = wv[i] * (mt.gk ? mt.scale * mt.gk[kk] : mt.scale); }
    asm volatile("s_waitcnt lgkmcnt(0)" ::: "memory");
    const int c = lane & 7;
#pragma unroll
    for (int j = 0; j < 4; ++j) { const int n = (lane >> 3) + 8 * j; const LAS float* s = scr + (8 * c) * 33 + n;
        u32x4 o; o.x = cvtpk(s[0 * 33], s[1 * 33]); o.y = cvtpk(s[2 * 33], s[3 * 33]); o.z = cvtpk(s[4 * 33], s[5 * 33]); o.w = cvtpk(s[6 * 33], s[7 * 33]);
        *(u32x4*)(mt.dst + (size_t)n * mt.K + 8 * c) = o; }
}
__device__ __forceinline__ void phase_weights(const Args& a, LAS unsigned char* lds, int gw, int NGW, int wave, int lane) {
    LAS float* scr = (LAS float*)(lds + wave * 16896);
    for (int it = gw; it < DEPTH * W_I_L; it += 2 * NGW) {
        float wa[32], wb[32]; WMeta ma, mb; const bool two = it + NGW < DEPTH * W_I_L;
        witem_load(a, it, lane, wa, ma);
        if (two) witem_load(a, it + NGW, lane, wb, mb);
        witem_store(ma, wa, scr, lane);
        if (two) witem_store(mb, wb, scr + 64 * 33, lane);
        asm volatile("s_waitcnt lgkmcnt(0)" ::: "memory");
    }
}

template <bool XBF> struct RowLd;
template <> struct RowLd<false> { typedef f32x4 raw; static __device__ __forceinline__ raw ld(const void* x, size_t m, int lane, int j) { return *((const f32x4*)((const float*)x + m * DM) + lane + 64 * j); }
    static __device__ __forceinline__ f32x4 cv(raw r) { return r; } };
template <> struct RowLd<true> { typedef u32x2 raw; static __device__ __forceinline__ raw ld(const void* x, size_t m, int lane, int j) { return *((const u32x2*)((const bf16*)x + m * DM) + lane + 64 * j); }
    static __device__ __forceinline__ f32x4 cv(raw r) { f32x4 v; v.x = __uint_as_float(r.x << 16); v.y = __uint_as_float(r.x & 0xffff0000u); v.z = __uint_as_float(r.y << 16); v.w = __uint_as_float(r.y & 0xffff0000u); return v; } };
template <int MODE, bool XBF>
__device__ __forceinline__ void phase_norm(const void* x, const float* g, bf16* H, float* outf, const float* w_in_l, const float* b_fox, float* FF,
                                           LAS unsigned char* lds, int gw, int NGW, int tid, int lane) {
    LAS f32x4* wf = (LAS f32x4*)(lds + LDS_WF);
    if (MODE == 1) {
        __syncthreads();
        for (int k = tid; k < DM; k += NTHREADS) wf[k] = *(const f32x4*)(w_in_l + (size_t)k * NIN_SRC + 768);
        __syncthreads();
    }
    f32x4 gv[4];
#pragma unroll
    for (int j = 0; j < 4; ++j) gv[j] = *((const f32x4*)g + lane + 64 * j);
    f32x4 v[4]; typename RowLd<XBF>::raw vn[4];
    if (gw < MTOK) {
#pragma unroll
        for (int j = 0; j < 4; ++j) vn[j] = RowLd<XBF>::ld(x, (size_t)gw, lane, j); }
    for (int m = gw; m < MTOK; m += NGW) {
        float s = 0.f;
#pragma unroll
        for (int j = 0; j < 4; ++j) v[j] = RowLd<XBF>::cv(vn[j]);
        if (m + NGW < MTOK) {
#pragma unroll
            for (int j = 0; j < 4; ++j) vn[j] = RowLd<XBF>::ld(x, (size_t)(m + NGW), lane, j); }
#pragma unroll
        for (int j = 0; j < 4; ++j) s += (v[j].x * v[j].x + v[j].y * v[j].y) + (v[j].z * v[j].z + v[j].w * v[j].w);
        const float rstd = 1.0f / sqrtf(wave_sum(s) * (1.f / DM) + RMS_EPS);
        if (MODE == 3) { if (lane == 0) outf[m] = rstd; continue; }
        if (MODE == 1) {
            if (!XBF) { u32x2* o = (u32x2*)(H + (size_t)m * DM) + lane;
#pragma unroll
                for (int j = 0; j < 4; ++j) { u32x2 w; w.x = cvtpk(v[j].x, v[j].y); w.y = cvtpk(v[j].z, v[j].w); o[64 * j] = w; } }
            if (lane == 0) outf[m] = rstd;
        }
#pragma unroll
        for (int j = 0; j < 4; ++j) v[j] = v[j] * rstd * gv[j];
        if (MODE == 2) {
            f32x4* o = (f32x4*)(outf + (size_t)m * DM) + lane;
#pragma unroll
            for (int j = 0; j < 4; ++j) o[64 * j] = v[j];
        } else if (MODE == 0) {
            u32x2* o = (u32x2*)(H + (size_t)m * DM) + lane;
#pragma unroll
            for (int j = 0; j < 4; ++j) { u32x2 w; w.x = cvtpk(v[j].x, v[j].y); w.y = cvtpk(v[j].z, v[j].w); o[64 * j] = w; }
        }
        if (MODE == 1) {
            f32x4 d = {0.f, 0.f, 0.f, 0.f};
#pragma unroll
            for (int j = 0; j < 4; ++j) { const int k = 4 * lane + 256 * j;
                d += wf[k] * v[j].x; d += wf[k + 1] * v[j].y; d += wf[k + 2] * v[j].z; d += wf[k + 3] * v[j].w; }
            d.x = wave_sum(d.x); d.y = wave_sum(d.y); d.z = wave_sum(d.z); d.w = wave_sum(d.w);
            if (lane < 4) { float z = (lane == 0 ? d.x : lane == 1 ? d.y : lane == 2 ? d.z : d.w) + b_fox[lane];
                const float ls = fminf(z, 0.f) - log1pf(expf(-fabsf(z)));
                FF[(size_t)m * 4 + lane] = ls; }
        }
    }
}

__device__ __forceinline__ void cumsum_seq(const float* FF, float* CUM, int bh, int lane) {
    const int b = bh >> 2, h = bh & 3;
    const float* src = FF + ((size_t)b * SEQ + 32 * lane) * 4 + h;
    float v[32]; float s = 0.f;
#pragma unroll
    for (int i = 0; i < 32; ++i) { s += src[4 * i]; v[i] = s; }
    float inc = s;
#pragma unroll
    for (int o = 1; o < 64; o <<= 1) { const float t = __shfl_up(inc, o); if (lane >= o) inc += t; }
    const float excl = inc - s;
    float* dst = CUM + (size_t)bh * SEQ + 32 * lane;
#pragma unroll
    for (int i = 0; i < 32; i += 4) { f32x4 w = {v[i] + excl, v[i + 1] + excl, v[i + 2] + excl, v[i + 3] + excl}; *(f32x4*)(dst + i) = w; }
}

__device__ __forceinline__ void unpack8(const u32x4 a, float (&f)[8]) {
#pragma unroll
    for (int i = 0; i < 4; ++i) { f[2 * i] = __uint_as_float(a[i] << 16); f[2 * i + 1] = __uint_as_float(a[i] & 0xffff0000u); } }
__device__ __forceinline__ void phase_fixup(const bf16* HALO, bf16* ACT, const float* cw, const float* cb, int gt, int NGT) {
    constexpr int NCG = DFF / 8, NG = MTOK / 64;
    for (int it = gt; it < NG * 2 * NCG; it += NGT) {
        const int cg8 = it % NCG, rs = it / NCG, s = rs & 1, j = rs >> 1, c0 = cg8 * 8;
        const bool first = ((j * 64) % SEQ) == 0;
        const bf16* hj = HALO + (size_t)j * 4 * NFF2; const bf16* hp = hj - 4 * NFF2;
        const bf16* pt = hj + (size_t)s * NFF2;
        const bf16* p1 = (s == 0) ? hp + 3 * NFF2 : hj;
        const bf16* p2 = (s == 0) ? hp + 2 * NFF2 : hp + 3 * NFF2;
        const u32x4 z = {0u, 0u, 0u, 0u};
        float ut[8], u1[8], u2[8], gt_[8], g1[8], g2[8];
        unpack8(*(const u32x4*)(pt + c0), ut); unpack8(*(const u32x4*)(pt + DFF + c0), gt_);
        unpack8((s == 0 && first) ? z : *(const u32x4*)(p1 + c0), u1); unpack8((s == 0 && first) ? z : *(const u32x4*)(p1 + DFF + c0), g1);
        unpack8(first ? z : *(const u32x4*)(p2 + c0), u2); unpack8(first ? z : *(const u32x4*)(p2 + DFF + c0), g2);
        float o[8];
#pragma unroll
        for (int i = 0; i < 8; ++i) { const int c = c0 + i;
            const float yu = cb[c] + cw[c] * u2[i] + cw[NFF2 + c] * u1[i] + cw[2 * NFF2 + c] * ut[i];
            const float yg = cb[DFF + c] + cw[DFF + c] * g2[i] + cw[NFF2 + DFF + c] * g1[i] + cw[2 * NFF2 + DFF + c] * gt_[i];
            o[i] = yu * yg / (1.f + __expf(-yg)); }
        u32x4 w; w.x = cvtpk(o[0], o[1]); w.y = cvtpk(o[2], o[3]); w.z = cvtpk(o[4], o[5]); w.w = cvtpk(o[6], o[7]);
        *(u32x4*)(ACT + (size_t)(j * 64 + s) * DFF + c0) = w;
    }
}
__device__ __forceinline__ s16x4 vtr(LAS const char* p) { typedef short v4i16_t __attribute__((ext_vector_type(4))); return __builtin_bit_cast(s16x4, __builtin_amdgcn_ds_read_tr16_b64_v4i16((LAS v4i16_t*)p)); }
constexpr int KROWB = 144, KT_BYTES = 64 * KROWB;

__device__ __forceinline__ void qk_tile(f32x16& p0, f32x16& p1, LAS const char* kt, const bf16x8 (&qr)[4], int r32, int hi) {
    LAS const char* kb = kt + r32 * KROWB + hi * 16;
#pragma unroll
    for (int ks = 0; ks < 4; ++ks) {
        const bf16x8 a0 = *(LAS const bf16x8*)(kb + ks * 32), a1 = *(LAS const bf16x8*)(kb + 32 * KROWB + ks * 32);
        p0 = __builtin_amdgcn_mfma_f32_32x32x16_bf16(a0, qr[ks], p0, 0, 0, 0);
        p1 = __builtin_amdgcn_mfma_f32_32x32x16_bf16(a1, qr[ks], p1, 0, 0, 0);
    }
}
template <int NDB>
__device__ __forceinline__ void softmax_pv(f32x16& p0, f32x16& p1, float& m, float& l, f32x16 (&o)[NDB], LAS const char* vt, int vb) {
    float mx = fmaxf(p0[0], p1[0]);
#pragma unroll
    for (int r = 1; r < 16; ++r) mx = fmaxf(mx, fmaxf(p0[r], p1[r]));
    mx = fmaxf(mx, __shfl_xor(mx, 32));
    if (__builtin_amdgcn_ballot_w64(mx > m) != 0ull) {
        const float mn = fmaxf(m, mx);
        const float alpha = ex2(m - mn);
        m = mn; l *= alpha;
#pragma unroll
        for (int db = 0; db < NDB; ++db)
#pragma unroll
            for (int r = 0; r < 16; ++r) o[db][r] *= alpha;
    }
    const float mn = m;
    float rs = 0.f;
#pragma unroll
    for (int r = 0; r < 16; ++r) { p0[r] = ex2(p0[r] - mn); p1[r] = ex2(p1[r] - mn); rs += p0[r] + p1[r]; }
    l += rs;
    bf16x8 pf[4];
    { u32x4 w;
      w.x = cvtpk(p0[0], p0[1]); w.y = cvtpk(p0[2], p0[3]); w.z = cvtpk(p0[4], p0[5]); w.w = cvtpk(p0[6], p0[7]); pf[0] = __builtin_bit_cast(bf16x8, w);
      w.x = cvtpk(p0[8], p0[9]); w.y = cvtpk(p0[10], p0[11]); w.z = cvtpk(p0[12], p0[13]); w.w = cvtpk(p0[14], p0[15]); pf[1] = __builtin_bit_cast(bf16x8, w);
      w.x = cvtpk(p1[0], p1[1]); w.y = cvtpk(p1[2], p1[3]); w.z = cvtpk(p1[4], p1[5]); w.w = cvtpk(p1[6], p1[7]); pf[2] = __builtin_bit_cast(bf16x8, w);
      w.x = cvtpk(p1[8], p1[9]); w.y = cvtpk(p1[10], p1[11]); w.z = cvtpk(p1[12], p1[13]); w.w = cvtpk(p1[14], p1[15]); pf[3] = __builtin_bit_cast(bf16x8, w); }
#pragma unroll
    for (int kk = 0; kk < 4; ++kk)
#pragma unroll
        for (int db = 0; db < NDB; ++db) {
            const s16x4 lo = vtr(vt + vb + db * 4096 + kk * 1024), hh = vtr(vt + vb + db * 4096 + kk * 1024 + 512);
            const bf16x8 vf = {lo[0], lo[1], lo[2], lo[3], hh[0], hh[1], hh[2], hh[3]};
            o[db] = __builtin_amdgcn_mfma_f32_32x32x16_bf16(vf, pf[kk], o[db], 0, 0, 0);
        }
}

template <int MODE>
__device__ __forceinline__ void attn_unit64(const bf16* qkv, bf16* mix, const float* cum_bh, int b, int h, int blk, LAS unsigned char* lds, int tid, int wave, int lane) {
    constexpr int CUMOFF = KT_BYTES + 8192, BUFSZ = CUMOFF + 256;
    const int r32 = lane & 31, hi = lane >> 5;
    const size_t rowbase = (size_t)b * SEQ;
    const int Q0 = blk * 256, qw0 = Q0 + 32 * wave;
    const int CQ = (MODE == 0 ? C_FQ : C_CQ) + h * 64, CK = (MODE == 0 ? C_FK : C_CK) + h * 64, CV = (MODE == 0 ? C_FV : C_CV) + h * 64;
    const int c0 = 4 * blk, cw = c0 + (wave >> 1);
    int tbeg, tend, kvoff;
    if (MODE == 0) { tbeg = 0; tend = 4 * (blk + 1); kvoff = 0; }
    else { tbeg = (c0 >= 8) ? 0 : 8 - c0; tend = 12; kvoff = (c0 - 8) * 64; }
    const int srow = tid >> 3, sch = tid & 7;
    const bf16* kg = qkv + (rowbase + kvoff + srow) * NQKV + CK + sch * 8;
    const bf16* vg = qkv + (rowbase + kvoff + srow) * NQKV + CV + sch * 8;
    const int kdst = srow * KROWB + sch * 16, vdst = KT_BYTES + (sch >> 2) * 4096 + srow * 64 + (sch & 3) * 16;
    const float cref = (MODE == 0) ? cum_bh[Q0] : 0.f;
#define U64_LOAD(K, V, C, tt) do { if ((tt) >= tbeg) { K = *(const u32x4*)(kg + (size_t)(tt) * 64 * NQKV); V = *(const u32x4*)(vg + (size_t)(tt) * 64 * NQKV); \
        if (MODE == 0 && tid < 16) C = *(const f32x4*)(cum_bh + (tt) * 64 + 4 * tid); } } while (0)
#define U64_STAGE(K, V, C, buf) do { *(LAS u32x4*)((buf) + kdst) = K; *(LAS u32x4*)((buf) + vdst) = V; if (MODE == 0 && tid < 16) *(LAS f32x4*)((buf) + CUMOFF + tid * 16) = (cref - C) * L2E; } while (0)
#define LDS_BAR() asm volatile("s_waitcnt lgkmcnt(0)\n\ts_barrier" ::: "memory")
    u32x4 kA = {0u, 0u, 0u, 0u}, vA = kA, kB = kA, vB = kA; f32x4 cA = {0.f, 0.f, 0.f, 0.f}, cB = cA;
    U64_LOAD(kA, vA, cA, tend - 1); U64_LOAD(kB, vB, cB, tend - 2);
    bf16x8 qr[4];
#pragma unroll
    for (int ks = 0; ks < 4; ++ks) qr[ks] = *(const bf16x8*)(qkv + (rowbase + qw0 + r32) * NQKV + CQ + ks * 16 + hi * 8);
    float m = -1e30f, l = 0.f;
    f32x16 o[2];
#pragma unroll
    for (int db = 0; db < 2; ++db)
#pragma unroll
        for (int r = 0; r < 16; ++r) o[db][r] = 0.f;
    const int vb = (4 * hi + ((lane & 15) >> 2)) * 64 + ((lane >> 4) & 1) * 32 + (lane & 3) * 8;
    LAS const float* tab = (LAS const float*)(lds + LDS_TAB) + h * 192;
    auto compute = [&](const int t, LAS unsigned char* const buf) __attribute__((always_inline)) {
        const int kv0 = kvoff + 64 * t;
        bool doit;
        if (MODE == 0) doit = kv0 <= qw0 + 31; else { const int kc = c0 - 8 + t; doit = (kc >= cw - 8) && (kc <= cw); }
        if (doit) {
            f32x16 p0 = (f32x16){0.f, 0.f, 0.f, 0.f, 0.f, 0.f, 0.f, 0.f, 0.f, 0.f, 0.f, 0.f, 0.f, 0.f, 0.f, 0.f}, p1 = p0;
            if (MODE == 2 && cw - (c0 - 8 + t) >= 3) { const float bv = tab[191];
#pragma unroll
                for (int r = 0; r < 16; ++r) { p0[r] = bv; p1[r] = bv; } }
            if (MODE == 0) {
#pragma unroll
                for (int g = 0; g < 4; ++g) { const f32x4 ca = *(LAS const f32x4*)(buf + CUMOFF + (8 * g + 4 * hi) * 4), cb = *(LAS const f32x4*)(buf + CUMOFF + (32 + 8 * g + 4 * hi) * 4);
#pragma unroll
                    for (int i = 0; i < 4; ++i) { p0[4 * g + i] = ca[i]; p1[4 * g + i] = cb[i]; } }
            }
            qk_tile(p0, p1, (LAS const char*)buf, qr, r32, hi);
            if (MODE == 0) {
                if (kv0 + 63 > qw0) {
                    const int qa = qw0 + r32 - kv0 - 4 * hi;
#pragma unroll
                    for (int r = 0; r < 16; ++r) { const int kl = (r & 3) + 8 * (r >> 2); if (kl > qa) p0[r] = -INFINITY; if (kl + 32 > qa) p1[r] = -INFINITY; }
                }
            } else {
                const int dc = cw - (c0 - 8 + t);
                if (dc < 3) {
                    const int rel0 = qw0 + r32 - kv0 - 4 * hi + 63;
#pragma unroll
                    for (int r = 0; r < 16; ++r) { const int kl = (r & 3) + 8 * (r >> 2);
                        int i0 = rel0 - kl, i1 = rel0 - kl - 32; i0 = i0 < 0 ? 0 : (i0 > 191 ? 191 : i0); i1 = i1 < 0 ? 0 : (i1 > 191 ? 191 : i1);
                        p0[r] += tab[i0]; p1[r] += tab[i1]; }
                }
            }
            softmax_pv<2>(p0, p1, m, l, o, (LAS const char*)buf + KT_BYTES, vb);
        }
    };
    int pi = 0;
    for (int t = tend - 1; t >= tbeg; t -= 2, pi ^= 1) {
        LAS unsigned char* const sb = lds + (pi ? 2 * BUFSZ : 0); const bool two = (t - 1 >= tbeg);
        U64_STAGE(kA, vA, cA, sb); if (two) U64_STAGE(kB, vB, cB, sb + BUFSZ);
        LDS_BAR();
        U64_LOAD(kA, vA, cA, t - 2); U64_LOAD(kB, vB, cB, t - 3);
        compute(t, sb); if (two) compute(t - 1, sb + BUFSZ);
    }
#undef U64_LOAD
#undef U64_STAGE
    l += __shfl_xor(l, 32);
    const float inv = 1.0f / l;
    bf16* orow = mix + (rowbase + qw0 + r32) * MIXW + (MODE == 0 ? MX_FOX : MX_CHK) + h * 64 + 4 * hi;
#pragma unroll
    for (int db = 0; db < 2; ++db)
#pragma unroll
        for (int g = 0; g < 4; ++g) { u32x2 w; w.x = cvtpk(o[db][4 * g] * inv, o[db][4 * g + 1] * inv); w.y = cvtpk(o[db][4 * g + 2] * inv, o[db][4 * g + 3] * inv);
            *(u32x2*)(orow + 32 * db + 8 * g) = w; }
    __syncthreads();
}

template <int C>
__device__ __forceinline__ void diff_pass(const bf16* qkv, bf16* mix, float* park, int b, int h, int blk, float lam, float sl2, const float* gdiff, float outscale,
                                          LAS unsigned char* lds, int tid, int wave, int lane) {
    constexpr int VOFF = KT_BYTES, BUFSZ = VOFF + 16384;
    const int r32 = lane & 31, hi = lane >> 5;
    const size_t rowbase = (size_t)b * SEQ;
    const int Q0 = blk * 256, qw0 = Q0 + 32 * wave, cwv = qw0 >> 6, tend = 4 * (blk + 1);
    const int srow = tid >> 3, sch = tid & 7;
    const int vrow0 = tid >> 4, vch = tid & 15;
    const bf16* vg = qkv + (rowbase + vrow0) * NQKV + C_DV + h * 128 + vch * 8;
    const int kdst = srow * KROWB + sch * 16, vdst = VOFF + (vch >> 2) * 4096 + vrow0 * 64 + (vch & 3) * 16;
    const int vb = (4 * hi + ((lane & 15) >> 2)) * 64 + ((lane >> 4) & 1) * 32 + (lane & 3) * 8;
    const bf16* kg = qkv + (rowbase + srow) * NQKV + C_DK + h * 128 + C * 64 + sch * 8;
#define DF_LOAD(K, V0, V1, tt) do { if ((tt) >= 0) { const size_t go_ = (size_t)(tt) * 64 * NQKV; K = *(const u32x4*)(kg + go_); V0 = *(const u32x4*)(vg + go_); V1 = *(const u32x4*)(vg + go_ + (size_t)32 * NQKV); } } while (0)
#define DF_STAGE(K, V0, V1, buf) do { *(LAS u32x4*)((buf) + kdst) = K; *(LAS u32x4*)((buf) + vdst) = V0; *(LAS u32x4*)((buf) + vdst + 32 * 64) = V1; } while (0)
    u32x4 kA = {0u, 0u, 0u, 0u}, v0A = kA, v1A = kA, kB = kA, v0B = kA, v1B = kA;
    DF_LOAD(kA, v0A, v1A, tend - 1); DF_LOAD(kB, v0B, v1B, tend - 2);
    bf16x8 qr[4];
#pragma unroll
    for (int ks = 0; ks < 4; ++ks) qr[ks] = *(const bf16x8*)(qkv + (rowbase + qw0 + r32) * NQKV + C_DQ + h * 128 + C * 64 + ks * 16 + hi * 8);
    float m = -1e30f, l = 0.f;
    f32x16 o[4];
#pragma unroll
    for (int db = 0; db < 4; ++db)
#pragma unroll
        for (int r = 0; r < 16; ++r) o[db][r] = 0.f;
    f32x16 ab;
#pragma unroll
    for (int r = 0; r < 16; ++r) ab[r] = sl2 * (float)((r & 3) + 8 * (r >> 2) + 4 * hi);
    auto compute = [&](const int t, LAS unsigned char* const buf) __attribute__((always_inline)) {
        if (t <= cwv) {
            const int kv0 = 64 * t;
            f32x16 p0, p1;
            if (t < cwv) { const float d0 = sl2 * (float)(64 * (t - cwv)), d1 = d0 + 32.f * sl2;
#pragma unroll
                for (int r = 0; r < 16; ++r) { p0[r] = ab[r] + d0; p1[r] = ab[r] + d1; }
                qk_tile(p0, p1, (LAS const char*)buf, qr, r32, hi);
            } else { p0 = (f32x16){0.f, 0.f, 0.f, 0.f, 0.f, 0.f, 0.f, 0.f, 0.f, 0.f, 0.f, 0.f, 0.f, 0.f, 0.f, 0.f}; p1 = p0;
                qk_tile(p0, p1, (LAS const char*)buf, qr, r32, hi);
                const float ql = (float)(qw0 + r32 - kv0), base = ql - (float)(4 * hi);
#pragma unroll
                for (int r = 0; r < 16; ++r) { const float kl = (float)((r & 3) + 8 * (r >> 2)); p0[r] += sl2 * (ql - fabsf(base - kl)); p1[r] += sl2 * (ql - fabsf(base - kl - 32.f)); }
            }
            softmax_pv<4>(p0, p1, m, l, o, (LAS const char*)buf + VOFF, vb);
        }
    };
    int pi = 0;
    for (int t = tend - 1; t >= 0; t -= 2, pi ^= 1) {
        LAS unsigned char* const sb = lds + (pi ? 2 * BUFSZ : 0);
        DF_STAGE(kA, v0A, v1A, sb); DF_STAGE(kB, v0B, v1B, sb + BUFSZ);
        LDS_BAR();
        DF_LOAD(kA, v0A, v1A, t - 2); DF_LOAD(kB, v0B, v1B, t - 3);
        compute(t, sb); compute(t - 1, sb + BUFSZ);
    }
#undef DF_LOAD
#undef DF_STAGE
    l += __shfl_xor(l, 32);
    const float inv = 1.0f / l;
    if (C == 0) {
#pragma unroll
        for (int db = 0; db < 4; ++db)
#pragma unroll
            for (int r = 0; r < 16; ++r) park[(db * 16 + r) * NTHREADS] = o[db][r] * inv;
    } else {
        const float li = lam * inv;
        float ss = 0.f;
#pragma unroll
        for (int db = 0; db < 4; ++db) {
#pragma unroll
            for (int r = 0; r < 16; ++r) { const float v = park[(db * 16 + r) * NTHREADS] - o[db][r] * li; o[db][r] = v; ss += v * v; }
            asm volatile("" ::: "memory"); }
        ss += __shfl_xor(ss, 32);
        const float rn = outscale / sqrtf(ss * (1.f / 128.f) + RMS_EPS);
        bf16* orow = mix + (rowbase + qw0 + r32) * MIXW + MX_DIFF + h * 128 + 4 * hi;
#pragma unroll
        for (int db = 0; db < 4; ++db)
#pragma unroll
            for (int g = 0; g < 4; ++g) { const f32x4 gg = *(const f32x4*)(gdiff + 32 * db + 8 * g + 4 * hi);
                u32x2 w; w.x = cvtpk(o[db][4 * g] * rn * gg.x, o[db][4 * g + 1] * rn * gg.y); w.y = cvtpk(o[db][4 * g + 2] * rn * gg.z, o[db][4 * g + 3] * rn * gg.w);
                *(u32x2*)(orow + 32 * db + 8 * g) = w; }
    }
    __syncthreads();
}
__device__ __forceinline__ void attn_unit_diff2(const bf16* qkv, bf16* mix, int b, int h, int blk, float lam, float sl2, const float* gdiff, float outscale,
                                                LAS unsigned char* lds, int tid, int wave, int lane) {
    float* park = (float*)((unsigned char*)qkv - WS_QKV + WS_H) + (size_t)blockIdx.x * 64 * NTHREADS + tid;
    diff_pass<0>(qkv, mix, park, b, h, blk, lam, sl2, gdiff, outscale, lds, tid, wave, lane);
    int tid2 = threadIdx.x; asm volatile("" : "+v"(tid2) :: "memory"); __builtin_amdgcn_sched_barrier(0);
    float* park2 = (float*)((unsigned char*)qkv - WS_QKV + WS_H) + (size_t)blockIdx.x * 64 * NTHREADS + tid2;
    diff_pass<1>(qkv, mix, park2, b, h, blk, lam, sl2, gdiff, outscale, lds, tid2, __builtin_amdgcn_readfirstlane(tid2 >> 6), tid2 & 63);
}
#define SF(q) (0 << 5 | (q) << 1 | 0), (0 << 5 | (q) << 1 | 1)
#define SD(q) (1 << 5 | (q) << 1 | 0)
#define SC(q) (2 << 5 | (q) << 1 | 0), (2 << 5 | (q) << 1 | 1)
__device__ __forceinline__ int seg_code(int s) {
    constexpr unsigned char T[40] = { SD(7), SD(6), SD(5), SD(4), SD(3), SF(7), SD(2), SF(6), SF(5), SD(1), SF(4), SF(3), SD(0), SF(2),
        SC(7), SC(6), SC(5), SC(4), SC(3), SC(2), SC(1), SC(0), SF(1), SF(0) };
    return T[s];
}
__device__ __forceinline__ void phase_attn(const Args& a, int layer, unsigned* ctr, LAS unsigned char* lds, int tid0, int wave0, int lane0) {
    const bf16* qkv = (const bf16*)(a.ws + WS_QKV); bf16* mix = (bf16*)(a.ws + WS_MIX); const float* CUM = (const float*)(a.ws + WS_CUM);
    for (int i = tid0; i < 4 * 192; i += NTHREADS) ((LAS float*)(lds + LDS_TAB))[i] = a.in[6][(size_t)layer * 768 + i] * L2E;
    const float* dl = a.in[4] + (size_t)layer * 256;
    const float s01 = wave_sum(dl[lane0] * dl[64 + lane0]), s23 = wave_sum(dl[128 + lane0] * dl[192 + lane0]);
    const float lambda_init = 0.8f - 0.6f * expf(-0.3f * (float)layer);
    const float lam = expf(s01) - expf(s23) + lambda_init;
    const float* gdiff = a.in[5] + (size_t)layer * 128;
    LAS volatile unsigned* misc = (LAS volatile unsigned*)(lds + LDS_MISC);
    __syncthreads();
    for (;;) {
        if (threadIdx.x == 0) misc[0] = atomicAdd(ctr, 1u);
        __syncthreads();
        const unsigned idx = misc[0];
        int tidf = threadIdx.x; asm volatile("" : "+v"(tidf) :: "memory"); __builtin_amdgcn_sched_barrier(0);
        const int tid = tidf, lane = tidf & 63, wave = __builtin_amdgcn_readfirstlane(tidf >> 6);
        if (idx >= 1280u) break;
        const int code = seg_code((int)(idx >> 5)), kind = code >> 5, blk = (code >> 1) & 15, sub = (int)(idx & 31);
        if (kind == 1) { const int b = sub >> 1, h = sub & 1;
            attn_unit_diff2(qkv, mix, b, h, blk, lam, exp2f(-4.0f * (float)(h + 1)) * L2E, gdiff, 1.0f - lambda_init, lds, tid, wave, lane); }
        else { const int bh = (code & 1) * 32 + sub, b = bh >> 2, h = bh & 3;
            if (kind == 0) attn_unit64<0>(qkv, mix, CUM + (size_t)bh * SEQ, b, h, blk, lds, tid, wave, lane);
            else attn_unit64<2>(qkv, mix, nullptr, b, h, blk, lds, tid, wave, lane); }
    }
}
#define XB_TMO      128
#define XB_XCNT(j)  (256  + 64 * (j))
#define XB_XSUB(j)  (1280 + 64 * (j))
#define XB_XGEN(j)  (2304 + 64 * (j))
#define XB_TOP      3328
#define XB_TOPGEN   3392
#define XCD_BAR_WORDS 3456
#define XB_SPIN_CAP (1u << 18)

__device__ __forceinline__ unsigned xb_ld(unsigned* p)              { return __hip_atomic_load(p, __ATOMIC_RELAXED, __HIP_MEMORY_SCOPE_AGENT); }
__device__ __forceinline__ unsigned xb_add(unsigned* p, unsigned v) { return __hip_atomic_fetch_add(p, v, __ATOMIC_RELAXED, __HIP_MEMORY_SCOPE_AGENT); }
__device__ __forceinline__ unsigned xb_xcc_id() { return (unsigned)__builtin_amdgcn_s_getreg((3 << 11) | 20) & 0xFu; }
#define XB_SPIN(cond, bar) do { unsigned _sp = 0; while (cond) { __builtin_amdgcn_s_sleep(1); \
    if ((++_sp & 255u) == 0u) { if (xb_ld(&(bar)[XB_TMO])) break; if (_sp > XB_SPIN_CAP) { atomicAdd(&(bar)[XB_TMO], 1u); break; } } } } while (0)

struct XcdBarrier {
    unsigned* bar; unsigned x;
    volatile LAS unsigned* st;
};

__device__ __forceinline__ XcdBarrier xcd_barrier_post(unsigned* bar, volatile LAS unsigned* st) {
    XcdBarrier b; b.bar = bar; b.x = xb_xcc_id(); b.st = st;
    if (threadIdx.x == 0) (void)xb_add(&bar[XB_XCNT(b.x)], 1u);
    return b;
}
__device__ __forceinline__ void xcd_barrier_complete(unsigned* bar, unsigned x, unsigned& nloc, unsigned& nx) {
    const unsigned G = gridDim.x * gridDim.y * gridDim.z;
    unsigned sum, cnt, mine, sp = 0u;
    for (;;) {
        sum = 0u; cnt = 0u; mine = 0u;
#pragma unroll
        for (unsigned j = 0; j < 16; ++j) { const unsigned c = xb_ld(&bar[XB_XCNT(j)]); sum += c; cnt += (c > 0u) ? 1u : 0u; mine = (j == x) ? c : mine; }
        if (sum == G) break;
        __builtin_amdgcn_s_sleep(1);
        if ((++sp & 255u) == 0u) { if (xb_ld(&bar[XB_TMO])) break; if (sp > XB_SPIN_CAP) { atomicAdd(&bar[XB_TMO], 1u); break; } }
    }
    nloc = mine > 0u ? mine : 1u; nx = cnt > 0u ? cnt : 1u;
}

__device__ __forceinline__ void xcd_barrier(const XcdBarrier& b) {
    asm volatile("s_waitcnt vmcnt(0)" ::: "memory");
    __syncthreads();
    if (threadIdx.x == 0) {
        unsigned* bar = b.bar;
        __builtin_amdgcn_s_waitcnt(0);
        unsigned nloc = b.st[0], nx = b.st[1];
        if (nloc == 0u) { xcd_barrier_complete(bar, b.x, nloc, nx); b.st[0] = nloc; b.st[1] = nx; }
        const unsigned old = xb_add(&bar[XB_XSUB(b.x)], 1u);
        const unsigned gen = old / nloc;
        if (old + 1u == (gen + 1u) * nloc) {
            __builtin_amdgcn_fence(__ATOMIC_RELEASE, "agent");
            asm volatile("s_waitcnt vmcnt(0)" ::: "memory");
            const unsigned og = xb_add(&bar[XB_TOP], 1u);
            const unsigned tg = og / nx;
            if (og + 1u == (tg + 1u) * nx) xb_add(&bar[XB_TOPGEN], 1u);
            else XB_SPIN(xb_ld(&bar[XB_TOPGEN]) == tg, bar);
            __builtin_amdgcn_fence(__ATOMIC_ACQUIRE, "agent");
            xb_add(&bar[XB_XGEN(b.x)], 1u);
            asm volatile("s_waitcnt vmcnt(0)" ::: "memory");
        } else {
            XB_SPIN(xb_ld(&bar[XB_XGEN(b.x)]) == gen, bar);
            __builtin_amdgcn_fence(__ATOMIC_ACQUIRE, "agent");
            asm volatile("s_waitcnt vmcnt(0)" ::: "memory");
        }
    }
    __syncthreads();
}

#define GEMM_RUN(EPI, Aptr, Bptr, Mv, Nv, Kv, Eobj) GEMM_RUN2(EPI, Aptr, Bptr, Mv, Nv, Kv, Eobj, true, true)
#define GEMM_RUN2(EPI, Aptr, Bptr, Mv, Nv, Kv, Eobj, ALIGNV, SP2V) do { pg8::Gemm g_{(const pg8::bf16_t*)(Aptr), (const pg8::bf16_t*)(Bptr), (Mv), (Nv), (Kv)}; pg8::StaticOrder S_; S_.init((Mv), (Nv), (int)gridDim.x, (int)blockIdx.x); \
    pg8::gemm_phase<EPI, pg8::StaticOrder, ALIGNV, SP2V>(lds, g_, S_, Eobj); } while (0)

__global__ void __launch_bounds__(NTHREADS, 2) mk_fwd(Args a) {
    __shared__ __attribute__((aligned(16))) unsigned char lds_raw[LDS_BYTES];
    LAS unsigned char* lds = (LAS unsigned char*)lds_raw;
    cg::grid_group grid = cg::this_grid();
#define FRESH int tid = threadIdx.x; asm volatile("" : "+v"(tid)); const int lane = tid & 63, wave = __builtin_amdgcn_readfirstlane(tid >> 6); const int G = gridDim.x, gw = blockIdx.x * NWAVES + wave, NGW = G * NWAVES; (void)lane; (void)gw; (void)NGW; (void)G
    unsigned* ctl = (unsigned*)(a.ws + WS_CTL);
    unsigned* barw = ctl + 4096;
    volatile LAS unsigned* bst = (volatile LAS unsigned*)(lds + LDS_MISC + 64);
    if (threadIdx.x < 2) bst[threadIdx.x] = 0u;
    __syncthreads();
    if (a.out == nullptr) grid.sync();
    const XcdBarrier xbar = xcd_barrier_post(barw, bst);
#define GSYNC() xcd_barrier(xbar)
    bf16* H = (bf16*)(a.ws + WS_H); bf16* QKV = (bf16*)(a.ws + WS_QKV); bf16* MIX = (bf16*)(a.ws + WS_MIX); bf16* UV = (bf16*)(a.ws + WS_UV); bf16* ACT = (bf16*)(a.ws + WS_ACT); bf16* XB = (bf16*)(a.ws + WS_XB); float* RSTD = (float*)(a.ws + WS_CTL + 65536);
    float* FF = (float*)(a.ws + WS_FF); float* CUM = (float*)(a.ws + WS_CUM);
    { FRESH; phase_weights(a, lds, gw, NGW, wave, lane); }
    for (int l = 0; l < DEPTH; ++l) {
        if (l == 0) { FRESH; phase_norm<1, false>(a.in[0], a.in[1] + (size_t)l * DM, XB, RSTD, a.in[2] + (size_t)l * DM * NIN_SRC, a.in[3] + l * 4, FF, lds, gw, NGW, tid, lane); }
        else { FRESH; phase_norm<1, true>(XB, a.in[1] + (size_t)l * DM, nullptr, RSTD, a.in[2] + (size_t)l * DM * NIN_SRC, a.in[3] + l * 4, FF, lds, gw, NGW, tid, lane); }
        GSYNC();
        { FRESH; if (blockIdx.x < 64 && wave == 0) cumsum_seq(FF, CUM, blockIdx.x, lane); }
        { pg8::EpiBf16S E{(pg8::bf16_t*)QKV, NQKV, RSTD}; GEMM_RUN(pg8::EpiBf16S, XB, a.ws + WS_WIN + l * SZ_WIN, MTOK, NQKV, DM, E); }
        GSYNC();
        { FRESH; phase_attn(a, l, ctl + 64 * l, lds, tid, wave, lane); }
        GSYNC();
        { pg8::EpiResBS<false> E{XB, (pg8::bf16_t*)XB, DM, (float*)H}; GEMM_RUN(pg8::EpiResBS<false>, MIX, a.ws + WS_WOUT + l * SZ_WOUT, MTOK, DM, MIXW, E); }
        GSYNC();
        { FRESH; if (blockIdx.x < MTOK / NTHREADS) { const int row = blockIdx.x * NTHREADS + tid; const f32x4* p = (const f32x4*)((const float*)H + (size_t)row * 16);
            const f32x4 s4 = (p[0] + p[1]) + (p[2] + p[3]); RSTD[row] = 1.0f / sqrtf(((s4[0] + s4[1]) + (s4[2] + s4[3])) * (1.f / DM) + RMS_EPS); } }
        GSYNC();
        { pg8::EpiConv E{(pg8::bf16_t*)ACT, (pg8::bf16_t*)UV, a.in[10] + (size_t)l * 3 * NFF2, a.in[11] + (size_t)l * NFF2, RSTD}; GEMM_RUN(pg8::EpiConv, XB, a.ws + WS_WFI + l * SZ_WFI, MTOK, NFF2, DM, E); }
        GSYNC();
        { FRESH; phase_fixup(UV, ACT, a.in[10] + (size_t)l * 3 * NFF2, a.in[11] + (size_t)l * NFF2, blockIdx.x * NTHREADS + tid, G * NTHREADS); }
        GSYNC();
        { pg8::EpiResB<false> E{XB, (pg8::bf16_t*)XB, DM}; GEMM_RUN(pg8::EpiResB<false>, ACT, a.ws + WS_WFO + l * SZ_WFO, MTOK, DM, DFF, E); }
        GSYNC();
    }
    { FRESH; phase_norm<2, true>(XB, a.in[13], nullptr, a.out, nullptr, nullptr, nullptr, lds, gw, NGW, tid, lane); }
}

extern "C" void kernel_launch(void* const* d_in, const int* in_sizes, int n_in, void* d_out, int out_size, void* d_ws, size_t ws_size, hipStream_t stream) {
    static int grid_blocks = 0;
    if (grid_blocks == 0) {
        if (n_in != 14 || out_size != MTOK * DM || ws_size < WS_END || in_sizes[2] != DEPTH * DM * NIN_SRC || in_sizes[7] != DEPTH * MIXW * DM || in_sizes[9] != DEPTH * DM * NFF2 || in_sizes[12] != DEPTH * DFF * DM || in_sizes[6] != DEPTH * 4 * 192 || in_sizes[5] != DEPTH * 128) { fprintf(stderr, "kernel_launch: unexpected sizes n_in %d out %d ws %zu\n", n_in, out_size, ws_size); grid_blocks = -1; return; }
        int dev = 0, cus = 0, per_cu = 0;
        (void)hipGetDevice(&dev);
        (void)hipDeviceGetAttribute(&cus, hipDeviceAttributeMultiprocessorCount, dev);
        (void)hipOccupancyMaxActiveBlocksPerMultiprocessor(&per_cu, (const void*)mk_fwd, NTHREADS, 0);
        if (per_cu < 1) { fprintf(stderr, "kernel_launch: occupancy query says %d blocks/CU\n", per_cu); per_cu = 1; }
        (void)hipGetLastError();
        grid_blocks = cus * 1;
        fprintf(stderr, "kernel_launch: cus %d per_cu %d grid %d\n", cus, per_cu, grid_blocks);
    }
    if (grid_blocks < 0) return;
    if (hipMemsetAsync((char*)d_ws + WS_CTL, 0, 65536, stream) != hipSuccess) { fprintf(stderr, "kernel_launch: memset of control words failed\n"); return; }
    Args a{};
    for (int i = 0; i < 14; ++i) a.in[i] = (const float*)d_in[i];
    a.out = (float*)d_out; a.ws = (unsigned char*)d_ws;
    void* args[] = {&a};
    hipError_t e = hipLaunchCooperativeKernel((const void*)mk_fwd, dim3(grid_blocks), dim3(NTHREADS), args, 0, stream);
    if (e != hipSuccess) fprintf(stderr, "cooperative launch failed: %s (grid %d)\n", hipGetErrorString(e), grid_blocks);
}
```

```cpp
#include <hip/hip_runtime.h>
#include <cstdio>
#include <cstdint>
#include <hip/hip_cooperative_groups.h>
namespace cg = cooperative_groups;
namespace pg8 {
#define PG8_LAS __attribute__((address_space(3)))
typedef unsigned short bf16_t;
typedef short bf16x8 __attribute__((ext_vector_type(8)));
typedef float f32x4 __attribute__((ext_vector_type(4)));
typedef unsigned u32x4 __attribute__((ext_vector_type(4)));
constexpr int BM = 256, BK = 64, HALF = 128, HTB = HALF * BK * 2  , STAGE_BYTES = 8 * HTB, NXCD = 8, WGM = 8;

__host__ __device__ __forceinline__ int lds_byte(int r, int c) { const int st = (r >> 4) * 2 + (c >> 5), rr = r & 15, cc = c & 31, ob = rr * 64 + cc * 2; return st * 1024 + (ob ^ (((ob >> 9) & 1) << 5)); }
__host__ __device__ __forceinline__ void stage_rc(int b, int& R, int& C) { const int st = b / 1024, sb = b % 1024, swz = sb ^ (((sb >> 9) & 1) << 5); R = (st >> 1) * 16 + swz / 64; C = (st & 1) * 32 + (swz % 64) / 2; }
__host__ __device__ __forceinline__ int perm32(int rho) { const int n = rho >> 4, i = rho & 15; return 8 * (i >> 2) + 4 * n + (i & 3); }

struct Unit { int pm, pn; };
struct Gemm { const bf16_t* A; const bf16_t* Bt; int M, N, K; };

struct StaticOrder {
    int nM, nN, nwg, G, c;
    __host__ __device__ void init(int M, int N, int G_, int c_) { nM = M / BM; nN = N / BM; nwg = nM * nN; G = G_; c = c_; }
    __host__ __device__ bool next(int i, Unit& u) const {
        const long L = (long)i * G + c; if (L >= nwg) return false;
        int wgid = (int)L; { const int q = nwg / NXCD, r = nwg % NXCD, xcd = wgid % NXCD, off = wgid / NXCD; wgid = (xcd < r ? xcd * (q + 1) : r * (q + 1) + (xcd - r) * q) + off; }
        const int nig = WGM * nN, gid = wgid / nig, fm = gid * WGM, gsz = (nM - fm) < WGM ? (nM - fm) : WGM;
        u.pm = fm + ((wgid % nig) % gsz); u.pn = (wgid % nig) / gsz; return true;
    }
    __device__ __forceinline__ void a_ready(const Unit&) const {}
    __device__ __forceinline__ void done(const Unit&) const {}
};

typedef float f32x2c __attribute__((ext_vector_type(2))); typedef __bf16 bf16x2c __attribute__((ext_vector_type(2)));
__device__ __forceinline__ unsigned cvt_pk_bf16(float lo, float hi) { f32x2c v = {lo, hi}; bf16x2c b = __builtin_convertvector(v, bf16x2c); return __builtin_bit_cast(unsigned, b); }
typedef float f32x2 __attribute__((ext_vector_type(2)));
struct EpiBf16 {
    static constexpr bool PERM = true, AFTER_DRAIN = false, APERM = false;
    bf16_t* O; int ldc;
    __device__ __forceinline__ void operator()(const f32x4 (&acc)[2][2][4][2], const Unit& u, int wr, int wc, int fr, int fq) const {
        const int row0 = u.pm * BM + wr * 64 + fr; const int col0 = u.pn * BM + wc * 32 + 8 * fq;
#pragma unroll
        for (int ai = 0; ai < 2; ++ai)
#pragma unroll
            for (int m = 0; m < 4; ++m) { bf16_t* rowp = O + (size_t)(row0 + ai * HALF + m * 16) * ldc + col0;
#pragma unroll
                for (int bj = 0; bj < 2; ++bj) { const f32x4 v0 = acc[ai][bj][m][0], v1 = acc[ai][bj][m][1];
                    u32x4 w; w.x = cvt_pk_bf16(v0[0], v0[1]); w.y = cvt_pk_bf16(v0[2], v0[3]); w.z = cvt_pk_bf16(v1[0], v1[1]); w.w = cvt_pk_bf16(v1[2], v1[3]);
                    *(u32x4*)(rowp + bj * HALF) = w; } }
    }
};
struct EpiRes {
    static constexpr bool PERM = false, AFTER_DRAIN = false, APERM = false;
    const float* base; float* out; int ldc; float scale;
    __device__ __forceinline__ void operator()(const f32x4 (&acc)[2][2][4][2], const Unit& u, int wr, int wc, int fr, int fq) const {
        const int col0 = u.pn * BM + wc * 32 + 4 * fq;
#pragma unroll
        for (int ai = 0; ai < 2; ++ai)
#pragma unroll
            for (int m = 0; m < 4; ++m) { const size_t off = (size_t)(u.pm * BM + ai * HALF + wr * 64 + m * 16 + fr) * ldc + col0;
#pragma unroll
                for (int bj = 0; bj < 2; ++bj)
#pragma unroll
                    for (int n = 0; n < 2; ++n) { const f32x4 bs = *(const f32x4*)(base + off + bj * HALF + n * 16); *(f32x4*)(out + off + bj * HALF + n * 16) = bs + acc[ai][bj][m][n] * scale; } }
    }
};

__device__ __forceinline__ f32x4 dpp_shr1(f32x4 v) { f32x4 r;
#pragma unroll
    for (int i = 0; i < 4; ++i) r[i] = __shfl_up(v[i], 1, 16);
    return r; }
__device__ __forceinline__ f32x4 silu_mul(f32x4 yu, f32x4 yg) { f32x4 o;
#pragma unroll
    for (int i = 0; i < 4; ++i) o[i] = yu[i] * yg[i] * __builtin_amdgcn_rcpf(1.0f + __builtin_amdgcn_exp2f(-1.4426950408889634f * yg[i]));
    return o; }
struct EpiConv {
    static constexpr bool PERM = false, AFTER_DRAIN = false, APERM = true;
    bf16_t* act; bf16_t* halo; const float* cw; const float* cb; const float* rstd;
    typedef unsigned u32x2e __attribute__((ext_vector_type(2)));
    __device__ __forceinline__ void conv4(f32x4 (&y)[4], const f32x4 (&a4)[4][2], int n, const f32x4 rs, const f32x4 w0, const f32x4 w1, const f32x4 w2, const f32x4 b, int col, int fr, bf16_t* hp) const {
        constexpr int N2 = 5632;
        const f32x4 X0 = a4[0][n] * rs[0], X1 = a4[1][n] * rs[1], X2 = a4[2][n] * rs[2], X3 = a4[3][n] * rs[3];
        const f32x4 Xm1 = dpp_shr1(X3), Xm2 = dpp_shr1(X2);
        y[0] = b + w0 * Xm2 + w1 * Xm1 + w2 * X0;
        y[1] = b + w0 * Xm1 + w1 * X0 + w2 * X1;
        y[2] = b + w0 * X0 + w1 * X1 + w2 * X2;
        y[3] = b + w0 * X1 + w1 * X2 + w2 * X3;
        if (fr == 0 || fr == 15) { const f32x4 xa = fr == 0 ? X0 : X2, xb = fr == 0 ? X1 : X3;
            u32x2e w; w.x = cvt_pk_bf16(xa[0], xa[1]); w.y = cvt_pk_bf16(xa[2], xa[3]); *(u32x2e*)(hp + col) = w;
            w.x = cvt_pk_bf16(xb[0], xb[1]); w.y = cvt_pk_bf16(xb[2], xb[3]); *(u32x2e*)(hp + N2 + col) = w; }
    }
    __device__ __forceinline__ void operator()(const f32x4 (&acc)[2][2][4][2], const Unit& u, int wr, int wc, int fr, int fq) const {
        constexpr int DFFc = 2816, N2 = 5632;
#pragma unroll
        for (int n = 0; n < 2; ++n) {
            const int cu = u.pn * 128 + wc * 32 + n * 16 + 4 * fq, cg = DFFc + cu;
            const f32x4 w0u = *(const f32x4*)(cw + cu), w1u = *(const f32x4*)(cw + N2 + cu), w2u = *(const f32x4*)(cw + 2 * N2 + cu), bu = *(const f32x4*)(cb + cu);
            const f32x4 w0g = *(const f32x4*)(cw + cg), w1g = *(const f32x4*)(cw + N2 + cg), w2g = *(const f32x4*)(cw + 2 * N2 + cg), bg = *(const f32x4*)(cb + cg);
#pragma unroll
            for (int ai = 0; ai < 2; ++ai) {
                const int row0 = u.pm * BM + ai * HALF + wr * 64 + 4 * fr;
                const f32x4 rs = *(const f32x4*)(rstd + row0);
                bf16_t* hp = halo + ((size_t)(row0 >> 6) * 4 + (fr == 0 ? 0 : 2)) * N2;
                f32x4 yu[4], yg[4];
                conv4(yu, acc[ai][0], n, rs, w0u, w1u, w2u, bu, cu, fr, hp);
                conv4(yg, acc[ai][1], n, rs, w0g, w1g, w2g, bg, cg, fr, hp);
#pragma unroll
                for (int m = 0; m < 4; ++m) if (fr != 0 || m >= 2) { const f32x4 o = silu_mul(yu[m], yg[m]); u32x2e w; w.x = cvt_pk_bf16(o[0], o[1]); w.y = cvt_pk_bf16(o[2], o[3]);
                    *(u32x2e*)(act + (size_t)(row0 + m) * DFFc + cu) = w; }
            }
        }
    }
};

template <bool BASE_F32> struct EpiResB {
    static constexpr bool PERM = true, AFTER_DRAIN = false, APERM = false;
    const void* base; bf16_t* out; int ldc;
    __device__ __forceinline__ void operator()(const f32x4 (&acc)[2][2][4][2], const Unit& u, int wr, int wc, int fr, int fq) const {
        const int col0 = u.pn * BM + wc * 32 + 8 * fq;
#pragma unroll
        for (int ai = 0; ai < 2; ++ai)
#pragma unroll
            for (int m = 0; m < 4; ++m) { const size_t off = (size_t)(u.pm * BM + ai * HALF + wr * 64 + m * 16 + fr) * ldc + col0;
#pragma unroll
                for (int bj = 0; bj < 2; ++bj) { f32x4 b0, b1;
                    if (BASE_F32) { b0 = *(const f32x4*)((const float*)base + off + bj * HALF); b1 = *(const f32x4*)((const float*)base + off + bj * HALF + 4); }
                    else { const u32x4 r = *(const u32x4*)((const bf16_t*)base + off + bj * HALF);
                        b0[0] = __uint_as_float(r.x << 16); b0[1] = __uint_as_float(r.x & 0xffff0000u); b0[2] = __uint_as_float(r.y << 16); b0[3] = __uint_as_float(r.y & 0xffff0000u);
                        b1[0] = __uint_as_float(r.z << 16); b1[1] = __uint_as_float(r.z & 0xffff0000u); b1[2] = __uint_as_float(r.w << 16); b1[3] = __uint_as_float(r.w & 0xffff0000u); }
                    const f32x4 o0 = b0 + acc[ai][bj][m][0], o1 = b1 + acc[ai][bj][m][1];
                    u32x4 w; w.x = cvt_pk_bf16(o0[0], o0[1]); w.y = cvt_pk_bf16(o0[2], o0[3]); w.z = cvt_pk_bf16(o1[0], o1[1]); w.w = cvt_pk_bf16(o1[2], o1[3]);
                    *(u32x4*)(out + off + bj * HALF) = w; } }
    }
};

struct EpiBf16S {
    static constexpr bool PERM = true, AFTER_DRAIN = false, APERM = false;
    bf16_t* O; int ldc; const float* rs;
    __device__ __forceinline__ void operator()(const f32x4 (&acc)[2][2][4][2], const Unit& u, int wr, int wc, int fr, int fq) const {
        const int row0 = u.pm * BM + wr * 64 + fr; const int col0 = u.pn * BM + wc * 32 + 8 * fq;
#pragma unroll
        for (int ai = 0; ai < 2; ++ai)
#pragma unroll
            for (int m = 0; m < 4; ++m) { const int row = row0 + ai * HALF + m * 16; const float s = rs[row]; bf16_t* rowp = O + (size_t)row * ldc + col0;
#pragma unroll
                for (int bj = 0; bj < 2; ++bj) { const f32x4 v0 = acc[ai][bj][m][0] * s, v1 = acc[ai][bj][m][1] * s;
                    u32x4 w; w.x = cvt_pk_bf16(v0[0], v0[1]); w.y = cvt_pk_bf16(v0[2], v0[3]); w.z = cvt_pk_bf16(v1[0], v1[1]); w.w = cvt_pk_bf16(v1[2], v1[3]);
                    *(u32x4*)(rowp + bj * HALF) = w; } }
    }
};

template <bool BASE_F32> struct EpiResBS {
    static constexpr bool PERM = true, AFTER_DRAIN = false, APERM = false;
    const void* base; bf16_t* out; int ldc; float* part;
    __device__ __forceinline__ void operator()(const f32x4 (&acc)[2][2][4][2], const Unit& u, int wr, int wc, int fr, int fq) const {
        const int col0 = u.pn * BM + wc * 32 + 8 * fq;
#pragma unroll
        for (int ai = 0; ai < 2; ++ai)
#pragma unroll
            for (int m = 0; m < 4; ++m) { const int row = u.pm * BM + ai * HALF + wr * 64 + m * 16 + fr; const size_t off = (size_t)row * ldc + col0; float ss = 0.f;
#pragma unroll
                for (int bj = 0; bj < 2; ++bj) { f32x4 b0, b1;
                    if (BASE_F32) { b0 = *(const f32x4*)((const float*)base + off + bj * HALF); b1 = *(const f32x4*)((const float*)base + off + bj * HALF + 4); }
                    else { const u32x4 r = *(const u32x4*)((const bf16_t*)base + off + bj * HALF);
                        b0[0] = __uint_as_float(r.x << 16); b0[1] = __uint_as_float(r.x & 0xffff0000u); b0[2] = __uint_as_float(r.y << 16); b0[3] = __uint_as_float(r.y & 0xffff0000u);
                        b1[0] = __uint_as_float(r.z << 16); b1[1] = __uint_as_float(r.z & 0xffff0000u); b1[2] = __uint_as_float(r.w << 16); b1[3] = __uint_as_float(r.w & 0xffff0000u); }
                    const f32x4 o0 = b0 + acc[ai][bj][m][0], o1 = b1 + acc[ai][bj][m][1];
                    ss += (o0[0] * o0[0] + o0[1] * o0[1]) + (o0[2] * o0[2] + o0[3] * o0[3]) + (o1[0] * o1[0] + o1[1] * o1[1]) + (o1[2] * o1[2] + o1[3] * o1[3]);
                    u32x4 w; w.x = cvt_pk_bf16(o0[0], o0[1]); w.y = cvt_pk_bf16(o0[2], o0[3]); w.z = cvt_pk_bf16(o1[0], o1[1]); w.w = cvt_pk_bf16(o1[2], o1[3]);
                    *(u32x4*)(out + off + bj * HALF) = w; }
                ss += __shfl_xor(ss, 16); ss += __shfl_xor(ss, 32);
                if (fq == 0) part[(size_t)row * 16 + u.pn * 4 + wc] = ss; }
    }
};
template <class Epi, class Sched, bool ALIGN_EPI = false, bool SP2 = false>
__device__ __forceinline__ void gemm_phase(PG8_LAS unsigned char* lds, const Gemm g, const Sched& S, const Epi& E) {
    int tid_l = threadIdx.x; asm volatile("" : "+v"(tid_l)); const int tid = tid_l, wid = __builtin_amdgcn_readfirstlane(tid >> 6), lane = tid & 63, wr = wid >> 2, wc = wid & 3, fr = lane & 15, fq = lane >> 4;
    const int K = g.K, nt = K / BK;
    unsigned voffA[2], voffB[2];
#pragma unroll
    for (int i = 0; i < 2; ++i) { int R, C; stage_rc(tid * 16 + i * 8192, R, C); const int Rb = Epi::PERM ? ((R & ~31) + perm32(R & 31)) : R;
        const int Ra = Epi::APERM ? ((R & 64) + (R & 15) * 4 + ((R >> 4) & 3)) : R; voffA[i] = (unsigned)(Ra * K + C) * 2u; voffB[i] = (unsigned)(Rb * K + C) * 2u; }
    const size_t kstep = (size_t)(BK * 2);
    const size_t hstep = (size_t)HALF * K * 2;
    const size_t tstep = 2 * hstep;
    const unsigned ldsw = (unsigned)wid * 1024u;
    const int aoff = lds_byte(wr * 64 + fr, fq * 8), boff = lds_byte(wc * 32 + fr, fq * 8);
#define PG8_SA(b, h) (((b) * 2 + (h)) * HTB)
#define PG8_SB(b, h) ((4 + (b) * 2 + (h)) * HTB)
#define PG8_STAGE(bufoff, gbase, voff) do { _Pragma("unroll") for (int _i = 0; _i < 2; ++_i) \
        __builtin_amdgcn_global_load_lds((const unsigned*)((const char*)(gbase) + (voff)[_i]), (PG8_LAS unsigned*)(lds + (bufoff) + ldsw + _i * 8192), 16, 0, 0); } while (0)
#define PG8_LDA(dst, b, h) do { _Pragma("unroll") for (int m = 0; m < 4; ++m) _Pragma("unroll") for (int k = 0; k < 2; ++k) dst[m][k] = *(const PG8_LAS bf16x8*)(lds + PG8_SA(b, h) + aoff + m * 2048 + k * 1024); } while (0)
#define PG8_LDB(dst, b, h) do { _Pragma("unroll") for (int n = 0; n < 2; ++n) _Pragma("unroll") for (int k = 0; k < 2; ++k) dst[n][k] = *(const PG8_LAS bf16x8*)(lds + PG8_SB(b, h) + boff + n * 2048 + k * 1024); } while (0)
#define PG8_MMA(ai, bj, At, Bt) do { __builtin_amdgcn_s_setprio(1); _Pragma("unroll") for (int m = 0; m < 4; ++m) _Pragma("unroll") for (int n = 0; n < 2; ++n) _Pragma("unroll") for (int k = 0; k < 2; ++k) \
        acc[ai][bj][m][n] = __builtin_amdgcn_mfma_f32_16x16x32_bf16(Bt[n][k], At[m][k], acc[ai][bj][m][n], 0, 0, 0); __builtin_amdgcn_s_setprio(0); } while (0)
#define PG8_WAIT_V(n) asm volatile("s_waitcnt vmcnt(" #n ")" ::: "memory")
#define PG8_WAIT_L(n) asm volatile("s_waitcnt lgkmcnt(" #n ")" ::: "memory")
#define PG8_BAR __builtin_amdgcn_s_barrier()
#define PG8_SCHED __builtin_amdgcn_sched_barrier(0)
    Unit cur, nxt; int ui = 0;
    if (!S.next(0, cur)) return;
    f32x4 acc[2][2][4][2];
#pragma unroll
    for (int a = 0; a < 2; ++a)
#pragma unroll
        for (int b = 0; b < 2; ++b)
#pragma unroll
            for (int m = 0; m < 4; ++m)
#pragma unroll
                for (int n = 0; n < 2; ++n) acc[a][b][m][n] = (f32x4){0.f, 0.f, 0.f, 0.f};
    bf16x8 At[4][2], B0[2][2], B1[2][2];
    const char* cA = (const char*)g.A + (size_t)cur.pm * tstep; const char* cB = (const char*)g.Bt + (size_t)cur.pn * tstep;
    S.a_ready(cur);
    if constexpr (SP2) {
        PG8_STAGE(PG8_SB(0, 0), cB, voffB); PG8_STAGE(PG8_SB(0, 1), cB + hstep, voffB); PG8_STAGE(PG8_SA(0, 0), cA, voffA); PG8_STAGE(PG8_SA(0, 1), cA + hstep, voffA);
        if (wr == 1) PG8_BAR;
        PG8_WAIT_V(2); PG8_BAR;
        PG8_STAGE(PG8_SB(1, 0), cB + kstep, voffB); PG8_STAGE(PG8_SA(1, 0), cA + kstep, voffA); PG8_STAGE(PG8_SB(1, 1), cB + hstep + kstep, voffB);
        PG8_WAIT_V(6); PG8_BAR;
    } else {
        PG8_STAGE(PG8_SB(0, 0), cB, voffB); PG8_STAGE(PG8_SA(0, 0), cA, voffA); PG8_STAGE(PG8_SB(0, 1), cB + hstep, voffB); PG8_STAGE(PG8_SA(0, 1), cA + hstep, voffA);
        if (wr == 1) PG8_BAR;
        PG8_WAIT_V(4); PG8_BAR;
        PG8_STAGE(PG8_SB(1, 0), cB + kstep, voffB); PG8_STAGE(PG8_SA(1, 0), cA + kstep, voffA); PG8_STAGE(PG8_SB(1, 1), cB + hstep + kstep, voffB);
        PG8_WAIT_V(6); PG8_BAR;
    }
    for (;;) {
        const bool has_next = S.next(ui + 1, nxt);
        const char* nA = has_next ? (const char*)g.A + (size_t)nxt.pm * tstep : cA; const char* nB = has_next ? (const char*)g.Bt + (size_t)nxt.pn * tstep : cB;
        for (int t = 0; t < nt; t += 2) {
            const bool last = (t == nt - 2);
            const char* a1 = cA + (size_t)(t + 1) * kstep;
            const char* a2 = last ? nA : cA + (size_t)(t + 2) * kstep; const char* b2 = last ? nB : cB + (size_t)(t + 2) * kstep;
            const char* a3 = a2 + kstep; const char* b3 = b2 + kstep;
            if (last && has_next) S.a_ready(nxt);
            if constexpr (SP2) {
            PG8_LDB(B0, 0, 0); PG8_LDB(B1, 0, 1); PG8_SCHED; PG8_LDA(At, 0, 0); PG8_STAGE(PG8_SA(1, 1), a1 + hstep, voffA);
            PG8_WAIT_V(8); PG8_WAIT_L(0); PG8_BAR; PG8_MMA(0, 0, At, B0); PG8_MMA(0, 1, At, B1); PG8_BAR; PG8_SCHED;
            PG8_LDA(At, 0, 1); PG8_STAGE(PG8_SB(0, 0), b2, voffB); PG8_STAGE(PG8_SB(0, 1), b2 + hstep, voffB); PG8_STAGE(PG8_SA(0, 0), a2, voffA);
            PG8_WAIT_V(8); PG8_WAIT_L(0); PG8_BAR; PG8_MMA(1, 0, At, B0); PG8_MMA(1, 1, At, B1); PG8_BAR; PG8_SCHED;
            PG8_LDB(B0, 1, 0); PG8_LDB(B1, 1, 1); PG8_SCHED; PG8_LDA(At, 1, 0); PG8_STAGE(PG8_SA(0, 1), a2 + hstep, voffA);
            PG8_WAIT_V(8); PG8_WAIT_L(0); PG8_BAR; PG8_MMA(0, 0, At, B0); PG8_MMA(0, 1, At, B1); PG8_BAR; PG8_SCHED;
            PG8_LDA(At, 1, 1); PG8_STAGE(PG8_SB(1, 0), b3, voffB); PG8_STAGE(PG8_SB(1, 1), b3 + hstep, voffB); PG8_STAGE(PG8_SA(1, 0), a3, voffA);
            PG8_WAIT_V(8); PG8_WAIT_L(0); PG8_BAR; PG8_MMA(1, 0, At, B0); PG8_MMA(1, 1, At, B1); PG8_BAR; PG8_SCHED;
            } else {
            PG8_LDB(B0, 0, 0); PG8_SCHED; PG8_LDA(At, 0, 0); PG8_STAGE(PG8_SA(1, 1), a1 + hstep, voffA);
            PG8_WAIT_L(8); PG8_BAR; PG8_WAIT_L(0); PG8_MMA(0, 0, At, B0); PG8_BAR; PG8_SCHED;
            PG8_LDB(B1, 0, 1); PG8_STAGE(PG8_SB(0, 0), b2, voffB);
            PG8_BAR; PG8_WAIT_L(0); PG8_MMA(0, 1, At, B1); PG8_BAR;
            PG8_LDA(At, 0, 1); PG8_STAGE(PG8_SA(0, 0), a2, voffA);
            PG8_BAR; PG8_WAIT_L(0); PG8_MMA(1, 0, At, B0); PG8_BAR; PG8_SCHED;
            PG8_STAGE(PG8_SB(0, 1), b2 + hstep, voffB);
            PG8_WAIT_V(6); PG8_BAR; PG8_MMA(1, 1, At, B1); PG8_BAR;
            PG8_LDB(B0, 1, 0); PG8_SCHED; PG8_LDA(At, 1, 0); PG8_STAGE(PG8_SA(0, 1), a2 + hstep, voffA);
            PG8_WAIT_L(8); PG8_BAR; PG8_WAIT_L(0); PG8_MMA(0, 0, At, B0); PG8_BAR; PG8_SCHED;
            PG8_LDB(B1, 1, 1); PG8_STAGE(PG8_SB(1, 0), b3, voffB);
            PG8_BAR; PG8_WAIT_L(0); PG8_MMA(0, 1, At, B1); PG8_BAR;
            PG8_LDA(At, 1, 1); PG8_STAGE(PG8_SA(1, 0), a3, voffA);
            PG8_BAR; PG8_WAIT_L(0); PG8_MMA(1, 0, At, B0); PG8_BAR; PG8_SCHED;
            PG8_STAGE(PG8_SB(1, 1), b3 + hstep, voffB);
            PG8_WAIT_V(6); PG8_BAR; PG8_MMA(1, 1, At, B1); PG8_BAR;
            }
        }
        if constexpr (ALIGN_EPI) { if (wr == 0) PG8_BAR; }
        if constexpr (!Epi::AFTER_DRAIN) { E(acc, cur, wr, wc, fr, fq); S.done(cur); }
        if (!has_next) break;
#pragma unroll
        for (int a = 0; a < 2; ++a)
#pragma unroll
            for (int b = 0; b < 2; ++b)
#pragma unroll
                for (int m = 0; m < 4; ++m)
#pragma unroll
                    for (int n = 0; n < 2; ++n) acc[a][b][m][n] = (f32x4){0.f, 0.f, 0.f, 0.f};
        cur = nxt; cA = nA; cB = nB; ++ui;
        if constexpr (ALIGN_EPI) { if (wr == 1) PG8_BAR; }
    }
    PG8_WAIT_V(0);
    if constexpr (!ALIGN_EPI) { if (wr == 0) PG8_BAR; }
    PG8_BAR;
    if constexpr (Epi::AFTER_DRAIN) { E.fused(acc, cur, wr, wc, fr, fq, lds, wid, lane); S.done(cur); }
#undef PG8_SA
#undef PG8_SB
#undef PG8_STAGE
#undef PG8_LDA
#undef PG8_LDB
#undef PG8_MMA
#undef PG8_WAIT_V
#undef PG8_WAIT_L
#undef PG8_BAR
#undef PG8_SCHED
}
}
#define LAS __attribute__((address_space(3)))
typedef unsigned short bf16;
typedef short bf16x8 __attribute__((ext_vector_type(8)));
typedef short s16x4 __attribute__((ext_vector_type(4)));
typedef float f32x16 __attribute__((ext_vector_type(16)));
typedef float f32x4 __attribute__((ext_vector_type(4)));
typedef unsigned u32x4 __attribute__((ext_vector_type(4)));
typedef unsigned u32x2 __attribute__((ext_vector_type(2)));

constexpr int DM = 1024, BATCH = 16, SEQ = 2048, MTOK = BATCH * SEQ, DEPTH = 2;
constexpr int NIN_SRC = 2308, NQKV = 2304, MIXW = 768, DFF = 2816, NFF2 = 5632;
constexpr float RMS_EPS = 1e-6f, L2E = 1.4426950408889634f, QSCALE = 0.125f * 1.4426950408889634f;
constexpr int C_FQ = 0, C_FK = 256, C_FV = 512, C_DQ = 768, C_DK = 1024, C_DV = 1280, C_CQ = 1536, C_CK = 1792, C_CV = 2048;
constexpr int MX_FOX = 0, MX_DIFF = 256, MX_CHK = 512;
constexpr int NTHREADS = 512, NWAVES = 8;
constexpr size_t MiB = 1u << 20;
constexpr size_t WS_CTL = 0, WS_FF = 1 * MiB, WS_CUM = 1 * MiB + 512 * 1024;
constexpr size_t WS_WIN = 2 * MiB, WS_WOUT = 14 * MiB, WS_WFI = 18 * MiB, WS_WFO = 40 * MiB;
constexpr size_t SZ_WIN = 6 * MiB, SZ_WOUT = 2 * MiB, SZ_WFI = 11 * MiB, SZ_WFO = (size_t)DM * DFF * 2;
constexpr size_t WS_H = 52 * MiB, WS_QKV = 116 * MiB, WS_MIX = 308 * MiB, WS_UV = 116 * MiB, WS_ACT = 260 * MiB, WS_XB = 436 * MiB, WS_END = 500 * MiB;
static_assert(WS_WFO + 2 * SZ_WFO <= WS_H, "ws map");
constexpr int HALF_M = MTOK / 2;
constexpr int LDS_RING = 131072, LDS_WF = 131072, LDS_MISC = 147456, LDS_TAB = 147456 + 256, LDS_BYTES = 155648;

typedef float f32x2_t __attribute__((ext_vector_type(2))); typedef __bf16 bf16x2_t __attribute__((ext_vector_type(2)));
__device__ __forceinline__ unsigned cvtpk(float lo, float hi) { f32x2_t v = {lo, hi}; bf16x2_t b = __builtin_convertvector(v, bf16x2_t); return __builtin_bit_cast(unsigned, b); }
__device__ __forceinline__ float bf2f(unsigned short v) { return __uint_as_float((unsigned)v << 16); }
__device__ __forceinline__ float wave_sum(float v) {
#pragma unroll
    for (int o = 1; o < 64; o <<= 1) v += __shfl_xor(v, o);
    return v;
}
__device__ __forceinline__ float ex2(float v) { return __builtin_amdgcn_exp2f(v); }

struct Args { const float* in[14]; float* out; unsigned char* ws; };
struct WMeta { bf16* dst; int K; float scale; const float* gk; };
constexpr int W_I_IN = 16 * 72, W_I_OUT = 12 * 32, W_I_FI = 16 * 176, W_I_FO = 44 * 32, W_I_L = W_I_IN + W_I_OUT + W_I_FI + W_I_FO;
__device__ __forceinline__ void witem_load(const Args& a, int it, int lane, float (&wv)[32], WMeta& mt) {
    const int l = it / W_I_L; int r = it % W_I_L;
    const float* W; int K, Nsrc, nblk, mode; bf16* WT;
    if (r < W_I_IN) { W = a.in[2] + (size_t)l * DM * NIN_SRC; K = DM; Nsrc = NIN_SRC; nblk = 72; WT = (bf16*)(a.ws + WS_WIN + l * SZ_WIN); mode = 1; }
    else if ((r -= W_I_IN) < W_I_OUT) { W = a.in[7] + (size_t)l * MIXW * DM; K = MIXW; Nsrc = DM; nblk = 32; WT = (bf16*)(a.ws + WS_WOUT + l * SZ_WOUT); mode = 0; }
    else if ((r -= W_I_OUT) < W_I_FI) { W = a.in[9] + (size_t)l * DM * NFF2; K = DM; Nsrc = NFF2; nblk = 176; WT = (bf16*)(a.ws + WS_WFI + l * SZ_WFI); mode = 2; }
    else { r -= W_I_FI; W = a.in[12] + (size_t)l * DFF * DM; K = DFF; Nsrc = DM; nblk = 32; WT = (bf16*)(a.ws + WS_WFO + l * SZ_WFO); mode = 0; }
    const int kb = r / nblk, nb = r % nblk, k0 = 64 * kb, n0 = 32 * nb;
    int sc0 = n0; float scale = 1.f;
    if (mode == 2) sc0 = (n0 >> 8) * 128 + (n0 & 127) + ((n0 & 128) ? DFF : 0);
    if (mode == 1) { sc0 = n0 + (n0 >= 768 ? 4 : 0);
        if ((n0 >= C_FQ && n0 < C_FK) || (n0 >= C_DQ && n0 < C_DK) || (n0 >= C_CQ && n0 < C_CK)) scale = QSCALE; }
    const float* src = W + (size_t)(k0 + (lane >> 5)) * Nsrc + sc0 + (lane & 31);
#pragma unroll
    for (int i = 0; i < 32; ++i) wv[i] = __builtin_nontemporal_load(src + (size_t)(2 * i) * Nsrc);
    mt.dst = WT + (size_t)n0 * K + k0; mt.K = K; mt.scale = scale; mt.gk = (mode == 1) ? a.in[1] + (size_t)l * DM + k0 : (mode == 2) ? a.in[8] + (size_t)l * DM + k0 : nullptr;
}
__device__ __forceinline__ void witem_store(const WMeta& mt, const float (&wv)[32], LAS float* scr, int lane) {
#pragma unroll
    for (int i = 0; i < 32; ++i) { const int kk = 2 * i + (lane >> 5); scr[kk * 33 + (lane & 31)] = wv[i] * (mt.gk ? mt.scale * mt.gk[kk] : mt.scale); }
    asm volatile("s_waitcnt lgkmcnt(0)" ::: "memory");
    const int c = lane & 7;
#pragma unroll
    for (int j = 0; j < 4; ++j) { const int n = (lane >> 3) + 8 * j; const LAS float* s = scr + (8 * c) * 33 + n;
        u32x4 o; o.x = cvtpk(s[0 * 33], s[1 * 33]); o.y = cvtpk(s[2 * 33], s[3 * 33]); o.z = cvtpk(s[4 * 33], s[5 * 33]); o.w = cvtpk(s[6 * 33], s[7 * 33]);
        *(u32x4*)(mt.dst + (size_t)n * mt.K + 8 * c) = o; }
}
__device__ __forceinline__ void phase_weights(const Args& a, LAS unsigned char* lds, int gw, int NGW, int wave, int lane) {
    LAS float* scr = (LAS float*)(lds + wave * 16896);
    for (int it = gw; it < DEPTH * W_I_L; it += 2 * NGW) {
        float wa[32], wb[32]; WMeta ma, mb; const bool two = it + NGW < DEPTH * W_I_L;
        witem_load(a, it, lane, wa, ma);
        if (two) witem_load(a, it + NGW, lane, wb, mb);
        witem_store(ma, wa, scr, lane);
        if (two) witem_store(mb, wb, scr + 64 * 33, lane);
        asm volatile("s_waitcnt lgkmcnt(0)" ::: "memory");
    }
}

template <bool XBF> struct RowLd;
template <> struct RowLd<false> { typedef f32x4 raw; static __device__ __forceinline__ raw ld(const void* x, size_t m, int lane, int j) { return __builtin_nontemporal_load((const f32x4*)((const float*)x + m * DM) + lane + 64 * j); }
    static __device__ __forceinline__ f32x4 cv(raw r) { return r; } };
template <> struct RowLd<true> { typedef u32x2 raw; static __device__ __forceinline__ raw ld(const void* x, size_t m, int lane, int j) { return *((const u32x2*)((const bf16*)x + m * DM) + lane + 64 * j); }
    static __device__ __forceinline__ f32x4 cv(raw r) { f32x4 v; v.x = __uint_as_float(r.x << 16); v.y = __uint_as_float(r.x & 0xffff0000u); v.z = __uint_as_float(r.y << 16); v.w = __uint_as_float(r.y & 0xffff0000u); return v; } };
template <int MODE, bool XBF>
__device__ __forceinline__ void phase_norm(const void* x, const float* g, bf16* H, float* outf, const float* w_in_l, const float* b_fox, float* FF,
                                           LAS unsigned char* lds, int gw, int NGW, int tid, int lane) {
    LAS f32x4* wf = (LAS f32x4*)(lds + LDS_WF);
    if (MODE == 1) {
        __syncthreads();
        for (int k = tid; k < DM; k += NTHREADS) wf[k] = *(const f32x4*)(w_in_l + (size_t)k * NIN_SRC + 768);
        __syncthreads();
    }
    f32x4 gv[4];
#pragma unroll
    for (int j = 0; j < 4; ++j) gv[j] = *((const f32x4*)g + lane + 64 * j);
    f32x4 v[4]; typename RowLd<XBF>::raw vn[4];
    if (gw < MTOK) {
#pragma unroll
        for (int j = 0; j < 4; ++j) vn[j] = RowLd<XBF>::ld(x, (size_t)gw, lane, j); }
    for (int m = gw; m < MTOK; m += NGW) {
        float s = 0.f;
#pragma unroll
        for (int j = 0; j < 4; ++j) v[j] = RowLd<XBF>::cv(vn[j]);
        if (m + NGW < MTOK) {
#pragma unroll
            for (int j = 0; j < 4; ++j) vn[j] = RowLd<XBF>::ld(x, (size_t)(m + NGW), lane, j); }
#pragma unroll
        for (int j = 0; j < 4; ++j) s += (v[j].x * v[j].x + v[j].y * v[j].y) + (v[j].z * v[j].z + v[j].w * v[j].w);
        const float rstd = 1.0f / sqrtf(wave_sum(s) * (1.f / DM) + RMS_EPS);
        if (MODE == 3) { if (lane == 0) outf[m] = rstd; continue; }
        if (MODE == 1) {
            if (!XBF) { u32x2* o = (u32x2*)(H + (size_t)m * DM) + lane;
#pragma unroll
                for (int j = 0; j < 4; ++j) { u32x2 w; w.x = cvtpk(v[j].x, v[j].y); w.y = cvtpk(v[j].z, v[j].w); o[64 * j] = w; } }
            if (lane == 0) outf[m] = rstd;
        }
#pragma unroll
        for (int j = 0; j < 4; ++j) v[j] = v[j] * rstd * gv[j];
        if (MODE == 2) {
            f32x4* o = (f32x4*)(outf + (size_t)m * DM) + lane;
#pragma unroll
            for (int j = 0; j < 4; ++j) __builtin_nontemporal_store(v[j], o + 64 * j);
        } else if (MODE == 0) {
            u32x2* o = (u32x2*)(H + (size_t)m * DM) + lane;
#pragma unroll
            for (int j = 0; j < 4; ++j) { u32x2 w; w.x = cvtpk(v[j].x, v[j].y); w.y = cvtpk(v[j].z, v[j].w); o[64 * j] = w; }
        }
        if (MODE == 1) {
            f32x4 d = {0.f, 0.f, 0.f, 0.f};
#pragma unroll
            for (int j = 0; j < 4; ++j) { const int k = 4 * lane + 256 * j;
                d += wf[k] * v[j].x; d += wf[k + 1] * v[j].y; d += wf[k + 2] * v[j].z; d += wf[k + 3] * v[j].w; }
            d.x = wave_sum(d.x); d.y = wave_sum(d.y); d.z = wave_sum(d.z); d.w = wave_sum(d.w);
            if (lane < 4) { float z = (lane == 0 ? d.x : lane == 1 ? d.y : lane == 2 ? d.z : d.w) + b_fox[lane];
                const float ls = fminf(z, 0.f) - log1pf(expf(-fabsf(z)));
                FF[(size_t)m * 4 + lane] = ls; }
        }
    }
}

__device__ __forceinline__ void cumsum_seq(const float* FF, float* CUM, int bh, int lane) {
    const int b = bh >> 2, h = bh & 3;
    const float* src = FF + ((size_t)b * SEQ + 32 * lane) * 4 + h;
    float v[32]; float s = 0.f;
#pragma unroll
    for (int i = 0; i < 32; ++i) { s += src[4 * i]; v[i] = s; }
    float inc = s;
#pragma unroll
    for (int o = 1; o < 64; o <<= 1) { const float t = __shfl_up(inc, o); if (lane >= o) inc += t; }
    const float excl = inc - s;
    float* dst = CUM + (size_t)bh * SEQ + 32 * lane;
#pragma unroll
    for (int i = 0; i < 32; i += 4) { f32x4 w = {v[i] + excl, v[i + 1] + excl, v[i + 2] + excl, v[i + 3] + excl}; *(f32x4*)(dst + i) = w; }
}

__device__ __forceinline__ void unpack8(const u32x4 a, float (&f)[8]) {
#pragma unroll
    for (int i = 0; i < 4; ++i) { f[2 * i] = __uint_as_float(a[i] << 16); f[2 * i + 1] = __uint_as_float(a[i] & 0xffff0000u); } }
__device__ __forceinline__ void phase_fixup(const bf16* HALO, bf16* ACT, const float* cw, const float* cb, int gt, int NGT) {
    constexpr int NCG = DFF / 8, NG = MTOK / 64;
    for (int it = gt; it < NG * 2 * NCG; it += NGT) {
        const int cg8 = it % NCG, rs = it / NCG, s = rs & 1, j = rs >> 1, c0 = cg8 * 8;
        const bool first = ((j * 64) % SEQ) == 0;
        const bf16* hj = HALO + (size_t)j * 4 * NFF2; const bf16* hp = hj - 4 * NFF2;
        const bf16* pt = hj + (size_t)s * NFF2;
        const bf16* p1 = (s == 0) ? hp + 3 * NFF2 : hj;
        const bf16* p2 = (s == 0) ? hp + 2 * NFF2 : hp + 3 * NFF2;
        const u32x4 z = {0u, 0u, 0u, 0u};
        float ut[8], u1[8], u2[8], gt_[8], g1[8], g2[8];
        unpack8(*(const u32x4*)(pt + c0), ut); unpack8(*(const u32x4*)(pt + DFF + c0), gt_);
        unpack8((s == 0 && first) ? z : *(const u32x4*)(p1 + c0), u1); unpack8((s == 0 && first) ? z : *(const u32x4*)(p1 + DFF + c0), g1);
        unpack8(first ? z : *(const u32x4*)(p2 + c0), u2); unpack8(first ? z : *(const u32x4*)(p2 + DFF + c0), g2);
        float o[8];
#pragma unroll
        for (int i = 0; i < 8; ++i) { const int c = c0 + i;
            const float yu = cb[c] + cw[c] * u2[i] + cw[NFF2 + c] * u1[i] + cw[2 * NFF2 + c] * ut[i];
            const float yg = cb[DFF + c] + cw[DFF + c] * g2[i] + cw[NFF2 + DFF + c] * g1[i] + cw[2 * NFF2 + DFF + c] * gt_[i];
            o[i] = yu * yg / (1.f + __expf(-yg)); }
        u32x4 w; w.x = cvtpk(o[0], o[1]); w.y = cvtpk(o[2], o[3]); w.z = cvtpk(o[4], o[5]); w.w = cvtpk(o[6], o[7]);
        *(u32x4*)(ACT + (size_t)(j * 64 + s) * DFF + c0) = w;
    }
}
__device__ __forceinline__ s16x4 vtr(LAS const char* p) { typedef short v4i16_t __attribute__((ext_vector_type(4))); return __builtin_bit_cast(s16x4, __builtin_amdgcn_ds_read_tr16_b64_v4i16((LAS v4i16_t*)p)); }
constexpr int KROWB = 144, KT_BYTES = 64 * KROWB;

__device__ __forceinline__ void qk_tile(f32x16& p0, f32x16& p1, LAS const char* kt, const bf16x8 (&qr)[4], int r32, int hi) {
    LAS const char* kb = kt + r32 * KROWB + hi * 16;
#pragma unroll
    for (int ks = 0; ks < 4; ++ks) {
        const bf16x8 a0 = *(LAS const bf16x8*)(kb + ks * 32), a1 = *(LAS const bf16x8*)(kb + 32 * KROWB + ks * 32);
        p0 = __builtin_amdgcn_mfma_f32_32x32x16_bf16(a0, qr[ks], p0, 0, 0, 0);
        p1 = __builtin_amdgcn_mfma_f32_32x32x16_bf16(a1, qr[ks], p1, 0, 0, 0);
    }
}
template <int NDB>
__device__ __forceinline__ void softmax_pv(f32x16& p0, f32x16& p1, float& m, float& l, f32x16 (&o)[NDB], LAS const char* vt, int vb) {
    float mx = fmaxf(p0[0], p1[0]);
#pragma unroll
    for (int r = 1; r < 16; ++r) mx = fmaxf(mx, fmaxf(p0[r], p1[r]));
    mx = fmaxf(mx, __shfl_xor(mx, 32));
    if (__builtin_amdgcn_ballot_w64(mx > m) != 0ull) {
        const float mn = fmaxf(m, mx);
        const float alpha = ex2(m - mn);
        m = mn; l *= alpha;
#pragma unroll
        for (int db = 0; db < NDB; ++db)
#pragma unroll
            for (int r = 0; r < 16; ++r) o[db][r] *= alpha;
    }
    const float mn = m;
    float rs = 0.f;
#pragma unroll
    for (int r = 0; r < 16; ++r) { p0[r] = ex2(p0[r] - mn); p1[r] = ex2(p1[r] - mn); rs += p0[r] + p1[r]; }
    l += rs;
    bf16x8 pf[4];
    { u32x4 w;
      w.x = cvtpk(p0[0], p0[1]); w.y = cvtpk(p0[2], p0[3]); w.z = cvtpk(p0[4], p0[5]); w.w = cvtpk(p0[6], p0[7]); pf[0] = __builtin_bit_cast(bf16x8, w);
      w.x = cvtpk(p0[8], p0[9]); w.y = cvtpk(p0[10], p0[11]); w.z = cvtpk(p0[12], p0[13]); w.w = cvtpk(p0[14], p0[15]); pf[1] = __builtin_bit_cast(bf16x8, w);
      w.x = cvtpk(p1[0], p1[1]); w.y = cvtpk(p1[2], p1[3]); w.z = cvtpk(p1[4], p1[5]); w.w = cvtpk(p1[6], p1[7]); pf[2] = __builtin_bit_cast(bf16x8, w);
      w.x = cvtpk(p1[8], p1[9]); w.y = cvtpk(p1[10], p1[11]); w.z = cvtpk(p1[12], p1[13]); w.w = cvtpk(p1[14], p1[15]); pf[3] = __builtin_bit_cast(bf16x8, w); }
#pragma unroll
    for (int kk = 0; kk < 4; ++kk)
#pragma unroll
        for (int db = 0; db < NDB; ++db) {
            const s16x4 lo = vtr(vt + vb + db * 4096 + kk * 1024), hh = vtr(vt + vb + db * 4096 + kk * 1024 + 512);
            const bf16x8 vf = {lo[0], lo[1], lo[2], lo[3], hh[0], hh[1], hh[2], hh[3]};
            o[db] = __builtin_amdgcn_mfma_f32_32x32x16_bf16(vf, pf[kk], o[db], 0, 0, 0);
        }
}

template <int MODE>
__device__ __forceinline__ void attn_unit64(const bf16* qkv, bf16* mix, const float* cum_bh, int b, int h, int blk, LAS unsigned char* lds, int tid, int wave, int lane) {
    constexpr int CUMOFF = KT_BYTES + 8192, BUFSZ = CUMOFF + 256;
    const int r32 = lane & 31, hi = lane >> 5;
    const size_t rowbase = (size_t)b * SEQ;
    const int Q0 = blk * 256, qw0 = Q0 + 32 * wave;
    const int CQ = (MODE == 0 ? C_FQ : C_CQ) + h * 64, CK = (MODE == 0 ? C_FK : C_CK) + h * 64, CV = (MODE == 0 ? C_FV : C_CV) + h * 64;
    const int c0 = 4 * blk, cw = c0 + (wave >> 1);
    int tbeg, tend, kvoff;
    if (MODE == 0) { tbeg = 0; tend = 4 * (blk + 1); kvoff = 0; }
    else { tbeg = (c0 >= 8) ? 0 : 8 - c0; tend = 12; kvoff = (c0 - 8) * 64; }
    const int srow = tid >> 3, sch = tid & 7;
    const bf16* kg = qkv + (rowbase + kvoff + srow) * NQKV + CK + sch * 8;
    const bf16* vg = qkv + (rowbase + kvoff + srow) * NQKV + CV + sch * 8;
    const int kdst = srow * KROWB + sch * 16, vdst = KT_BYTES + (sch >> 2) * 4096 + srow * 64 + (sch & 3) * 16;
    const float cref = (MODE == 0) ? cum_bh[Q0] : 0.f;
#define U64_LOAD(K, V, C, tt) do { if ((tt) >= tbeg) { K = *(const u32x4*)(kg + (size_t)(tt) * 64 * NQKV); V = *(const u32x4*)(vg + (size_t)(tt) * 64 * NQKV); \
        if (MODE == 0 && tid < 16) C = *(const f32x4*)(cum_bh + (tt) * 64 + 4 * tid); } } while (0)
#define U64_STAGE(K, V, C, buf) do { *(LAS u32x4*)((buf) + kdst) = K; *(LAS u32x4*)((buf) + vdst) = V; if (MODE == 0 && tid < 16) *(LAS f32x4*)((buf) + CUMOFF + tid * 16) = (cref - C) * L2E; } while (0)
#define LDS_BAR() asm volatile("s_waitcnt lgkmcnt(0)\n\ts_barrier" ::: "memory")
    u32x4 kA = {0u, 0u, 0u, 0u}, vA = kA, kB = kA, vB = kA; f32x4 cA = {0.f, 0.f, 0.f, 0.f}, cB = cA;
    U64_LOAD(kA, vA, cA, tend - 1); U64_LOAD(kB, vB, cB, tend - 2);
    bf16x8 qr[4];
#pragma unroll
    for (int ks = 0; ks < 4; ++ks) qr[ks] = *(const bf16x8*)(qkv + (rowbase + qw0 + r32) * NQKV + CQ + ks * 16 + hi * 8);
    float m = -1e30f, l = 0.f;
    f32x16 o[2];
#pragma unroll
    for (int db = 0; db < 2; ++db)
#pragma unroll
        for (int r = 0; r < 16; ++r) o[db][r] = 0.f;
    const int vb = (4 * hi + ((lane & 15) >> 2)) * 64 + ((lane >> 4) & 1) * 32 + (lane & 3) * 8;
    LAS const float* tab = (LAS const float*)(lds + LDS_TAB) + h * 192;
    auto compute = [&](const int t, LAS unsigned char* const buf) __attribute__((always_inline)) {
        const int kv0 = kvoff + 64 * t;
        bool doit;
        if (MODE == 0) doit = kv0 <= qw0 + 31; else { const int kc = c0 - 8 + t; doit = (kc >= cw - 8) && (kc <= cw); }
        if (doit) {
            f32x16 p0 = (f32x16){0.f, 0.f, 0.f, 0.f, 0.f, 0.f, 0.f, 0.f, 0.f, 0.f, 0.f, 0.f, 0.f, 0.f, 0.f, 0.f}, p1 = p0;
            if (MODE == 2 && cw - (c0 - 8 + t) >= 3) { const float bv = tab[191];
#pragma unroll
                for (int r = 0; r < 16; ++r) { p0[r] = bv; p1[r] = bv; } }
            if (MODE == 0) {
#pragma unroll
                for (int g = 0; g < 4; ++g) { const f32x4 ca = *(LAS const f32x4*)(buf + CUMOFF + (8 * g + 4 * hi) * 4), cb = *(LAS const f32x4*)(buf + CUMOFF + (32 + 8 * g + 4 * hi) * 4);
#pragma unroll
                    for (int i = 0; i < 4; ++i) { p0[4 * g + i] = ca[i]; p1[4 * g + i] = cb[i]; } }
            }
            qk_tile(p0, p1, (LAS const char*)buf, qr, r32, hi);
            if (MODE == 0) {
                if (kv0 + 63 > qw0) {
                    const int qa = qw0 + r32 - kv0 - 4 * hi;
#pragma unroll
                    for (int r = 0; r < 16; ++r) { const int kl = (r & 3) + 8 * (r >> 2); if (kl > qa) p0[r] = -INFINITY; if (kl + 32 > qa) p1[r] = -INFINITY; }
                }
            } else {
                const int dc = cw - (c0 - 8 + t);
                if (dc < 3) {
                    const int rel0 = qw0 + r32 - kv0 - 4 * hi + 63;
#pragma unroll
                    for (int r = 0; r < 16; ++r) { const int kl = (r & 3) + 8 * (r >> 2);
                        int i0 = rel0 - kl, i1 = rel0 - kl - 32; i0 = i0 < 0 ? 0 : (i0 > 191 ? 191 : i0); i1 = i1 < 0 ? 0 : (i1 > 191 ? 191 : i1);
                        p0[r] += tab[i0]; p1[r] += tab[i1]; }
                }
            }
            softmax_pv<2>(p0, p1, m, l, o, (LAS const char*)buf + KT_BYTES, vb);
        }
    };
    int pi = 0;
    for (int t = tend - 1; t >= tbeg; t -= 2, pi ^= 1) {
        LAS unsigned char* const sb = lds + (pi ? 2 * BUFSZ : 0); const bool two = (t - 1 >= tbeg);
        U64_STAGE(kA, vA, cA, sb); if (two) U64_STAGE(kB, vB, cB, sb + BUFSZ);
        LDS_BAR();
        U64_LOAD(kA, vA, cA, t - 2); U64_LOAD(kB, vB, cB, t - 3);
        compute(t, sb); if (two) compute(t - 1, sb + BUFSZ);
    }
#undef U64_LOAD
#undef U64_STAGE
    l += __shfl_xor(l, 32);
    const float inv = 1.0f / l;
    bf16* orow = mix + (rowbase + qw0 + r32) * MIXW + (MODE == 0 ? MX_FOX : MX_CHK) + h * 64 + 4 * hi;
#pragma unroll
    for (int db = 0; db < 2; ++db)
#pragma unroll
        for (int g = 0; g < 4; ++g) { u32x2 w; w.x = cvtpk(o[db][4 * g] * inv, o[db][4 * g + 1] * inv); w.y = cvtpk(o[db][4 * g + 2] * inv, o[db][4 * g + 3] * inv);
            *(u32x2*)(orow + 32 * db + 8 * g) = w; }
    __syncthreads();
}

template <int C>
__device__ __forceinline__ void diff_pass(const bf16* qkv, bf16* mix, float* park, int b, int h, int blk, float lam, float sl2, const float* gdiff, float outscale,
                                          LAS unsigned char* lds, int tid, int wave, int lane) {
    constexpr int VOFF = KT_BYTES, BUFSZ = VOFF + 16384;
    const int r32 = lane & 31, hi = lane >> 5;
    const size_t rowbase = (size_t)b * SEQ;
    const int Q0 = blk * 256, qw0 = Q0 + 32 * wave, cwv = qw0 >> 6, tend = 4 * (blk + 1);
    const int srow = tid >> 3, sch = tid & 7;
    const int vrow0 = tid >> 4, vch = tid & 15;
    const bf16* vg = qkv + (rowbase + vrow0) * NQKV + C_DV + h * 128 + vch * 8;
    const int kdst = srow * KROWB + sch * 16, vdst = VOFF + (vch >> 2) * 4096 + vrow0 * 64 + (vch & 3) * 16;
    const int vb = (4 * hi + ((lane & 15) >> 2)) * 64 + ((lane >> 4) & 1) * 32 + (lane & 3) * 8;
    const bf16* kg = qkv + (rowbase + srow) * NQKV + C_DK + h * 128 + C * 64 + sch * 8;
#define DF_LOAD(K, V0, V1, tt) do { if ((tt) >= 0) { const size_t go_ = (size_t)(tt) * 64 * NQKV; K = *(const u32x4*)(kg + go_); V0 = *(const u32x4*)(vg + go_); V1 = *(const u32x4*)(vg + go_ + (size_t)32 * NQKV); } } while (0)
#define DF_STAGE(K, V0, V1, buf) do { *(LAS u32x4*)((buf) + kdst) = K; *(LAS u32x4*)((buf) + vdst) = V0; *(LAS u32x4*)((buf) + vdst + 32 * 64) = V1; } while (0)
    u32x4 kA = {0u, 0u, 0u, 0u}, v0A = kA, v1A = kA, kB = kA, v0B = kA, v1B = kA;
    DF_LOAD(kA, v0A, v1A, tend - 1); DF_LOAD(kB, v0B, v1B, tend - 2);
    bf16x8 qr[4];
#pragma unroll
    for (int ks = 0; ks < 4; ++ks) qr[ks] = *(const bf16x8*)(qkv + (rowbase + qw0 + r32) * NQKV + C_DQ + h * 128 + C * 64 + ks * 16 + hi * 8);
    float m = -1e30f, l = 0.f;
    f32x16 o[4];
#pragma unroll
    for (int db = 0; db < 4; ++db)
#pragma unroll
        for (int r = 0; r < 16; ++r) o[db][r] = 0.f;
    f32x16 ab;
#pragma unroll
    for (int r = 0; r < 16; ++r) ab[r] = sl2 * (float)((r & 3) + 8 * (r >> 2) + 4 * hi);
    auto compute = [&](const int t, LAS unsigned char* const buf) __attribute__((always_inline)) {
        if (t <= cwv) {
            const int kv0 = 64 * t;
            f32x16 p0, p1;
            if (t < cwv) { const float d0 = sl2 * (float)(64 * (t - cwv)), d1 = d0 + 32.f * sl2;
#pragma unroll
                for (int r = 0; r < 16; ++r) { p0[r] = ab[r] + d0; p1[r] = ab[r] + d1; }
                qk_tile(p0, p1, (LAS const char*)buf, qr, r32, hi);
            } else { p0 = (f32x16){0.f, 0.f, 0.f, 0.f, 0.f, 0.f, 0.f, 0.f, 0.f, 0.f, 0.f, 0.f, 0.f, 0.f, 0.f, 0.f}; p1 = p0;
                qk_tile(p0, p1, (LAS const char*)buf, qr, r32, hi);
                const float ql = (float)(qw0 + r32 - kv0), base = ql - (float)(4 * hi);
#pragma unroll
                for (int r = 0; r < 16; ++r) { const float kl = (float)((r & 3) + 8 * (r >> 2)); p0[r] += sl2 * (ql - fabsf(base - kl)); p1[r] += sl2 * (ql - fabsf(base - kl - 32.f)); }
            }
            softmax_pv<4>(p0, p1, m, l, o, (LAS const char*)buf + VOFF, vb);
        }
    };
    int pi = 0;
    for (int t = tend - 1; t >= 0; t -= 2, pi ^= 1) {
        LAS unsigned char* const sb = lds + (pi ? 2 * BUFSZ : 0);
        DF_STAGE(kA, v0A, v1A, sb); DF_STAGE(kB, v0B, v1B, sb + BUFSZ);
        LDS_BAR();
        DF_LOAD(kA, v0A, v1A, t - 2); DF_LOAD(kB, v0B, v1B, t - 3);
        compute(t, sb); compute(t - 1, sb + BUFSZ);
    }
#undef DF_LOAD
#undef DF_STAGE
    l += __shfl_xor(l, 32);
    const float inv = 1.0f / l;
    if (C == 0) {
#pragma unroll
        for (int db = 0; db < 4; ++db)
#pragma unroll
            for (int r = 0; r < 16; ++r) park[(db * 16 + r) * NTHREADS] = o[db][r] * inv;
    } else {
        const float li = lam * inv;
        float ss = 0.f;
#pragma unroll
        for (int db = 0; db < 4; ++db) {
#pragma unroll
            for (int r = 0; r < 16; ++r) { const float v = park[(db * 16 + r) * NTHREADS] - o[db][r] * li; o[db][r] = v; ss += v * v; }
            asm volatile("" ::: "memory"); }
        ss += __shfl_xor(ss, 32);
        const float rn = outscale / sqrtf(ss * (1.f / 128.f) + RMS_EPS);
        bf16* orow = mix + (rowbase + qw0 + r32) * MIXW + MX_DIFF + h * 128 + 4 * hi;
#pragma unroll
        for (int db = 0; db < 4; ++db)
#pragma unroll
            for (int g = 0; g < 4; ++g) { const f32x4 gg = *(const f32x4*)(gdiff + 32 * db + 8 * g + 4 * hi);
                u32x2 w; w.x = cvtpk(o[db][4 * g] * rn * gg.x, o[db][4 * g + 1] * rn * gg.y); w.y = cvtpk(o[db][4 * g + 2] * rn * gg.z, o[db][4 * g + 3] * rn * gg.w);
                *(u32x2*)(orow + 32 * db + 8 * g) = w; }
    }
    __syncthreads();
}
__device__ __forceinline__ void attn_unit_diff2(const bf16* qkv, bf16* mix, int b, int h, int blk, float lam, float sl2, const float* gdiff, float outscale,
                                                LAS unsigned char* lds, int tid, int wave, int lane) {
    float* park = (float*)((unsigned char*)qkv - WS_QKV + WS_H) + (size_t)blockIdx.x * 64 * NTHREADS + tid;
    diff_pass<0>(qkv, mix, park, b, h, blk, lam, sl2, gdiff, outscale, lds, tid, wave, lane);
    int tid2 = threadIdx.x; asm volatile("" : "+v"(tid2) :: "memory"); __builtin_amdgcn_sched_barrier(0);
    float* park2 = (float*)((unsigned char*)qkv - WS_QKV + WS_H) + (size_t)blockIdx.x * 64 * NTHREADS + tid2;
    diff_pass<1>(qkv, mix, park2, b, h, blk, lam, sl2, gdiff, outscale, lds, tid2, __builtin_amdgcn_readfirstlane(tid2 >> 6), tid2 & 63);
}
#define SF(q) (0 << 5 | (q) << 1 | 0), (0 << 5 | (q) << 1 | 1)
#define SD(q) (1 << 5 | (q) << 1 | 0)
#define SC(q) (2 << 5 | (q) << 1 | 0), (2 << 5 | (q) << 1 | 1)
__device__ __forceinline__ int seg_code(int s) {
    constexpr unsigned char T[40] = { SD(7), SD(6), SD(5), SD(4), SD(3), SF(7), SD(2), SF(6), SF(5), SD(1), SF(4), SF(3), SD(0), SF(2),
        SC(7), SC(6), SC(5), SC(4), SC(3), SC(2), SC(1), SC(0), SF(1), SF(0) };
    return T[s];
}
__device__ __forceinline__ void phase_attn(const Args& a, int layer, unsigned* ctr, LAS unsigned char* lds, int tid0, int wave0, int lane0) {
    const bf16* qkv = (const bf16*)(a.ws + WS_QKV); bf16* mix = (bf16*)(a.ws + WS_MIX); const float* CUM = (const float*)(a.ws + WS_CUM);
    for (int i = tid0; i < 4 * 192; i += NTHREADS) ((LAS float*)(lds + LDS_TAB))[i] = a.in[6][(size_t)layer * 768 + i] * L2E;
    const float* dl = a.in[4] + (size_t)layer * 256;
    const float s01 = wave_sum(dl[lane0] * dl[64 + lane0]), s23 = wave_sum(dl[128 + lane0] * dl[192 + lane0]);
    const float lambda_init = 0.8f - 0.6f * expf(-0.3f * (float)layer);
    const float lam = expf(s01) - expf(s23) + lambda_init;
    const float* gdiff = a.in[5] + (size_t)layer * 128;
    LAS volatile unsigned* misc = (LAS volatile unsigned*)(lds + LDS_MISC);
    __syncthreads();
    for (;;) {
        if (threadIdx.x == 0) misc[0] = atomicAdd(ctr, 1u);
        __syncthreads();
        const unsigned idx = misc[0];
        int tidf = threadIdx.x; asm volatile("" : "+v"(tidf) :: "memory"); __builtin_amdgcn_sched_barrier(0);
        const int tid = tidf, lane = tidf & 63, wave = __builtin_amdgcn_readfirstlane(tidf >> 6);
        if (idx >= 1280u) break;
        const int code = seg_code((int)(idx >> 5)), kind = code >> 5, blk = (code >> 1) & 15, sub = (int)(idx & 31);
        if (kind == 1) { const int b = sub >> 1, h = sub & 1;
            attn_unit_diff2(qkv, mix, b, h, blk, lam, exp2f(-4.0f * (float)(h + 1)) * L2E, gdiff, 1.0f - lambda_init, lds, tid, wave, lane); }
        else { const int bh = (code & 1) * 32 + sub, b = bh >> 2, h = bh & 3;
            if (kind == 0) attn_unit64<0>(qkv, mix, CUM + (size_t)bh * SEQ, b, h, blk, lds, tid, wave, lane);
            else attn_unit64<2>(qkv, mix, nullptr, b, h, blk, lds, tid, wave, lane); }
    }
}
#define XB_TMO      128
#define XB_XCNT(j)  (256  + 64 * (j))
#define XB_XSUB(j)  (1280 + 64 * (j))
#define XB_XGEN(j)  (2304 + 64 * (j))
#define XB_TOP      3328
#define XB_TOPGEN   3392
#define XCD_BAR_WORDS 3456
#define XB_SPIN_CAP (1u << 18)

__device__ __forceinline__ unsigned xb_ld(unsigned* p)              { return __hip_atomic_load(p, __ATOMIC_RELAXED, __HIP_MEMORY_SCOPE_AGENT); }
__device__ __forceinline__ unsigned xb_add(unsigned* p, unsigned v) { return __hip_atomic_fetch_add(p, v, __ATOMIC_RELAXED, __HIP_MEMORY_SCOPE_AGENT); }
__device__ __forceinline__ unsigned xb_xcc_id() { return (unsigned)__builtin_amdgcn_s_getreg((3 << 11) | 20) & 0xFu; }
#define XB_SPIN(cond, bar) do { unsigned _sp = 0; while (cond) { __builtin_amdgcn_s_sleep(1); \
    if ((++_sp & 255u) == 0u) { if (xb_ld(&(bar)[XB_TMO])) break; if (_sp > XB_SPIN_CAP) { atomicAdd(&(bar)[XB_TMO], 1u); break; } } } } while (0)

struct XcdBarrier {
    unsigned* bar; unsigned x;
    volatile LAS unsigned* st;
};

__device__ __forceinline__ XcdBarrier xcd_barrier_post(unsigned* bar, volatile LAS unsigned* st) {
    XcdBarrier b; b.bar = bar; b.x = xb_xcc_id(); b.st = st;
    if (threadIdx.x == 0) (void)xb_add(&bar[XB_XCNT(b.x)], 1u);
    return b;
}
__device__ __forceinline__ void xcd_barrier_complete(unsigned* bar, unsigned x, unsigned& nloc, unsigned& nx) {
    const unsigned G = gridDim.x * gridDim.y * gridDim.z;
    unsigned sum, cnt, mine, sp = 0u;
    for (;;) {
        sum = 0u; cnt = 0u; mine = 0u;
#pragma unroll
        for (unsigned j = 0; j < 16; ++j) { const unsigned c = xb_ld(&bar[XB_XCNT(j)]); sum += c; cnt += (c > 0u) ? 1u : 0u; mine = (j == x) ? c : mine; }
        if (sum == G) break;
        __builtin_amdgcn_s_sleep(1);
        if ((++sp & 255u) == 0u) { if (xb_ld(&bar[XB_TMO])) break; if (sp > XB_SPIN_CAP) { atomicAdd(&bar[XB_TMO], 1u); break; } }
    }
    nloc = mine > 0u ? mine : 1u; nx = cnt > 0u ? cnt : 1u;
}

__device__ __forceinline__ void xcd_barrier(const XcdBarrier& b) {
    asm volatile("s_waitcnt vmcnt(0)" ::: "memory");
    __syncthreads();
    if (threadIdx.x == 0) {
        unsigned* bar = b.bar;
        __builtin_amdgcn_s_waitcnt(0);
        unsigned nloc = b.st[0], nx = b.st[1];
        if (nloc == 0u) { xcd_barrier_complete(bar, b.x, nloc, nx); b.st[0] = nloc; b.st[1] = nx; }
        const unsigned old = xb_add(&bar[XB_XSUB(b.x)], 1u);
        const unsigned gen = old / nloc;
        if (old + 1u == (gen + 1u) * nloc) {
            __builtin_amdgcn_fence(__ATOMIC_RELEASE, "agent");
            asm volatile("s_waitcnt vmcnt(0)" ::: "memory");
            const unsigned og = xb_add(&bar[XB_TOP], 1u);
            const unsigned tg = og / nx;
            if (og + 1u == (tg + 1u) * nx) xb_add(&bar[XB_TOPGEN], 1u);
            else XB_SPIN(xb_ld(&bar[XB_TOPGEN]) == tg, bar);
            __builtin_amdgcn_fence(__ATOMIC_ACQUIRE, "agent");
            xb_add(&bar[XB_XGEN(b.x)], 1u);
            asm volatile("s_waitcnt vmcnt(0)" ::: "memory");
        } else {
            XB_SPIN(xb_ld(&bar[XB_XGEN(b.x)]) == gen, bar);
            __builtin_amdgcn_fence(__ATOMIC_ACQUIRE, "agent");
            asm volatile("s_waitcnt vmcnt(0)" ::: "memory");
        }
    }
    __syncthreads();
}

#define GEMM_RUN(EPI, Aptr, Bptr, Mv, Nv, Kv, Eobj) GEMM_RUN2(EPI, Aptr, Bptr, Mv, Nv, Kv, Eobj, true, true)
#define GEMM_RUN2(EPI, Aptr, Bptr, Mv, Nv, Kv, Eobj, ALIGNV, SP2V) do { pg8::Gemm g_{(const pg8::bf16_t*)(Aptr), (const pg8::bf16_t*)(Bptr), (Mv), (Nv), (Kv)}; pg8::StaticOrder S_; S_.init((Mv), (Nv), (int)gridDim.x, (int)blockIdx.x); \
    pg8::gemm_phase<EPI, pg8::StaticOrder, ALIGNV, SP2V>(lds, g_, S_, Eobj); } while (0)

__global__ void __launch_bounds__(NTHREADS, 2) mk_fwd(Args a) {
    __shared__ __attribute__((aligned(16))) unsigned char lds_raw[LDS_BYTES];
    LAS unsigned char* lds = (LAS unsigned char*)lds_raw;
    cg::grid_group grid = cg::this_grid();
#define FRESH int tid = threadIdx.x; asm volatile("" : "+v"(tid)); const int lane = tid & 63, wave = __builtin_amdgcn_readfirstlane(tid >> 6); const int G = gridDim.x, gw = blockIdx.x * NWAVES + wave, NGW = G * NWAVES; (void)lane; (void)gw; (void)NGW; (void)G
    unsigned* ctl = (unsigned*)(a.ws + WS_CTL);
    unsigned* barw = ctl + 4096;
    volatile LAS unsigned* bst = (volatile LAS unsigned*)(lds + LDS_MISC + 64);
    if (threadIdx.x < 2) bst[threadIdx.x] = 0u;
    __syncthreads();
    if (a.out == nullptr) grid.sync();
    const XcdBarrier xbar = xcd_barrier_post(barw, bst);
#define GSYNC() xcd_barrier(xbar)
    bf16* H = (bf16*)(a.ws + WS_H); bf16* QKV = (bf16*)(a.ws + WS_QKV); bf16* MIX = (bf16*)(a.ws + WS_MIX); bf16* UV = (bf16*)(a.ws + WS_UV); bf16* ACT = (bf16*)(a.ws + WS_ACT); bf16* XB = (bf16*)(a.ws + WS_XB); float* RSTD = (float*)(a.ws + WS_CTL + 65536);
    float* FF = (float*)(a.ws + WS_FF); float* CUM = (float*)(a.ws + WS_CUM);
    { FRESH; phase_weights(a, lds, gw, NGW, wave, lane); }
    for (int l = 0; l < DEPTH; ++l) {
        if (l == 0) { FRESH; phase_norm<1, false>(a.in[0], a.in[1] + (size_t)l * DM, XB, RSTD, a.in[2] + (size_t)l * DM * NIN_SRC, a.in[3] + l * 4, FF, lds, gw, NGW, tid, lane); }
        else { FRESH; phase_norm<1, true>(XB, a.in[1] + (size_t)l * DM, nullptr, RSTD, a.in[2] + (size_t)l * DM * NIN_SRC, a.in[3] + l * 4, FF, lds, gw, NGW, tid, lane); }
        GSYNC();
        { FRESH; if (blockIdx.x < 64 && wave == 0) cumsum_seq(FF, CUM, blockIdx.x, lane); }
        { pg8::EpiBf16S E{(pg8::bf16_t*)QKV, NQKV, RSTD}; GEMM_RUN(pg8::EpiBf16S, XB, a.ws + WS_WIN + l * SZ_WIN, MTOK, NQKV, DM, E); }
        GSYNC();
        { FRESH; phase_attn(a, l, ctl + 64 * l, lds, tid, wave, lane); }
        GSYNC();
        { pg8::EpiResBS<false> E{XB, (pg8::bf16_t*)XB, DM, (float*)H}; GEMM_RUN(pg8::EpiResBS<false>, MIX, a.ws + WS_WOUT + l * SZ_WOUT, MTOK, DM, MIXW, E); }
        GSYNC();
        { FRESH; if (blockIdx.x < MTOK / NTHREADS) { const int row = blockIdx.x * NTHREADS + tid; const f32x4* p = (const f32x4*)((const float*)H + (size_t)row * 16);
            const f32x4 s4 = (p[0] + p[1]) + (p[2] + p[3]); RSTD[row] = 1.0f / sqrtf(((s4[0] + s4[1]) + (s4[2] + s4[3])) * (1.f / DM) + RMS_EPS); } }
        GSYNC();
        { pg8::EpiConv E{(pg8::bf16_t*)ACT, (pg8::bf16_t*)UV, a.in[10] + (size_t)l * 3 * NFF2, a.in[11] + (size_t)l * NFF2, RSTD}; GEMM_RUN(pg8::EpiConv, XB, a.ws + WS_WFI + l * SZ_WFI, MTOK, NFF2, DM, E); }
        GSYNC();
        { FRESH; phase_fixup(UV, ACT, a.in[10] + (size_t)l * 3 * NFF2, a.in[11] + (size_t)l * NFF2, blockIdx.x * NTHREADS + tid, G * NTHREADS); }
        GSYNC();
        { pg8::EpiResB<false> E{XB, (pg8::bf16_t*)XB, DM}; GEMM_RUN(pg8::EpiResB<false>, ACT, a.ws + WS_WFO + l * SZ_WFO, MTOK, DM, DFF, E); }
        GSYNC();
    }
    { FRESH; phase_norm<2, true>(XB, a.in[13], nullptr, a.out, nullptr, nullptr, nullptr, lds, gw, NGW, tid, lane); }
}

extern "C" void kernel_launch(void* const* d_in, const int* in_sizes, int n_in, void* d_out, int out_size, void* d_ws, size_t ws_size, hipStream_t stream) {
    static int grid_blocks = 0;
    if (grid_blocks == 0) {
        if (n_in != 14 || out_size != MTOK * DM || ws_size < WS_END || in_sizes[2] != DEPTH * DM * NIN_SRC || in_sizes[7] != DEPTH * MIXW * DM || in_sizes[9] != DEPTH * DM * NFF2 || in_sizes[12] != DEPTH * DFF * DM || in_sizes[6] != DEPTH * 4 * 192 || in_sizes[5] != DEPTH * 128) { fprintf(stderr, "kernel_launch: unexpected sizes n_in %d out %d ws %zu\n", n_in, out_size, ws_size); grid_blocks = -1; return; }
        int dev = 0, cus = 0, per_cu = 0;
        (void)hipGetDevice(&dev);
        (void)hipDeviceGetAttribute(&cus, hipDeviceAttributeMultiprocessorCount, dev);
        (void)hipOccupancyMaxActiveBlocksPerMultiprocessor(&per_cu, (const void*)mk_fwd, NTHREADS, 0);
        if (per_cu < 1) { fprintf(stderr, "kernel_launch: occupancy query says %d blocks/CU\n", per_cu); per_cu = 1; }
        (void)hipGetLastError();
        grid_blocks = cus * 1;
        fprintf(stderr, "kernel_launch: cus %d per_cu %d grid %d\n", cus, per_cu, grid_blocks);
    }
    if (grid_blocks < 0) return;
    if (hipMemsetAsync((char*)d_ws + WS_CTL, 0, 65536, stream) != hipSuccess) { fprintf(stderr, "kernel_launch: memset of control words failed\n"); return; }
    Args a{};
    for (int i = 0; i < 14; ++i) a.in[i] = (const float*)d_in[i];
    a.out = (float*)d_out; a.ws = (unsigned char*)d_ws;
    void* args[] = {&a};
    hipError_t e = hipLaunchCooperativeKernel((const void*)mk_fwd, dim3(grid_blocks), dim3(NTHREADS), args, 0, stream);
    if (e != hipSuccess) fprintf(stderr, "cooperative launch failed: %s (grid %d)\n", hipGetErrorString(e), grid_blocks);
}
```

```cpp
#include <hip/hip_runtime.h>
#include <cstdio>
#include <cstdint>
#include <hip/hip_cooperative_groups.h>
namespace cg = cooperative_groups;
namespace pg8 {
#define PG8_LAS __attribute__((address_space(3)))
typedef unsigned short bf16_t;
typedef short bf16x8 __attribute__((ext_vector_type(8)));
typedef float f32x4 __attribute__((ext_vector_type(4)));
typedef unsigned u32x4 __attribute__((ext_vector_type(4)));
constexpr int BM = 256, BK = 64, HALF = 128, HTB = HALF * BK * 2  , STAGE_BYTES = 8 * HTB, NXCD = 8, WGM = 8;

__host__ __device__ __forceinline__ int lds_byte(int r, int c) { const int st = (r >> 4) * 2 + (c >> 5), rr = r & 15, cc = c & 31, ob = rr * 64 + cc * 2; return st * 1024 + (ob ^ (((ob >> 9) & 1) << 5)); }
__host__ __device__ __forceinline__ void stage_rc(int b, int& R, int& C) { const int st = b / 1024, sb = b % 1024, swz = sb ^ (((sb >> 9) & 1) << 5); R = (st >> 1) * 16 + swz / 64; C = (st & 1) * 32 + (swz % 64) / 2; }
__host__ __device__ __forceinline__ int perm32(int rho) { const int n = rho >> 4, i = rho & 15; return 8 * (i >> 2) + 4 * n + (i & 3); }

struct Unit { int pm, pn; };
struct Gemm { const bf16_t* A; const bf16_t* Bt; int M, N, K; };

struct StaticOrder {
    int nM, nN, nwg, G, c;
    __host__ __device__ void init(int M, int N, int G_, int c_) { nM = M / BM; nN = N / BM; nwg = nM * nN; G = G_; c = c_; }
    __host__ __device__ bool next(int i, Unit& u) const {
        const long L = (long)i * G + c; if (L >= nwg) return false;
        int wgid = (int)L; { const int q = nwg / NXCD, r = nwg % NXCD, xcd = wgid % NXCD, off = wgid / NXCD; wgid = (xcd < r ? xcd * (q + 1) : r * (q + 1) + (xcd - r) * q) + off; }
        const int nig = WGM * nN, gid = wgid / nig, fm = gid * WGM, gsz = (nM - fm) < WGM ? (nM - fm) : WGM;
        u.pm = fm + ((wgid % nig) % gsz); u.pn = (wgid % nig) / gsz; return true;
    }
    __device__ __forceinline__ void a_ready(const Unit&) const {}
    __device__ __forceinline__ void done(const Unit&) const {}
};

typedef float f32x2c __attribute__((ext_vector_type(2))); typedef __bf16 bf16x2c __attribute__((ext_vector_type(2)));
__device__ __forceinline__ unsigned cvt_pk_bf16(float lo, float hi) { f32x2c v = {lo, hi}; bf16x2c b = __builtin_convertvector(v, bf16x2c); return __builtin_bit_cast(unsigned, b); }
typedef float f32x2 __attribute__((ext_vector_type(2)));
struct EpiBf16 {
    static constexpr bool PERM = true, AFTER_DRAIN = false, APERM = false;
    bf16_t* O; int ldc;
    __device__ __forceinline__ void operator()(const f32x4 (&acc)[2][2][4][2], const Unit& u, int wr, int wc, int fr, int fq) const {
        const int row0 = u.pm * BM + wr * 64 + fr; const int col0 = u.pn * BM + wc * 32 + 8 * fq;
#pragma unroll
        for (int ai = 0; ai < 2; ++ai)
#pragma unroll
            for (int m = 0; m < 4; ++m) { bf16_t* rowp = O + (size_t)(row0 + ai * HALF + m * 16) * ldc + col0;
#pragma unroll
                for (int bj = 0; bj < 2; ++bj) { const f32x4 v0 = acc[ai][bj][m][0], v1 = acc[ai][bj][m][1];
                    u32x4 w; w.x = cvt_pk_bf16(v0[0], v0[1]); w.y = cvt_pk_bf16(v0[2], v0[3]); w.z = cvt_pk_bf16(v1[0], v1[1]); w.w = cvt_pk_bf16(v1[2], v1[3]);
                    *(u32x4*)(rowp + bj * HALF) = w; } }
    }
};
struct EpiRes {
    static constexpr bool PERM = false, AFTER_DRAIN = false, APERM = false;
    const float* base; float* out; int ldc; float scale;
    __device__ __forceinline__ void operator()(const f32x4 (&acc)[2][2][4][2], const Unit& u, int wr, int wc, int fr, int fq) const {
        const int col0 = u.pn * BM + wc * 32 + 4 * fq;
#pragma unroll
        for (int ai = 0; ai < 2; ++ai)
#pragma unroll
            for (int m = 0; m < 4; ++m) { const size_t off = (size_t)(u.pm * BM + ai * HALF + wr * 64 + m * 16 + fr) * ldc + col0;
#pragma unroll
                for (int bj = 0; bj < 2; ++bj)
#pragma unroll
                    for (int n = 0; n < 2; ++n) { const f32x4 bs = *(const f32x4*)(base + off + bj * HALF + n * 16); *(f32x4*)(out + off + bj * HALF + n * 16) = bs + acc[ai][bj][m][n] * scale; } }
    }
};

__device__ __forceinline__ f32x4 dpp_shr1(f32x4 v) { f32x4 r;
#pragma unroll
    for (int i = 0; i < 4; ++i) r[i] = __shfl_up(v[i], 1, 16);
    return r; }
__device__ __forceinline__ f32x4 silu_mul(f32x4 yu, f32x4 yg) { f32x4 o;
#pragma unroll
    for (int i = 0; i < 4; ++i) o[i] = yu[i] * yg[i] * __builtin_amdgcn_rcpf(1.0f + __builtin_amdgcn_exp2f(-1.4426950408889634f * yg[i]));
    return o; }
struct EpiConv {
    static constexpr bool PERM = false, AFTER_DRAIN = false, APERM = true;
    bf16_t* act; bf16_t* halo; const float* cw; const float* cb; const float* rstd;
    typedef unsigned u32x2e __attribute__((ext_vector_type(2)));
    __device__ __forceinline__ void conv4(f32x4 (&y)[4], const f32x4 (&a4)[4][2], int n, const f32x4 rs, const f32x4 w0, const f32x4 w1, const f32x4 w2, const f32x4 b, int col, int fr, bf16_t* hp) const {
        constexpr int N2 = 5632;
        const f32x4 X0 = a4[0][n] * rs[0], X1 = a4[1][n] * rs[1], X2 = a4[2][n] * rs[2], X3 = a4[3][n] * rs[3];
        const f32x4 Xm1 = dpp_shr1(X3), Xm2 = dpp_shr1(X2);
        y[0] = b + w0 * Xm2 + w1 * Xm1 + w2 * X0;
        y[1] = b + w0 * Xm1 + w1 * X0 + w2 * X1;
        y[2] = b + w0 * X0 + w1 * X1 + w2 * X2;
        y[3] = b + w0 * X1 + w1 * X2 + w2 * X3;
        if (fr == 0 || fr == 15) { const f32x4 xa = fr == 0 ? X0 : X2, xb = fr == 0 ? X1 : X3;
            u32x2e w; w.x = cvt_pk_bf16(xa[0], xa[1]); w.y = cvt_pk_bf16(xa[2], xa[3]); *(u32x2e*)(hp + col) = w;
            w.x = cvt_pk_bf16(xb[0], xb[1]); w.y = cvt_pk_bf16(xb[2], xb[3]); *(u32x2e*)(hp + N2 + col) = w; }
    }
    __device__ __forceinline__ void operator()(const f32x4 (&acc)[2][2][4][2], const Unit& u, int wr, int wc, int fr, int fq) const {
        constexpr int DFFc = 2816, N2 = 5632;
#pragma unroll
        for (int n = 0; n < 2; ++n) {
            const int cu = u.pn * 128 + wc * 32 + n * 16 + 4 * fq, cg = DFFc + cu;
            const f32x4 w0u = *(const f32x4*)(cw + cu), w1u = *(const f32x4*)(cw + N2 + cu), w2u = *(const f32x4*)(cw + 2 * N2 + cu), bu = *(const f32x4*)(cb + cu);
            const f32x4 w0g = *(const f32x4*)(cw + cg), w1g = *(const f32x4*)(cw + N2 + cg), w2g = *(const f32x4*)(cw + 2 * N2 + cg), bg = *(const f32x4*)(cb + cg);
#pragma unroll
            for (int ai = 0; ai < 2; ++ai) {
                const int row0 = u.pm * BM + ai * HALF + wr * 64 + 4 * fr;
                const f32x4 rs = *(const f32x4*)(rstd + row0);
                bf16_t* hp = halo + ((size_t)(row0 >> 6) * 4 + (fr == 0 ? 0 : 2)) * N2;
                f32x4 yu[4], yg[4];
                conv4(yu, acc[ai][0], n, rs, w0u, w1u, w2u, bu, cu, fr, hp);
                conv4(yg, acc[ai][1], n, rs, w0g, w1g, w2g, bg, cg, fr, hp);
#pragma unroll
                for (int m = 0; m < 4; ++m) if (fr != 0 || m >= 2) { const f32x4 o = silu_mul(yu[m], yg[m]); u32x2e w; w.x = cvt_pk_bf16(o[0], o[1]); w.y = cvt_pk_bf16(o[2], o[3]);
                    *(u32x2e*)(act + (size_t)(row0 + m) * DFFc + cu) = w; }
            }
        }
    }
};

template <bool BASE_F32> struct EpiResB {
    static constexpr bool PERM = true, AFTER_DRAIN = false, APERM = false;
    const void* base; bf16_t* out; int ldc;
    __device__ __forceinline__ void operator()(const f32x4 (&acc)[2][2][4][2], const Unit& u, int wr, int wc, int fr, int fq) const {
        const int col0 = u.pn * BM + wc * 32 + 8 * fq;
#pragma unroll
        for (int ai = 0; ai < 2; ++ai)
#pragma unroll
            for (int m = 0; m < 4; ++m) { const size_t off = (size_t)(u.pm * BM + ai * HALF + wr * 64 + m * 16 + fr) * ldc + col0;
#pragma unroll
                for (int bj = 0; bj < 2; ++bj) { f32x4 b0, b1;
                    if (BASE_F32) { b0 = *(const f32x4*)((const float*)base + off + bj * HALF); b1 = *(const f32x4*)((const float*)base + off + bj * HALF + 4); }
                    else { const u32x4 r = *(const u32x4*)((const bf16_t*)base + off + bj * HALF);
                        b0[0] = __uint_as_float(r.x << 16); b0[1] = __uint_as_float(r.x & 0xffff0000u); b0[2] = __uint_as_float(r.y << 16); b0[3] = __uint_as_float(r.y & 0xffff0000u);
                        b1[0] = __uint_as_float(r.z << 16); b1[1] = __uint_as_float(r.z & 0xffff0000u); b1[2] = __uint_as_float(r.w << 16); b1[3] = __uint_as_float(r.w & 0xffff0000u); }
                    const f32x4 o0 = b0 + acc[ai][bj][m][0], o1 = b1 + acc[ai][bj][m][1];
                    u32x4 w; w.x = cvt_pk_bf16(o0[0], o0[1]); w.y = cvt_pk_bf16(o0[2], o0[3]); w.z = cvt_pk_bf16(o1[0], o1[1]); w.w = cvt_pk_bf16(o1[2], o1[3]);
                    *(u32x4*)(out + off + bj * HALF) = w; } }
    }
};

struct EpiBf16S {
    static constexpr bool PERM = true, AFTER_DRAIN = false, APERM = false;
    bf16_t* O; int ldc; const float* rs;
    __device__ __forceinline__ void operator()(const f32x4 (&acc)[2][2][4][2], const Unit& u, int wr, int wc, int fr, int fq) const {
        const int row0 = u.pm * BM + wr * 64 + fr; const int col0 = u.pn * BM + wc * 32 + 8 * fq;
#pragma unroll
        for (int ai = 0; ai < 2; ++ai)
#pragma unroll
            for (int m = 0; m < 4; ++m) { const int row = row0 + ai * HALF + m * 16; const float s = rs[row]; bf16_t* rowp = O + (size_t)row * ldc + col0;
#pragma unroll
                for (int bj = 0; bj < 2; ++bj) { const f32x4 v0 = acc[ai][bj][m][0] * s, v1 = acc[ai][bj][m][1] * s;
                    u32x4 w; w.x = cvt_pk_bf16(v0[0], v0[1]); w.y = cvt_pk_bf16(v0[2], v0[3]); w.z = cvt_pk_bf16(v1[0], v1[1]); w.w = cvt_pk_bf16(v1[2], v1[3]);
                    *(u32x4*)(rowp + bj * HALF) = w; } }
    }
};

template <bool BASE_F32> struct EpiResBS {
    static constexpr bool PERM = true, AFTER_DRAIN = false, APERM = false;
    const void* base; bf16_t* out; int ldc; float* part;
    __device__ __forceinline__ void operator()(const f32x4 (&acc)[2][2][4][2], const Unit& u, int wr, int wc, int fr, int fq) const {
        const int col0 = u.pn * BM + wc * 32 + 8 * fq;
#pragma unroll
        for (int ai = 0; ai < 2; ++ai)
#pragma unroll
            for (int m = 0; m < 4; ++m) { const int row = u.pm * BM + ai * HALF + wr * 64 + m * 16 + fr; const size_t off = (size_t)row * ldc + col0; float ss = 0.f;
#pragma unroll
                for (int bj = 0; bj < 2; ++bj) { f32x4 b0, b1;
                    if (BASE_F32) { b0 = *(const f32x4*)((const float*)base + off + bj * HALF); b1 = *(const f32x4*)((const float*)base + off + bj * HALF + 4); }
                    else { const u32x4 r = *(const u32x4*)((const bf16_t*)base + off + bj * HALF);
                        b0[0] = __uint_as_float(r.x << 16); b0[1] = __uint_as_float(r.x & 0xffff0000u); b0[2] = __uint_as_float(r.y << 16); b0[3] = __uint_as_float(r.y & 0xffff0000u);
                        b1[0] = __uint_as_float(r.z << 16); b1[1] = __uint_as_float(r.z & 0xffff0000u); b1[2] = __uint_as_float(r.w << 16); b1[3] = __uint_as_float(r.w & 0xffff0000u); }
                    const f32x4 o0 = b0 + acc[ai][bj][m][0], o1 = b1 + acc[ai][bj][m][1];
                    ss += (o0[0] * o0[0] + o0[1] * o0[1]) + (o0[2] * o0[2] + o0[3] * o0[3]) + (o1[0] * o1[0] + o1[1] * o1[1]) + (o1[2] * o1[2] + o1[3] * o1[3]);
                    u32x4 w; w.x = cvt_pk_bf16(o0[0], o0[1]); w.y = cvt_pk_bf16(o0[2], o0[3]); w.z = cvt_pk_bf16(o1[0], o1[1]); w.w = cvt_pk_bf16(o1[2], o1[3]);
                    *(u32x4*)(out + off + bj * HALF) = w; }
                ss += __shfl_xor(ss, 16); ss += __shfl_xor(ss, 32);
                if (fq == 0) part[(size_t)row * 16 + u.pn * 4 + wc] = ss; }
    }
};
template <class Epi, class Sched, bool ALIGN_EPI = false, bool SP2 = false>
__device__ __forceinline__ void gemm_phase(PG8_LAS unsigned char* lds, const Gemm g, const Sched& S, const Epi& E) {
    int tid_l = threadIdx.x; asm volatile("" : "+v"(tid_l)); const int tid = tid_l, wid = __builtin_amdgcn_readfirstlane(tid >> 6), lane = tid & 63, wr = wid >> 2, wc = wid & 3, fr = lane & 15, fq = lane >> 4;
    const int K = g.K, nt = K / BK;
    unsigned voffA[2], voffB[2];
#pragma unroll
    for (int i = 0; i < 2; ++i) { int R, C; stage_rc(tid * 16 + i * 8192, R, C); const int Rb = Epi::PERM ? ((R & ~31) + perm32(R & 31)) : R;
        const int Ra = Epi::APERM ? ((R & 64) + (R & 15) * 4 + ((R >> 4) & 3)) : R; voffA[i] = (unsigned)(Ra * K + C) * 2u; voffB[i] = (unsigned)(Rb * K + C) * 2u; }
    const size_t kstep = (size_t)(BK * 2);
    const size_t hstep = (size_t)HALF * K * 2;
    const size_t tstep = 2 * hstep;
    const unsigned ldsw = (unsigned)wid * 1024u;
    const int aoff = lds_byte(wr * 64 + fr, fq * 8), boff = lds_byte(wc * 32 + fr, fq * 8);
#define PG8_SA(b, h) (((b) * 2 + (h)) * HTB)
#define PG8_SB(b, h) ((4 + (b) * 2 + (h)) * HTB)
#define PG8_STAGE(bufoff, gbase, voff) do { _Pragma("unroll") for (int _i = 0; _i < 2; ++_i) \
        __builtin_amdgcn_global_load_lds((const unsigned*)((const char*)(gbase) + (voff)[_i]), (PG8_LAS unsigned*)(lds + (bufoff) + ldsw + _i * 8192), 16, 0, 0); } while (0)
#define PG8_LDA(dst, b, h) do { _Pragma("unroll") for (int m = 0; m < 4; ++m) _Pragma("unroll") for (int k = 0; k < 2; ++k) dst[m][k] = *(const PG8_LAS bf16x8*)(lds + PG8_SA(b, h) + aoff + m * 2048 + k * 1024); } while (0)
#define PG8_LDB(dst, b, h) do { _Pragma("unroll") for (int n = 0; n < 2; ++n) _Pragma("unroll") for (int k = 0; k < 2; ++k) dst[n][k] = *(const PG8_LAS bf16x8*)(lds + PG8_SB(b, h) + boff + n * 2048 + k * 1024); } while (0)
#define PG8_MMA(ai, bj, At, Bt) do { __builtin_amdgcn_s_setprio(1); _Pragma("unroll") for (int m = 0; m < 4; ++m) _Pragma("unroll") for (int n = 0; n < 2; ++n) _Pragma("unroll") for (int k = 0; k < 2; ++k) \
        acc[ai][bj][m][n] = __builtin_amdgcn_mfma_f32_16x16x32_bf16(Bt[n][k], At[m][k], acc[ai][bj][m][n], 0, 0, 0); __builtin_amdgcn_s_setprio(0); } while (0)
#define PG8_WAIT_V(n) asm volatile("s_waitcnt vmcnt(" #n ")" ::: "memory")
#define PG8_WAIT_L(n) asm volatile("s_waitcnt lgkmcnt(" #n ")" ::: "memory")
#define PG8_BAR __builtin_amdgcn_s_barrier()
#define PG8_SCHED __builtin_amdgcn_sched_barrier(0)
    Unit cur, nxt; int ui = 0;
    if (!S.next(0, cur)) return;
    f32x4 acc[2][2][4][2];
#pragma unroll
    for (int a = 0; a < 2; ++a)
#pragma unroll
        for (int b = 0; b < 2; ++b)
#pragma unroll
            for (int m = 0; m < 4; ++m)
#pragma unroll
                for (int n = 0; n < 2; ++n) acc[a][b][m][n] = (f32x4){0.f, 0.f, 0.f, 0.f};
    bf16x8 At[4][2], B0[2][2], B1[2][2];
    const char* cA = (const char*)g.A + (size_t)cur.pm * tstep; const char* cB = (const char*)g.Bt + (size_t)cur.pn * tstep;
    S.a_ready(cur);
    if constexpr (SP2) {
        PG8_STAGE(PG8_SB(0, 0), cB, voffB); PG8_STAGE(PG8_SB(0, 1), cB + hstep, voffB); PG8_STAGE(PG8_SA(0, 0), cA, voffA); PG8_STAGE(PG8_SA(0, 1), cA + hstep, voffA);
        if (wr == 1) PG8_BAR;
        PG8_WAIT_V(2); PG8_BAR;
        PG8_STAGE(PG8_SB(1, 0), cB + kstep, voffB); PG8_STAGE(PG8_SA(1, 0), cA + kstep, voffA); PG8_STAGE(PG8_SB(1, 1), cB + hstep + kstep, voffB);
        PG8_WAIT_V(6); PG8_BAR;
    } else {
        PG8_STAGE(PG8_SB(0, 0), cB, voffB); PG8_STAGE(PG8_SA(0, 0), cA, voffA); PG8_STAGE(PG8_SB(0, 1), cB + hstep, voffB); PG8_STAGE(PG8_SA(0, 1), cA + hstep, voffA);
        if (wr == 1) PG8_BAR;
        PG8_WAIT_V(4); PG8_BAR;
        PG8_STAGE(PG8_SB(1, 0), cB + kstep, voffB); PG8_STAGE(PG8_SA(1, 0), cA + kstep, voffA); PG8_STAGE(PG8_SB(1, 1), cB + hstep + kstep, voffB);
        PG8_WAIT_V(6); PG8_BAR;
    }
    for (;;) {
        const bool has_next = S.next(ui + 1, nxt);
        const char* nA = has_next ? (const char*)g.A + (size_t)nxt.pm * tstep : cA; const char* nB = has_next ? (const char*)g.Bt + (size_t)nxt.pn * tstep : cB;
        for (int t = 0; t < nt; t += 2) {
            const bool last = (t == nt - 2);
            const char* a1 = cA + (size_t)(t + 1) * kstep;
            const char* a2 = last ? nA : cA + (size_t)(t + 2) * kstep; const char* b2 = last ? nB : cB + (size_t)(t + 2) * kstep;
            const char* a3 = a2 + kstep; const char* b3 = b2 + kstep;
            if (last && has_next) S.a_ready(nxt);
            if constexpr (SP2) {
            PG8_LDB(B0, 0, 0); PG8_LDB(B1, 0, 1); PG8_SCHED; PG8_LDA(At, 0, 0); PG8_STAGE(PG8_SA(1, 1), a1 + hstep, voffA);
            PG8_WAIT_V(8); PG8_WAIT_L(0); PG8_BAR; PG8_MMA(0, 0, At, B0); PG8_MMA(0, 1, At, B1); PG8_BAR; PG8_SCHED;
            PG8_LDA(At, 0, 1); PG8_STAGE(PG8_SB(0, 0), b2, voffB); PG8_STAGE(PG8_SB(0, 1), b2 + hstep, voffB); PG8_STAGE(PG8_SA(0, 0), a2, voffA);
            PG8_WAIT_V(8); PG8_WAIT_L(0); PG8_BAR; PG8_MMA(1, 0, At, B0); PG8_MMA(1, 1, At, B1); PG8_BAR; PG8_SCHED;
            PG8_LDB(B0, 1, 0); PG8_LDB(B1, 1, 1); PG8_SCHED; PG8_LDA(At, 1, 0); PG8_STAGE(PG8_SA(0, 1), a2 + hstep, voffA);
            PG8_WAIT_V(8); PG8_WAIT_L(0); PG8_BAR; PG8_MMA(0, 0, At, B0); PG8_MMA(0, 1, At, B1); PG8_BAR; PG8_SCHED;
            PG8_LDA(At, 1, 1); PG8_STAGE(PG8_SB(1, 0), b3, voffB); PG8_STAGE(PG8_SB(1, 1), b3 + hstep, voffB); PG8_STAGE(PG8_SA(1, 0), a3, voffA);
            PG8_WAIT_V(8); PG8_WAIT_L(0); PG8_BAR; PG8_MMA(1, 0, At, B0); PG8_MMA(1, 1, At, B1); PG8_BAR; PG8_SCHED;
            } else {
            PG8_LDB(B0, 0, 0); PG8_SCHED; PG8_LDA(At, 0, 0); PG8_STAGE(PG8_SA(1, 1), a1 + hstep, voffA);
            PG8_WAIT_L(8); PG8_BAR; PG8_WAIT_L(0); PG8_MMA(0, 0, At, B0); PG8_BAR; PG8_SCHED;
            PG8_LDB(B1, 0, 1); PG8_STAGE(PG8_SB(0, 0), b2, voffB);
            PG8_BAR; PG8_WAIT_L(0); PG8_MMA(0, 1, At, B1); PG8_BAR;
            PG8_LDA(At, 0, 1); PG8_STAGE(PG8_SA(0, 0), a2, voffA);
            PG8_BAR; PG8_WAIT_L(0); PG8_MMA(1, 0, At, B0); PG8_BAR; PG8_SCHED;
            PG8_STAGE(PG8_SB(0, 1), b2 + hstep, voffB);
            PG8_WAIT_V(6); PG8_BAR; PG8_MMA(1, 1, At, B1); PG8_BAR;
            PG8_LDB(B0, 1, 0); PG8_SCHED; PG8_LDA(At, 1, 0); PG8_STAGE(PG8_SA(0, 1), a2 + hstep, voffA);
            PG8_WAIT_L(8); PG8_BAR; PG8_WAIT_L(0); PG8_MMA(0, 0, At, B0); PG8_BAR; PG8_SCHED;
            PG8_LDB(B1, 1, 1); PG8_STAGE(PG8_SB(1, 0), b3, voffB);
            PG8_BAR; PG8_WAIT_L(0); PG8_MMA(0, 1, At, B1); PG8_BAR;
            PG8_LDA(At, 1, 1); PG8_STAGE(PG8_SA(1, 0), a3, voffA);
            PG8_BAR; PG8_WAIT_L(0); PG8_MMA(1, 0, At, B0); PG8_BAR; PG8_SCHED;
            PG8_STAGE(PG8_SB(1, 1), b3 + hstep, voffB);
            PG8_WAIT_V(6); PG8_BAR; PG8_MMA(1, 1, At, B1); PG8_BAR;
            }
        }
        if constexpr (ALIGN_EPI) { if (wr == 0) PG8_BAR; }
        if constexpr (!Epi::AFTER_DRAIN) { E(acc, cur, wr, wc, fr, fq); S.done(cur); }
        if (!has_next) break;
#pragma unroll
        for (int a = 0; a < 2; ++a)
#pragma unroll
            for (int b = 0; b < 2; ++b)
#pragma unroll
                for (int m = 0; m < 4; ++m)
#pragma unroll
                    for (int n = 0; n < 2; ++n) acc[a][b][m][n] = (f32x4){0.f, 0.f, 0.f, 0.f};
        cur = nxt; cA = nA; cB = nB; ++ui;
        if constexpr (ALIGN_EPI) { if (wr == 1) PG8_BAR; }
    }
    PG8_WAIT_V(0);
    if constexpr (!ALIGN_EPI) { if (wr == 0) PG8_BAR; }
    PG8_BAR;
    if constexpr (Epi::AFTER_DRAIN) { E.fused(acc, cur, wr, wc, fr, fq, lds, wid, lane); S.done(cur); }
#undef PG8_SA
#undef PG8_SB
#undef PG8_STAGE
#undef PG8_LDA
#undef PG8_LDB
#undef PG8_MMA
#undef PG8_WAIT_V
#undef PG8_WAIT_L
#undef PG8_BAR
#undef PG8_SCHED
}
}
#define LAS __attribute__((address_space(3)))
typedef unsigned short bf16;
typedef short bf16x8 __attribute__((ext_vector_type(8)));
typedef short s16x4 __attribute__((ext_vector_type(4)));
typedef float f32x16 __attribute__((ext_vector_type(16)));
typedef float f32x4 __attribute__((ext_vector_type(4)));
typedef unsigned u32x4 __attribute__((ext_vector_type(4)));
typedef unsigned u32x2 __attribute__((ext_vector_type(2)));

constexpr int DM = 1024, BATCH = 16, SEQ = 2048, MTOK = BATCH * SEQ, DEPTH = 2;
constexpr int NIN_SRC = 2308, NQKV = 2304, MIXW = 768, DFF = 2816, NFF2 = 5632;
constexpr float RMS_EPS = 1e-6f, L2E = 1.4426950408889634f, QSCALE = 0.125f * 1.4426950408889634f;
constexpr int C_FQ = 0, C_FK = 256, C_FV = 512, C_DQ = 768, C_DK = 1024, C_DV = 1280, C_CQ = 1536, C_CK = 1792, C_CV = 2048;
constexpr int MX_FOX = 0, MX_DIFF = 256, MX_CHK = 512;
constexpr int NTHREADS = 512, NWAVES = 8;
constexpr size_t MiB = 1u << 20;
constexpr size_t WS_CTL = 0, WS_FF = 1 * MiB, WS_CUM = 1 * MiB + 512 * 1024;
constexpr size_t WS_WIN = 2 * MiB, WS_WOUT = 14 * MiB, WS_WFI = 18 * MiB, WS_WFO = 40 * MiB;
constexpr size_t SZ_WIN = 6 * MiB, SZ_WOUT = 2 * MiB, SZ_WFI = 11 * MiB, SZ_WFO = (size_t)DM * DFF * 2;
constexpr size_t WS_H = 52 * MiB, WS_QKV = 116 * MiB, WS_MIX = 308 * MiB, WS_UV = 116 * MiB, WS_ACT = 260 * MiB, WS_XB = 436 * MiB, WS_END = 500 * MiB;
static_assert(WS_WFO + 2 * SZ_WFO <= WS_H, "ws map");
constexpr int HALF_M = MTOK / 2;
constexpr int LDS_RING = 131072, LDS_WF = 131072, LDS_MISC = 147456, LDS_TAB = 147456 + 256, LDS_BYTES = 155648;

typedef float f32x2_t __attribute__((ext_vector_type(2))); typedef __bf16 bf16x2_t __attribute__((ext_vector_type(2)));
__device__ __forceinline__ unsigned cvtpk(float lo, float hi) { f32x2_t v = {lo, hi}; bf16x2_t b = __builtin_convertvector(v, bf16x2_t); return __builtin_bit_cast(unsigned, b); }
__device__ __forceinline__ float bf2f(unsigned short v) { return __uint_as_float((unsigned)v << 16); }
__device__ __forceinline__ float wave_sum(float v) {
#pragma unroll
    for (int o = 1; o < 64; o <<= 1) v += __shfl_xor(v, o);
    return v;
}
__device__ __forceinline__ float ex2(float v) { return __builtin_amdgcn_exp2f(v); }

struct Args { const float* in[14]; float* out; unsigned char* ws; };
struct WMeta { bf16* dst; int K; float scale; const float* gk; };
constexpr int W_I_IN = 16 * 72, W_I_OUT = 12 * 32, W_I_FI = 16 * 176, W_I_FO = 44 * 32, W_I_L = W_I_IN + W_I_OUT + W_I_FI + W_I_FO;
__device__ __forceinline__ void witem_load(const Args& a, int it, int lane, float (&wv)[32], WMeta& mt) {
    const int l = it / W_I_L; int r = it % W_I_L;
    const float* W; int K, Nsrc, nblk, mode; bf16* WT;
    if (r < W_I_IN) { W = a.in[2] + (size_t)l * DM * NIN_SRC; K = DM; Nsrc = NIN_SRC; nblk = 72; WT = (bf16*)(a.ws + WS_WIN + l * SZ_WIN); mode = 1; }
    else if ((r -= W_I_IN) < W_I_OUT) { W = a.in[7] + (size_t)l * MIXW * DM; K = MIXW; Nsrc = DM; nblk = 32; WT = (bf16*)(a.ws + WS_WOUT + l * SZ_WOUT); mode = 0; }
    else if ((r -= W_I_OUT) < W_I_FI) { W = a.in[9] + (size_t)l * DM * NFF2; K = DM; Nsrc = NFF2; nblk = 176; WT = (bf16*)(a.ws + WS_WFI + l * SZ_WFI); mode = 2; }
    else { r -= W_I_FI; W = a.in[12] + (size_t)l * DFF * DM; K = DFF; Nsrc = DM; nblk = 32; WT = (bf16*)(a.ws + WS_WFO + l * SZ_WFO); mode = 0; }
    const int kb = r / nblk, nb = r % nblk, k0 = 64 * kb, n0 = 32 * nb;
    int sc0 = n0; float scale = 1.f;
    if (mode == 2) sc0 = (n0 >> 8) * 128 + (n0 & 127) + ((n0 & 128) ? DFF : 0);
    if (mode == 1) { sc0 = n0 + (n0 >= 768 ? 4 : 0);
        if ((n0 >= C_FQ && n0 < C_FK) || (n0 >= C_DQ && n0 < C_DK) || (n0 >= C_CQ && n0 < C_CK)) scale = QSCALE; }
    const float* src = W + (size_t)(k0 + (lane >> 5)) * Nsrc + sc0 + (lane & 31);
#pragma unroll
    for (int i = 0; i < 32; ++i) wv[i] = __builtin_nontemporal_load(src + (size_t)(2 * i) * Nsrc);
    mt.dst = WT + (size_t)n0 * K + k0; mt.K = K; mt.scale = scale; mt.gk = (mode == 1) ? a.in[1] + (size_t)l * DM + k0 : (mode == 2) ? a.in[8] + (size_t)l * DM + k0 : nullptr;
}
__device__ __forceinline__ void witem_store(const WMeta& mt, const float (&wv)[32], LAS float* scr, int lane) {
#pragma unroll
    for (int i = 0; i < 32; ++i) { const int kk = 2 * i + (lane >> 5); scr[kk * 33 + (lane & 31)] = wv[i] * (mt.gk ? mt.scale * mt.gk[kk] : mt.scale); }
    asm volatile("s_waitcnt lgkmcnt(0)" ::: "memory");
    const int c = lane & 7;
#pragma unroll
    for (int j = 0; j < 4; ++j) { const int n = (lane >> 3) + 8 * j; const LAS float* s = scr + (8 * c) * 33 + n;
        u32x4 o; o.x = cvtpk(s[0 * 33], s[1 * 33]); o.y = cvtpk(s[2 * 33], s[3 * 33]); o.z = cvtpk(s[4 * 33], s[5 * 33]); o.w = cvtpk(s[6 * 33], s[7 * 33]);
        *(u32x4*)(mt.dst + (size_t)n * mt.K + 8 * c) = o; }
}
__device__ __forceinline__ void phase_weights(const Args& a, LAS unsigned char* lds, int gw, int NGW, int wave, int lane) {
    LAS float* scr = (LAS float*)(lds + wave * 16896);
    for (int it = gw; it < DEPTH * W_I_L; it += 2 * NGW) {
        float wa[32], wb[32]; WMeta ma, mb; const bool two = it + NGW < DEPTH * W_I_L;
        witem_load(a, it, lane, wa, ma);
        if (two) witem_load(a, it + NGW, lane, wb, mb);
        witem_store(ma, wa, scr, lane);
        if (two) witem_store(mb, wb, scr + 64 * 33, lane);
        asm volatile("s_waitcnt lgkmcnt(0)" ::: "memory");
    }
}

template <bool XBF> struct RowLd;
template <> struct RowLd<false> { typedef f32x4 raw; static __device__ __forceinline__ raw ld(const void* x, size_t m, int lane, int j) { return __builtin_nontemporal_load((const f32x4*)((const float*)x + m * DM) + lane + 64 * j); }
    static __device__ __forceinline__ f32x4 cv(raw r) { return r; } };
template <> struct RowLd<true> { typedef u32x2 raw; static __device__ __forceinline__ raw ld(const void* x, size_t m, int lane, int j) { return *((const u32x2*)((const bf16*)x + m * DM) + lane + 64 * j); }
    static __device__ __forceinline__ f32x4 cv(raw r) { f32x4 v; v.x = __uint_as_float(r.x << 16); v.y = __uint_as_float(r.x & 0xffff0000u); v.z = __uint_as_float(r.y << 16); v.w = __uint_as_float(r.y & 0xffff0000u); return v; } };
template <int MODE, bool XBF>
__device__ __forceinline__ void phase_norm(const void* x, const float* g, bf16* H, float* outf, const float* w_in_l, const float* b_fox, float* FF,
                                           LAS unsigned char* lds, int gw, int NGW, int tid, int lane) {
    LAS f32x4* wf = (LAS f32x4*)(lds + LDS_WF);
    if (MODE == 1) {
        __syncthreads();
        for (int k = tid; k < DM; k += NTHREADS) wf[k] = *(const f32x4*)(w_in_l + (size_t)k * NIN_SRC + 768);
        __syncthreads();
    }
    f32x4 gv[4];
#pragma unroll
    for (int j = 0; j < 4; ++j) gv[j] = *((const f32x4*)g + lane + 64 * j);
    f32x4 v[4]; typename RowLd<XBF>::raw vn[4];
    if (gw < MTOK) {
#pragma unroll
        for (int j = 0; j < 4; ++j) vn[j] = RowLd<XBF>::ld(x, (size_t)gw, lane, j); }
    for (int m = gw; m < MTOK; m += NGW) {
        float s = 0.f;
#pragma unroll
        for (int j = 0; j < 4; ++j) v[j] = RowLd<XBF>::cv(vn[j]);
        if (m + NGW < MTOK) {
#pragma unroll
            for (int j = 0; j < 4; ++j) vn[j] = RowLd<XBF>::ld(x, (size_t)(m + NGW), lane, j); }
#pragma unroll
        for (int j = 0; j < 4; ++j) s += (v[j].x * v[j].x + v[j].y * v[j].y) + (v[j].z * v[j].z + v[j].w * v[j].w);
        const float rstd = 1.0f / sqrtf(wave_sum(s) * (1.f / DM) + RMS_EPS);
        if (MODE == 3) { if (lane == 0) outf[m] = rstd; continue; }
        if (MODE == 1) {
            if (!XBF) { u32x2* o = (u32x2*)(H + (size_t)m * DM) + lane;
#pragma unroll
                for (int j = 0; j < 4; ++j) { u32x2 w; w.x = cvtpk(v[j].x, v[j].y); w.y = cvtpk(v[j].z, v[j].w); o[64 * j] = w; } }
            if (lane == 0) outf[m] = rstd;
        }
#pragma unroll
        for (int j = 0; j < 4; ++j) v[j] = v[j] * rstd * gv[j];
        if (MODE == 2) {
            f32x4* o = (f32x4*)(outf + (size_t)m * DM) + lane;
#pragma unroll
            for (int j = 0; j < 4; ++j) __builtin_nontemporal_store(v[j], o + 64 * j);
        } else if (MODE == 0) {
            u32x2* o = (u32x2*)(H + (size_t)m * DM) + lane;
#pragma unroll
            for (int j = 0; j < 4; ++j) { u32x2 w; w.x = cvtpk(v[j].x, v[j].y); w.y = cvtpk(v[j].z, v[j].w); o[64 * j] = w; }
        }
        if (MODE == 1) {
            f32x4 d = {0.f, 0.f, 0.f, 0.f};
#pragma unroll
            for (int j = 0; j < 4; ++j) { const int k = 4 * lane + 256 * j;
                d += wf[k] * v[j].x; d += wf[k + 1] * v[j].y; d += wf[k + 2] * v[j].z; d += wf[k + 3] * v[j].w; }
            const bool h32 = (lane & 32) != 0, h16 = (lane & 16) != 0;
            float p0 = h32 ? d.z : d.x, p1 = h32 ? d.w : d.y;
            p0 += __shfl_xor(h32 ? d.x : d.z, 32); p1 += __shfl_xor(h32 ? d.y : d.w, 32);
            float r = h16 ? p1 : p0;
            r += __shfl_xor(h16 ? p0 : p1, 16);
            r += __shfl_xor(r, 8); r += __shfl_xor(r, 4); r += __shfl_xor(r, 2); r += __shfl_xor(r, 1);
            if ((lane & 15) == 0) { const int hh = lane >> 4; const float z = r + b_fox[hh];
                const float ls = fminf(z, 0.f) - log1pf(expf(-fabsf(z)));
                FF[(size_t)m * 4 + hh] = ls; }
        }
    }
}

__device__ __forceinline__ void cumsum_seq(const float* FF, float* CUM, int bh, int lane) {
    const int b = bh >> 2, h = bh & 3;
    const float* src = FF + ((size_t)b * SEQ + 32 * lane) * 4 + h;
    float v[32]; float s = 0.f;
#pragma unroll
    for (int i = 0; i < 32; ++i) { s += src[4 * i]; v[i] = s; }
    float inc = s;
#pragma unroll
    for (int o = 1; o < 64; o <<= 1) { const float t = __shfl_up(inc, o); if (lane >= o) inc += t; }
    const float excl = inc - s;
    float* dst = CUM + (size_t)bh * SEQ + 32 * lane;
#pragma unroll
    for (int i = 0; i < 32; i += 4) { f32x4 w = {v[i] + excl, v[i + 1] + excl, v[i + 2] + excl, v[i + 3] + excl}; *(f32x4*)(dst + i) = w; }
}

__device__ __forceinline__ void unpack8(const u32x4 a, float (&f)[8]) {
#pragma unroll
    for (int i = 0; i < 4; ++i) { f[2 * i] = __uint_as_float(a[i] << 16); f[2 * i + 1] = __uint_as_float(a[i] & 0xffff0000u); } }
__device__ __forceinline__ void phase_fixup(const bf16* HALO, bf16* ACT, const float* cw, const float* cb, int gt, int NGT) {
    constexpr int NCG = DFF / 8, NG = MTOK / 64;
    for (int it = gt; it < NG * 2 * NCG; it += NGT) {
        const int cg8 = it % NCG, rs = it / NCG, s = rs & 1, j = rs >> 1, c0 = cg8 * 8;
        const bool first = ((j * 64) % SEQ) == 0;
        const bf16* hj = HALO + (size_t)j * 4 * NFF2; const bf16* hp = hj - 4 * NFF2;
        const bf16* pt = hj + (size_t)s * NFF2;
        const bf16* p1 = (s == 0) ? hp + 3 * NFF2 : hj;
        const bf16* p2 = (s == 0) ? hp + 2 * NFF2 : hp + 3 * NFF2;
        const u32x4 z = {0u, 0u, 0u, 0u};
        float ut[8], u1[8], u2[8], gt_[8], g1[8], g2[8];
        unpack8(*(const u32x4*)(pt + c0), ut); unpack8(*(const u32x4*)(pt + DFF + c0), gt_);
        unpack8((s == 0 && first) ? z : *(const u32x4*)(p1 + c0), u1); unpack8((s == 0 && first) ? z : *(const u32x4*)(p1 + DFF + c0), g1);
        unpack8(first ? z : *(const u32x4*)(p2 + c0), u2); unpack8(first ? z : *(const u32x4*)(p2 + DFF + c0), g2);
        float o[8];
#pragma unroll
        for (int i = 0; i < 8; ++i) { const int c = c0 + i;
            const float yu = cb[c] + cw[c] * u2[i] + cw[NFF2 + c] * u1[i] + cw[2 * NFF2 + c] * ut[i];
            const float yg = cb[DFF + c] + cw[DFF + c] * g2[i] + cw[NFF2 + DFF + c] * g1[i] + cw[2 * NFF2 + DFF + c] * gt_[i];
            o[i] = yu * yg / (1.f + __expf(-yg)); }
        u32x4 w; w.x = cvtpk(o[0], o[1]); w.y = cvtpk(o[2], o[3]); w.z = cvtpk(o[4], o[5]); w.w = cvtpk(o[6], o[7]);
        *(u32x4*)(ACT + (size_t)(j * 64 + s) * DFF + c0) = w;
    }
}
__device__ __forceinline__ s16x4 vtr(LAS const char* p) { typedef short v4i16_t __attribute__((ext_vector_type(4))); return __builtin_bit_cast(s16x4, __builtin_amdgcn_ds_read_tr16_b64_v4i16((LAS v4i16_t*)p)); }
constexpr int KROWB = 144, KT_BYTES = 64 * KROWB;

__device__ __forceinline__ void qk_tile(f32x16& p0, f32x16& p1, LAS const char* kt, const bf16x8 (&qr)[4], int r32, int hi) {
    LAS const char* kb = kt + r32 * KROWB + hi * 16;
#pragma unroll
    for (int ks = 0; ks < 4; ++ks) {
        const bf16x8 a0 = *(LAS const bf16x8*)(kb + ks * 32), a1 = *(LAS const bf16x8*)(kb + 32 * KROWB + ks * 32);
        p0 = __builtin_amdgcn_mfma_f32_32x32x16_bf16(a0, qr[ks], p0, 0, 0, 0);
        p1 = __builtin_amdgcn_mfma_f32_32x32x16_bf16(a1, qr[ks], p1, 0, 0, 0);
    }
}
template <int NDB>
__device__ __forceinline__ void softmax_pv(f32x16& p0, f32x16& p1, float& m, float& l, f32x16 (&o)[NDB], LAS const char* vt, int vb) {
    float mx = fmaxf(p0[0], p1[0]);
#pragma unroll
    for (int r = 1; r < 16; ++r) mx = fmaxf(mx, fmaxf(p0[r], p1[r]));
    mx = fmaxf(mx, __shfl_xor(mx, 32));
    if (__builtin_amdgcn_ballot_w64(mx > m) != 0ull) {
        const float mn = fmaxf(m, mx);
        const float alpha = ex2(m - mn);
        m = mn; l *= alpha;
#pragma unroll
        for (int db = 0; db < NDB; ++db)
#pragma unroll
            for (int r = 0; r < 16; ++r) o[db][r] *= alpha;
    }
    const float mn = m;
    float rs = 0.f;
#pragma unroll
    for (int r = 0; r < 16; ++r) { p0[r] = ex2(p0[r] - mn); p1[r] = ex2(p1[r] - mn); rs += p0[r] + p1[r]; }
    l += rs;
    bf16x8 pf[4];
    { u32x4 w;
      w.x = cvtpk(p0[0], p0[1]); w.y = cvtpk(p0[2], p0[3]); w.z = cvtpk(p0[4], p0[5]); w.w = cvtpk(p0[6], p0[7]); pf[0] = __builtin_bit_cast(bf16x8, w);
      w.x = cvtpk(p0[8], p0[9]); w.y = cvtpk(p0[10], p0[11]); w.z = cvtpk(p0[12], p0[13]); w.w = cvtpk(p0[14], p0[15]); pf[1] = __builtin_bit_cast(bf16x8, w);
      w.x = cvtpk(p1[0], p1[1]); w.y = cvtpk(p1[2], p1[3]); w.z = cvtpk(p1[4], p1[5]); w.w = cvtpk(p1[6], p1[7]); pf[2] = __builtin_bit_cast(bf16x8, w);
      w.x = cvtpk(p1[8], p1[9]); w.y = cvtpk(p1[10], p1[11]); w.z = cvtpk(p1[12], p1[13]); w.w = cvtpk(p1[14], p1[15]); pf[3] = __builtin_bit_cast(bf16x8, w); }
#pragma unroll
    for (int kk = 0; kk < 4; ++kk)
#pragma unroll
        for (int db = 0; db < NDB; ++db) {
            const s16x4 lo = vtr(vt + vb + db * 4096 + kk * 1024), hh = vtr(vt + vb + db * 4096 + kk * 1024 + 512);
            const bf16x8 vf = {lo[0], lo[1], lo[2], lo[3], hh[0], hh[1], hh[2], hh[3]};
            o[db] = __builtin_amdgcn_mfma_f32_32x32x16_bf16(vf, pf[kk], o[db], 0, 0, 0);
        }
}

template <int MODE>
__device__ __forceinline__ void attn_unit64(const bf16* qkv, bf16* mix, const float* cum_bh, int b, int h, int blk, LAS unsigned char* lds, int tid, int wave, int lane) {
    constexpr int CUMOFF = KT_BYTES + 8192, BUFSZ = CUMOFF + 256;
    const int r32 = lane & 31, hi = lane >> 5;
    const size_t rowbase = (size_t)b * SEQ;
    const int Q0 = blk * 256, qw0 = Q0 + 32 * wave;
    const int CQ = (MODE == 0 ? C_FQ : C_CQ) + h * 64, CK = (MODE == 0 ? C_FK : C_CK) + h * 64, CV = (MODE == 0 ? C_FV : C_CV) + h * 64;
    const int c0 = 4 * blk, cw = c0 + (wave >> 1);
    int tbeg, tend, kvoff;
    if (MODE == 0) { tbeg = 0; tend = 4 * (blk + 1); kvoff = 0; }
    else { tbeg = (c0 >= 8) ? 0 : 8 - c0; tend = 12; kvoff = (c0 - 8) * 64; }
    const int srow = tid >> 3, sch = tid & 7;
    const bf16* kg = qkv + (rowbase + kvoff + srow) * NQKV + CK + sch * 8;
    const bf16* vg = qkv + (rowbase + kvoff + srow) * NQKV + CV + sch * 8;
    const int kdst = srow * KROWB + sch * 16, vdst = KT_BYTES + (sch >> 2) * 4096 + srow * 64 + (sch & 3) * 16;
    const float cref = (MODE == 0) ? cum_bh[Q0] : 0.f;
#define U64_LOAD(K, V, C, tt) do { if ((tt) >= tbeg) { K = *(const u32x4*)(kg + (size_t)(tt) * 64 * NQKV); V = *(const u32x4*)(vg + (size_t)(tt) * 64 * NQKV); \
        if (MODE == 0 && tid < 16) C = *(const f32x4*)(cum_bh + (tt) * 64 + 4 * tid); } } while (0)
#define U64_STAGE(K, V, C, buf) do { *(LAS u32x4*)((buf) + kdst) = K; *(LAS u32x4*)((buf) + vdst) = V; if (MODE == 0 && tid < 16) *(LAS f32x4*)((buf) + CUMOFF + tid * 16) = (cref - C) * L2E; } while (0)
#define LDS_BAR() asm volatile("s_waitcnt lgkmcnt(0)\n\ts_barrier" ::: "memory")
    u32x4 kA = {0u, 0u, 0u, 0u}, vA = kA, kB = kA, vB = kA; f32x4 cA = {0.f, 0.f, 0.f, 0.f}, cB = cA;
    U64_LOAD(kA, vA, cA, tend - 1); U64_LOAD(kB, vB, cB, tend - 2);
    bf16x8 qr[4];
#pragma unroll
    for (int ks = 0; ks < 4; ++ks) qr[ks] = *(const bf16x8*)(qkv + (rowbase + qw0 + r32) * NQKV + CQ + ks * 16 + hi * 8);
    float m = -1e30f, l = 0.f;
    f32x16 o[2];
#pragma unroll
    for (int db = 0; db < 2; ++db)
#pragma unroll
        for (int r = 0; r < 16; ++r) o[db][r] = 0.f;
    const int vb = (4 * hi + ((lane & 15) >> 2)) * 64 + ((lane >> 4) & 1) * 32 + (lane & 3) * 8;
    LAS const float* tab = (LAS const float*)(lds + LDS_TAB) + h * 192;
    auto compute = [&](const int t, LAS unsigned char* const buf) __attribute__((always_inline)) {
        const int kv0 = kvoff + 64 * t;
        bool doit;
        if (MODE == 0) doit = kv0 <= qw0 + 31; else { const int kc = c0 - 8 + t; doit = (kc >= cw - 8) && (kc <= cw); }
        if (doit) {
            f32x16 p0 = (f32x16){0.f, 0.f, 0.f, 0.f, 0.f, 0.f, 0.f, 0.f, 0.f, 0.f, 0.f, 0.f, 0.f, 0.f, 0.f, 0.f}, p1 = p0;
            if (MODE == 2 && cw - (c0 - 8 + t) >= 3) { const float bv = tab[191];
#pragma unroll
                for (int r = 0; r < 16; ++r) { p0[r] = bv; p1[r] = bv; } }
            if (MODE == 0) {
#pragma unroll
                for (int g = 0; g < 4; ++g) { const f32x4 ca = *(LAS const f32x4*)(buf + CUMOFF + (8 * g + 4 * hi) * 4), cb = *(LAS const f32x4*)(buf + CUMOFF + (32 + 8 * g + 4 * hi) * 4);
#pragma unroll
                    for (int i = 0; i < 4; ++i) { p0[4 * g + i] = ca[i]; p1[4 * g + i] = cb[i]; } }
            }
            qk_tile(p0, p1, (LAS const char*)buf, qr, r32, hi);
            if (MODE == 0) {
                if (kv0 + 63 > qw0) {
                    const int qa = qw0 + r32 - kv0 - 4 * hi;
#pragma unroll
                    for (int r = 0; r < 16; ++r) { const int kl = (r & 3) + 8 * (r >> 2); if (kl > qa) p0[r] = -INFINITY; if (kl + 32 > qa) p1[r] = -INFINITY; }
                }
            } else {
                const int dc = cw - (c0 - 8 + t);
                if (dc < 3) {
                    const int rel0 = qw0 + r32 - kv0 - 4 * hi + 63;
#pragma unroll
                    for (int r = 0; r < 16; ++r) { const int kl = (r & 3) + 8 * (r >> 2);
                        int i0 = rel0 - kl, i1 = rel0 - kl - 32; i0 = i0 < 0 ? 0 : (i0 > 191 ? 191 : i0); i1 = i1 < 0 ? 0 : (i1 > 191 ? 191 : i1);
                        p0[r] += tab[i0]; p1[r] += tab[i1]; }
                }
            }
            softmax_pv<2>(p0, p1, m, l, o, (LAS const char*)buf + KT_BYTES, vb);
        }
    };
    int pi = 0;
    for (int t = tend - 1; t >= tbeg; t -= 2, pi ^= 1) {
        LAS unsigned char* const sb = lds + (pi ? 2 * BUFSZ : 0); const bool two = (t - 1 >= tbeg);
        U64_STAGE(kA, vA, cA, sb); if (two) U64_STAGE(kB, vB, cB, sb + BUFSZ);
        LDS_BAR();
        U64_LOAD(kA, vA, cA, t - 2); U64_LOAD(kB, vB, cB, t - 3);
        compute(t, sb); if (two) compute(t - 1, sb + BUFSZ);
    }
#undef U64_LOAD
#undef U64_STAGE
    l += __shfl_xor(l, 32);
    const float inv = 1.0f / l;
    bf16* orow = mix + (rowbase + qw0 + r32) * MIXW + (MODE == 0 ? MX_FOX : MX_CHK) + h * 64 + 4 * hi;
#pragma unroll
    for (int db = 0; db < 2; ++db)
#pragma unroll
        for (int g = 0; g < 4; ++g) { u32x2 w; w.x = cvtpk(o[db][4 * g] * inv, o[db][4 * g + 1] * inv); w.y = cvtpk(o[db][4 * g + 2] * inv, o[db][4 * g + 3] * inv);
            *(u32x2*)(orow + 32 * db + 8 * g) = w; }
    __syncthreads();
}

template <int C>
__device__ __forceinline__ void diff_pass(const bf16* qkv, bf16* mix, float* park, int b, int h, int blk, float lam, float sl2, const float* gdiff, float outscale,
                                          LAS unsigned char* lds, int tid, int wave, int lane) {
    constexpr int VOFF = KT_BYTES, BUFSZ = VOFF + 16384;
    const int r32 = lane & 31, hi = lane >> 5;
    const size_t rowbase = (size_t)b * SEQ;
    const int Q0 = blk * 256, qw0 = Q0 + 32 * wave, cwv = qw0 >> 6, tend = 4 * (blk + 1);
    const int srow = tid >> 3, sch = tid & 7;
    const int vrow0 = tid >> 4, vch = tid & 15;
    const bf16* vg = qkv + (rowbase + vrow0) * NQKV + C_DV + h * 128 + vch * 8;
    const int kdst = srow * KROWB + sch * 16, vdst = VOFF + (vch >> 2) * 4096 + vrow0 * 64 + (vch & 3) * 16;
    const int vb = (4 * hi + ((lane & 15) >> 2)) * 64 + ((lane >> 4) & 1) * 32 + (lane & 3) * 8;
    const bf16* kg = qkv + (rowbase + srow) * NQKV + C_DK + h * 128 + C * 64 + sch * 8;
#define DF_LOAD(K, V0, V1, tt) do { if ((tt) >= 0) { const size_t go_ = (size_t)(tt) * 64 * NQKV; K = *(const u32x4*)(kg + go_); V0 = *(const u32x4*)(vg + go_); V1 = *(const u32x4*)(vg + go_ + (size_t)32 * NQKV); } } while (0)
#define DF_STAGE(K, V0, V1, buf) do { *(LAS u32x4*)((buf) + kdst) = K; *(LAS u32x4*)((buf) + vdst) = V0; *(LAS u32x4*)((buf) + vdst + 32 * 64) = V1; } while (0)
    u32x4 kA = {0u, 0u, 0u, 0u}, v0A = kA, v1A = kA, kB = kA, v0B = kA, v1B = kA;
    DF_LOAD(kA, v0A, v1A, tend - 1); DF_LOAD(kB, v0B, v1B, tend - 2);
    bf16x8 qr[4];
#pragma unroll
    for (int ks = 0; ks < 4; ++ks) qr[ks] = *(const bf16x8*)(qkv + (rowbase + qw0 + r32) * NQKV + C_DQ + h * 128 + C * 64 + ks * 16 + hi * 8);
    float m = -1e30f, l = 0.f;
    f32x16 o[4];
#pragma unroll
    for (int db = 0; db < 4; ++db)
#pragma unroll
        for (int r = 0; r < 16; ++r) o[db][r] = 0.f;
    f32x16 ab;
#pragma unroll
    for (int r = 0; r < 16; ++r) ab[r] = sl2 * (float)((r & 3) + 8 * (r >> 2) + 4 * hi);
    auto compute = [&](const int t, LAS unsigned char* const buf) __attribute__((always_inline)) {
        if (t <= cwv) {
            const int kv0 = 64 * t;
            f32x16 p0, p1;
            if (t < cwv) { const float d0 = sl2 * (float)(64 * (t - cwv)), d1 = d0 + 32.f * sl2;
#pragma unroll
                for (int r = 0; r < 16; ++r) { p0[r] = ab[r] + d0; p1[r] = ab[r] + d1; }
                qk_tile(p0, p1, (LAS const char*)buf, qr, r32, hi);
            } else { p0 = (f32x16){0.f, 0.f, 0.f, 0.f, 0.f, 0.f, 0.f, 0.f, 0.f, 0.f, 0.f, 0.f, 0.f, 0.f, 0.f, 0.f}; p1 = p0;
                qk_tile(p0, p1, (LAS const char*)buf, qr, r32, hi);
                const float ql = (float)(qw0 + r32 - kv0), base = ql - (float)(4 * hi);
#pragma unroll
                for (int r = 0; r < 16; ++r) { const float kl = (float)((r & 3) + 8 * (r >> 2)); p0[r] += sl2 * (ql - fabsf(base - kl)); p1[r] += sl2 * (ql - fabsf(base - kl - 32.f)); }
            }
            softmax_pv<4>(p0, p1, m, l, o, (LAS const char*)buf + VOFF, vb);
        }
    };
    int pi = 0;
    for (int t = tend - 1; t >= 0; t -= 2, pi ^= 1) {
        LAS unsigned char* const sb = lds + (pi ? 2 * BUFSZ : 0);
        DF_STAGE(kA, v0A, v1A, sb); DF_STAGE(kB, v0B, v1B, sb + BUFSZ);
        LDS_BAR();
        DF_LOAD(kA, v0A, v1A, t - 2); DF_LOAD(kB, v0B, v1B, t - 3);
        compute(t, sb); compute(t - 1, sb + BUFSZ);
    }
#undef DF_LOAD
#undef DF_STAGE
    l += __shfl_xor(l, 32);
    const float inv = 1.0f / l;
    if (C == 0) {
#pragma unroll
        for (int db = 0; db < 4; ++db)
#pragma unroll
            for (int r = 0; r < 16; ++r) park[(db * 16 + r) * NTHREADS] = o[db][r] * inv;
    } else {
        const float li = lam * inv;
        float ss = 0.f;
#pragma unroll
        for (int db = 0; db < 4; ++db) {
#pragma unroll
            for (int r = 0; r < 16; ++r) { const float v = park[(db * 16 + r) * NTHREADS] - o[db][r] * li; o[db][r] = v; ss += v * v; }
            asm volatile("" ::: "memory"); }
        ss += __shfl_xor(ss, 32);
        const float rn = outscale / sqrtf(ss * (1.f / 128.f) + RMS_EPS);
        bf16* orow = mix + (rowbase + qw0 + r32) * MIXW + MX_DIFF + h * 128 + 4 * hi;
#pragma unroll
        for (int db = 0; db < 4; ++db)
#pragma unroll
            for (int g = 0; g < 4; ++g) { const f32x4 gg = *(const f32x4*)(gdiff + 32 * db + 8 * g + 4 * hi);
                u32x2 w; w.x = cvtpk(o[db][4 * g] * rn * gg.x, o[db][4 * g + 1] * rn * gg.y); w.y = cvtpk(o[db][4 * g + 2] * rn * gg.z, o[db][4 * g + 3] * rn * gg.w);
                *(u32x2*)(orow + 32 * db + 8 * g) = w; }
    }
    __syncthreads();
}
__device__ __forceinline__ void attn_unit_diff2(const bf16* qkv, bf16* mix, int b, int h, int blk, float lam, float sl2, const float* gdiff, float outscale,
                                                LAS unsigned char* lds, int tid, int wave, int lane) {
    float* park = (float*)((unsigned char*)qkv - WS_QKV + WS_H) + (size_t)blockIdx.x * 64 * NTHREADS + tid;
    diff_pass<0>(qkv, mix, park, b, h, blk, lam, sl2, gdiff, outscale, lds, tid, wave, lane);
    int tid2 = threadIdx.x; asm volatile("" : "+v"(tid2) :: "memory"); __builtin_amdgcn_sched_barrier(0);
    float* park2 = (float*)((unsigned char*)qkv - WS_QKV + WS_H) + (size_t)blockIdx.x * 64 * NTHREADS + tid2;
    diff_pass<1>(qkv, mix, park2, b, h, blk, lam, sl2, gdiff, outscale, lds, tid2, __builtin_amdgcn_readfirstlane(tid2 >> 6), tid2 & 63);
}
#define SF(q) (0 << 5 | (q) << 1 | 0), (0 << 5 | (q) << 1 | 1)
#define SD(q) (1 << 5 | (q) << 1 | 0)
#define SC(q) (2 << 5 | (q) << 1 | 0), (2 << 5 | (q) << 1 | 1)
__device__ __forceinline__ int seg_code(int s) {
    constexpr unsigned char T[40] = { SD(7), SD(6), SD(5), SD(4), SD(3), SF(7), SD(2), SF(6), SF(5), SD(1), SF(4), SF(3), SD(0), SF(2),
        SC(7), SC(6), SC(5), SC(4), SC(3), SC(2), SC(1), SC(0), SF(1), SF(0) };
    return T[s];
}
__device__ __forceinline__ void phase_attn(const Args& a, int layer, unsigned* ctr, LAS unsigned char* lds, int tid0, int wave0, int lane0) {
    const bf16* qkv = (const bf16*)(a.ws + WS_QKV); bf16* mix = (bf16*)(a.ws + WS_MIX); const float* CUM = (const float*)(a.ws + WS_CUM);
    for (int i = tid0; i < 4 * 192; i += NTHREADS) ((LAS float*)(lds + LDS_TAB))[i] = a.in[6][(size_t)layer * 768 + i] * L2E;
    const float* dl = a.in[4] + (size_t)layer * 256;
    const float s01 = wave_sum(dl[lane0] * dl[64 + lane0]), s23 = wave_sum(dl[128 + lane0] * dl[192 + lane0]);
    const float lambda_init = 0.8f - 0.6f * expf(-0.3f * (float)layer);
    const float lam = expf(s01) - expf(s23) + lambda_init;
    const float* gdiff = a.in[5] + (size_t)layer * 128;
    LAS volatile unsigned* misc = (LAS volatile unsigned*)(lds + LDS_MISC);
    __syncthreads();
    for (;;) {
        if (threadIdx.x == 0) misc[0] = atomicAdd(ctr, 1u);
        __syncthreads();
        const unsigned idx = misc[0];
        int tidf = threadIdx.x; asm volatile("" : "+v"(tidf) :: "memory"); __builtin_amdgcn_sched_barrier(0);
        const int tid = tidf, lane = tidf & 63, wave = __builtin_amdgcn_readfirstlane(tidf >> 6);
        if (idx >= 1280u) break;
        const int code = seg_code((int)(idx >> 5)), kind = code >> 5, blk = (code >> 1) & 15, sub = (int)(idx & 31);
        if (kind == 1) { const int b = sub >> 1, h = sub & 1;
            attn_unit_diff2(qkv, mix, b, h, blk, lam, exp2f(-4.0f * (float)(h + 1)) * L2E, gdiff, 1.0f - lambda_init, lds, tid, wave, lane); }
        else { const int bh = (code & 1) * 32 + sub, b = bh >> 2, h = bh & 3;
            if (kind == 0) attn_unit64<0>(qkv, mix, CUM + (size_t)bh * SEQ, b, h, blk, lds, tid, wave, lane);
            else attn_unit64<2>(qkv, mix, nullptr, b, h, blk, lds, tid, wave, lane); }
    }
}
#define XB_TMO      128
#define XB_XCNT(j)  (256  + 64 * (j))
#define XB_XSUB(j)  (1280 + 64 * (j))
#define XB_XGEN(j)  (2304 + 64 * (j))
#define XB_TOP      3328
#define XB_TOPGEN   3392
#define XCD_BAR_WORDS 3456
#define XB_SPIN_CAP (1u << 18)

__device__ __forceinline__ unsigned xb_ld(unsigned* p)              { return __hip_atomic_load(p, __ATOMIC_RELAXED, __HIP_MEMORY_SCOPE_AGENT); }
__device__ __forceinline__ unsigned xb_add(unsigned* p, unsigned v) { return __hip_atomic_fetch_add(p, v, __ATOMIC_RELAXED, __HIP_MEMORY_SCOPE_AGENT); }
__device__ __forceinline__ unsigned xb_xcc_id() { return (unsigned)__builtin_amdgcn_s_getreg((3 << 11) | 20) & 0xFu; }
#define XB_SPIN(cond, bar) do { unsigned _sp = 0; while (cond) { __builtin_amdgcn_s_sleep(1); \
    if ((++_sp & 255u) == 0u) { if (xb_ld(&(bar)[XB_TMO])) break; if (_sp > XB_SPIN_CAP) { atomicAdd(&(bar)[XB_TMO], 1u); break; } } } } while (0)

struct XcdBarrier {
    unsigned* bar; unsigned x;
    volatile LAS unsigned* st;
};

__device__ __forceinline__ XcdBarrier xcd_barrier_post(unsigned* bar, volatile LAS unsigned* st) {
    XcdBarrier b; b.bar = bar; b.x = xb_xcc_id(); b.st = st;
    if (threadIdx.x == 0) (void)xb_add(&bar[XB_XCNT(b.x)], 1u);
    return b;
}
__device__ __forceinline__ void xcd_barrier_complete(unsigned* bar, unsigned x, unsigned& nloc, unsigned& nx) {
    const unsigned G = gridDim.x * gridDim.y * gridDim.z;
    unsigned sum, cnt, mine, sp = 0u;
    for (;;) {
        sum = 0u; cnt = 0u; mine = 0u;
#pragma unroll
        for (unsigned j = 0; j < 16; ++j) { const unsigned c = xb_ld(&bar[XB_XCNT(j)]); sum += c; cnt += (c > 0u) ? 1u : 0u; mine = (j == x) ? c : mine; }
        if (sum == G) break;
        __builtin_amdgcn_s_sleep(1);
        if ((++sp & 255u) == 0u) { if (xb_ld(&bar[XB_TMO])) break; if (sp > XB_SPIN_CAP) { atomicAdd(&bar[XB_TMO], 1u); break; } }
    }
    nloc = mine > 0u ? mine : 1u; nx = cnt > 0u ? cnt : 1u;
}

__device__ __forceinline__ void xcd_barrier(const XcdBarrier& b) {
    asm volatile("s_waitcnt vmcnt(0)" ::: "memory");
    __syncthreads();
    if (threadIdx.x == 0) {
        unsigned* bar = b.bar;
        __builtin_amdgcn_s_waitcnt(0);
        unsigned nloc = b.st[0], nx = b.st[1];
        if (nloc == 0u) { xcd_barrier_complete(bar, b.x, nloc, nx); b.st[0] = nloc; b.st[1] = nx; }
        const unsigned old = xb_add(&bar[XB_XSUB(b.x)], 1u);
        const unsigned gen = old / nloc;
        if (old + 1u == (gen + 1u) * nloc) {
            __builtin_amdgcn_fence(__ATOMIC_RELEASE, "agent");
            asm volatile("s_waitcnt vmcnt(0)" ::: "memory");
            const unsigned og = xb_add(&bar[XB_TOP], 1u);
            const unsigned tg = og / nx;
            if (og + 1u == (tg + 1u) * nx) xb_add(&bar[XB_TOPGEN], 1u);
            else XB_SPIN(xb_ld(&bar[XB_TOPGEN]) == tg, bar);
            __builtin_amdgcn_fence(__ATOMIC_ACQUIRE, "agent");
            xb_add(&bar[XB_XGEN(b.x)], 1u);
            asm volatile("s_waitcnt vmcnt(0)" ::: "memory");
        } else {
            XB_SPIN(xb_ld(&bar[XB_XGEN(b.x)]) == gen, bar);
            __builtin_amdgcn_fence(__ATOMIC_ACQUIRE, "agent");
            asm volatile("s_waitcnt vmcnt(0)" ::: "memory");
        }
    }
    __syncthreads();
}

#define GEMM_RUN(EPI, Aptr, Bptr, Mv, Nv, Kv, Eobj) GEMM_RUN2(EPI, Aptr, Bptr, Mv, Nv, Kv, Eobj, true, true)
#define GEMM_RUN2(EPI, Aptr, Bptr, Mv, Nv, Kv, Eobj, ALIGNV, SP2V) do { pg8::Gemm g_{(const pg8::bf16_t*)(Aptr), (const pg8::bf16_t*)(Bptr), (Mv), (Nv), (Kv)}; pg8::StaticOrder S_; S_.init((Mv), (Nv), (int)gridDim.x, (int)blockIdx.x); \
    pg8::gemm_phase<EPI, pg8::StaticOrder, ALIGNV, SP2V>(lds, g_, S_, Eobj); } while (0)

__global__ void __launch_bounds__(NTHREADS, 2) mk_fwd(Args a) {
    __shared__ __attribute__((aligned(16))) unsigned char lds_raw[LDS_BYTES];
    LAS unsigned char* lds = (LAS unsigned char*)lds_raw;
    cg::grid_group grid = cg::this_grid();
#define FRESH int tid = threadIdx.x; asm volatile("" : "+v"(tid)); const int lane = tid & 63, wave = __builtin_amdgcn_readfirstlane(tid >> 6); const int G = gridDim.x, gw = blockIdx.x * NWAVES + wave, NGW = G * NWAVES; (void)lane; (void)gw; (void)NGW; (void)G
    unsigned* ctl = (unsigned*)(a.ws + WS_CTL);
    unsigned* barw = ctl + 4096;
    volatile LAS unsigned* bst = (volatile LAS unsigned*)(lds + LDS_MISC + 64);
    if (threadIdx.x < 2) bst[threadIdx.x] = 0u;
    __syncthreads();
    if (a.out == nullptr) grid.sync();
    const XcdBarrier xbar = xcd_barrier_post(barw, bst);
#define GSYNC() xcd_barrier(xbar)
    bf16* H = (bf16*)(a.ws + WS_H); bf16* QKV = (bf16*)(a.ws + WS_QKV); bf16* MIX = (bf16*)(a.ws + WS_MIX); bf16* UV = (bf16*)(a.ws + WS_UV); bf16* ACT = (bf16*)(a.ws + WS_ACT); bf16* XB = (bf16*)(a.ws + WS_XB); float* RSTD = (float*)(a.ws + WS_CTL + 65536);
    float* FF = (float*)(a.ws + WS_FF); float* CUM = (float*)(a.ws + WS_CUM);
    { FRESH; phase_weights(a, lds, gw, NGW, wave, lane); }
    for (int l = 0; l < DEPTH; ++l) {
        if (l == 0) { FRESH; phase_norm<1, false>(a.in[0], a.in[1] + (size_t)l * DM, XB, RSTD, a.in[2] + (size_t)l * DM * NIN_SRC, a.in[3] + l * 4, FF, lds, gw, NGW, tid, lane); }
        else { FRESH; phase_norm<1, true>(XB, a.in[1] + (size_t)l * DM, nullptr, RSTD, a.in[2] + (size_t)l * DM * NIN_SRC, a.in[3] + l * 4, FF, lds, gw, NGW, tid, lane); }
        GSYNC();
        { FRESH; if (blockIdx.x < 64 && wave == 0) cumsum_seq(FF, CUM, blockIdx.x, lane); }
        { pg8::EpiBf16S E{(pg8::bf16_t*)QKV, NQKV, RSTD}; GEMM_RUN(pg8::EpiBf16S, XB, a.ws + WS_WIN + l * SZ_WIN, MTOK, NQKV, DM, E); }
        GSYNC();
        { FRESH; phase_attn(a, l, ctl + 64 * l, lds, tid, wave, lane); }
        GSYNC();
        { pg8::EpiResBS<false> E{XB, (pg8::bf16_t*)XB, DM, (float*)H}; GEMM_RUN(pg8::EpiResBS<false>, MIX, a.ws + WS_WOUT + l * SZ_WOUT, MTOK, DM, MIXW, E); }
        GSYNC();
        { FRESH; if (blockIdx.x < MTOK / NTHREADS) { const int row = blockIdx.x * NTHREADS + tid; const f32x4* p = (const f32x4*)((const float*)H + (size_t)row * 16);
            const f32x4 s4 = (p[0] + p[1]) + (p[2] + p[3]); RSTD[row] = 1.0f / sqrtf(((s4[0] + s4[1]) + (s4[2] + s4[3])) * (1.f / DM) + RMS_EPS); } }
        GSYNC();
        { pg8::EpiConv E{(pg8::bf16_t*)ACT, (pg8::bf16_t*)UV, a.in[10] + (size_t)l * 3 * NFF2, a.in[11] + (size_t)l * NFF2, RSTD}; GEMM_RUN(pg8::EpiConv, XB, a.ws + WS_WFI + l * SZ_WFI, MTOK, NFF2, DM, E); }
        GSYNC();
        { FRESH; phase_fixup(UV, ACT, a.in[10] + (size_t)l * 3 * NFF2, a.in[11] + (size_t)l * NFF2, blockIdx.x * NTHREADS + tid, G * NTHREADS); }
        GSYNC();
        { pg8::EpiResB<false> E{XB, (pg8::bf16_t*)XB, DM}; GEMM_RUN(pg8::EpiResB<false>, ACT, a.ws + WS_WFO + l * SZ_WFO, MTOK, DM, DFF, E); }
        GSYNC();
    }
    { FRESH; phase_norm<2, true>(XB, a.in[13], nullptr, a.out, nullptr, nullptr, nullptr, lds, gw, NGW, tid, lane); }
}

extern "C" void kernel_launch(void* const* d_in, const int* in_sizes, int n_in, void* d_out, int out_size, void* d_ws, size_t ws_size, hipStream_t stream) {
    static int grid_blocks = 0;
    if (grid_blocks == 0) {
        if (n_in != 14 || out_size != MTOK * DM || ws_size < WS_END || in_sizes[2] != DEPTH * DM * NIN_SRC || in_sizes[7] != DEPTH * MIXW * DM || in_sizes[9] != DEPTH * DM * NFF2 || in_sizes[12] != DEPTH * DFF * DM || in_sizes[6] != DEPTH * 4 * 192 || in_sizes[5] != DEPTH * 128) { fprintf(stderr, "kernel_launch: unexpected sizes n_in %d out %d ws %zu\n", n_in, out_size, ws_size); grid_blocks = -1; return; }
        int dev = 0, cus = 0, per_cu = 0;
        (void)hipGetDevice(&dev);
        (void)hipDeviceGetAttribute(&cus, hipDeviceAttributeMultiprocessorCount, dev);
        (void)hipOccupancyMaxActiveBlocksPerMultiprocessor(&per_cu, (const void*)mk_fwd, NTHREADS, 0);
        if (per_cu < 1) { fprintf(stderr, "kernel_launch: occupancy query says %d blocks/CU\n", per_cu); per_cu = 1; }
        (void)hipGetLastError();
        grid_blocks = cus * 1;
        fprintf(stderr, "kernel_launch: cus %d per_cu %d grid %d\n", cus, per_cu, grid_blocks);
    }
    if (grid_blocks < 0) return;
    if (hipMemsetAsync((char*)d_ws + WS_CTL, 0, 65536, stream) != hipSuccess) { fprintf(stderr, "kernel_launch: memset of control words failed\n"); return; }
    Args a{};
    for (int i = 0; i < 14; ++i) a.in[i] = (const float*)d_in[i];
    a.out = (float*)d_out; a.ws = (unsigned char*)d_ws;
    void* args[] = {&a};
    hipError_t e = hipLaunchCooperativeKernel((const void*)mk_fwd, dim3(grid_blocks), dim3(NTHREADS), args, 0, stream);
    if (e != hipSuccess) fprintf(stderr, "cooperative launch failed: %s (grid %d)\n", hipGetErrorString(e), grid_blocks);
}
```

```cpp
#include <hip/hip_runtime.h>
#include <cstdio>
#include <cstdint>
#include <hip/hip_cooperative_groups.h>
namespace cg = cooperative_groups;
namespace pg8 {
#define PG8_LAS __attribute__((address_space(3)))
typedef unsigned short bf16_t;
typedef short bf16x8 __attribute__((ext_vector_type(8)));
typedef float f32x4 __attribute__((ext_vector_type(4)));
typedef unsigned u32x4 __attribute__((ext_vector_type(4)));
constexpr int BM = 256, BK = 64, HALF = 128, HTB = HALF * BK * 2  , STAGE_BYTES = 8 * HTB, NXCD = 8, WGM = 8;

__host__ __device__ __forceinline__ int lds_byte(int r, int c) { const int st = (r >> 4) * 2 + (c >> 5), rr = r & 15, cc = c & 31, ob = rr * 64 + cc * 2; return st * 1024 + (ob ^ (((ob >> 9) & 1) << 5)); }
__host__ __device__ __forceinline__ void stage_rc(int b, int& R, int& C) { const int st = b / 1024, sb = b % 1024, swz = sb ^ (((sb >> 9) & 1) << 5); R = (st >> 1) * 16 + swz / 64; C = (st & 1) * 32 + (swz % 64) / 2; }
__host__ __device__ __forceinline__ int perm32(int rho) { const int n = rho >> 4, i = rho & 15; return 8 * (i >> 2) + 4 * n + (i & 3); }

struct Unit { int pm, pn; };
struct Gemm { const bf16_t* A; const bf16_t* Bt; int M, N, K; };

struct StaticOrder {
    int nM, nN, nwg, G, c;
    __host__ __device__ void init(int M, int N, int G_, int c_) { nM = M / BM; nN = N / BM; nwg = nM * nN; G = G_; c = c_; }
    __host__ __device__ bool next(int i, Unit& u) const {
        const long L = (long)i * G + c; if (L >= nwg) return false;
        int wgid = (int)L; { const int q = nwg / NXCD, r = nwg % NXCD, xcd = wgid % NXCD, off = wgid / NXCD; wgid = (xcd < r ? xcd * (q + 1) : r * (q + 1) + (xcd - r) * q) + off; }
        const int nig = WGM * nN, gid = wgid / nig, fm = gid * WGM, gsz = (nM - fm) < WGM ? (nM - fm) : WGM;
        u.pm = fm + ((wgid % nig) % gsz); u.pn = (wgid % nig) / gsz; return true;
    }
    __device__ __forceinline__ void a_ready(const Unit&) const {}
    __device__ __forceinline__ void done(const Unit&) const {}
};

typedef float f32x2c __attribute__((ext_vector_type(2))); typedef __bf16 bf16x2c __attribute__((ext_vector_type(2)));
__device__ __forceinline__ unsigned cvt_pk_bf16(float lo, float hi) { f32x2c v = {lo, hi}; bf16x2c b = __builtin_convertvector(v, bf16x2c); return __builtin_bit_cast(unsigned, b); }
typedef float f32x2 __attribute__((ext_vector_type(2)));
struct EpiBf16 {
    static constexpr bool PERM = true, AFTER_DRAIN = false, APERM = false;
    bf16_t* O; int ldc;
    __device__ __forceinline__ void operator()(const f32x4 (&acc)[2][2][4][2], const Unit& u, int wr, int wc, int fr, int fq) const {
        const int row0 = u.pm * BM + wr * 64 + fr; const int col0 = u.pn * BM + wc * 32 + 8 * fq;
#pragma unroll
        for (int ai = 0; ai < 2; ++ai)
#pragma unroll
            for (int m = 0; m < 4; ++m) { bf16_t* rowp = O + (size_t)(row0 + ai * HALF + m * 16) * ldc + col0;
#pragma unroll
                for (int bj = 0; bj < 2; ++bj) { const f32x4 v0 = acc[ai][bj][m][0], v1 = acc[ai][bj][m][1];
                    u32x4 w; w.x = cvt_pk_bf16(v0[0], v0[1]); w.y = cvt_pk_bf16(v0[2], v0[3]); w.z = cvt_pk_bf16(v1[0], v1[1]); w.w = cvt_pk_bf16(v1[2], v1[3]);
                    *(u32x4*)(rowp + bj * HALF) = w; } }
    }
};
struct EpiRes {
    static constexpr bool PERM = false, AFTER_DRAIN = false, APERM = false;
    const float* base; float* out; int ldc; float scale;
    __device__ __forceinline__ void operator()(const f32x4 (&acc)[2][2][4][2], const Unit& u, int wr, int wc, int fr, int fq) const {
        const int col0 = u.pn * BM + wc * 32 + 4 * fq;
#pragma unroll
        for (int ai = 0; ai < 2; ++ai)
#pragma unroll
            for (int m = 0; m < 4; ++m) { const size_t off = (size_t)(u.pm * BM + ai * HALF + wr * 64 + m * 16 + fr) * ldc + col0;
#pragma unroll
                for (int bj = 0; bj < 2; ++bj)
#pragma unroll
                    for (int n = 0; n < 2; ++n) { const f32x4 bs = *(const f32x4*)(base + off + bj * HALF + n * 16); *(f32x4*)(out + off + bj * HALF + n * 16) = bs + acc[ai][bj][m][n] * scale; } }
    }
};

__device__ __forceinline__ f32x4 dpp_shr1(f32x4 v) { f32x4 r;
#pragma unroll
    for (int i = 0; i < 4; ++i) r[i] = __shfl_up(v[i], 1, 16);
    return r; }
__device__ __forceinline__ f32x4 silu_mul(f32x4 yu, f32x4 yg) { f32x4 o;
#pragma unroll
    for (int i = 0; i < 4; ++i) o[i] = yu[i] * yg[i] * __builtin_amdgcn_rcpf(1.0f + __builtin_amdgcn_exp2f(-1.4426950408889634f * yg[i]));
    return o; }
struct EpiConv {
    static constexpr bool PERM = false, AFTER_DRAIN = false, APERM = true;
    bf16_t* act; bf16_t* halo; const float* cw; const float* cb; const float* rstd;
    typedef unsigned u32x2e __attribute__((ext_vector_type(2)));
    __device__ __forceinline__ void conv4(f32x4 (&y)[4], const f32x4 (&a4)[4][2], int n, const f32x4 rs, const f32x4 w0, const f32x4 w1, const f32x4 w2, const f32x4 b, int col, int fr, bf16_t* hp) const {
        constexpr int N2 = 5632;
        const f32x4 X0 = a4[0][n] * rs[0], X1 = a4[1][n] * rs[1], X2 = a4[2][n] * rs[2], X3 = a4[3][n] * rs[3];
        const f32x4 Xm1 = dpp_shr1(X3), Xm2 = dpp_shr1(X2);
        y[0] = b + w0 * Xm2 + w1 * Xm1 + w2 * X0;
        y[1] = b + w0 * Xm1 + w1 * X0 + w2 * X1;
        y[2] = b + w0 * X0 + w1 * X1 + w2 * X2;
        y[3] = b + w0 * X1 + w1 * X2 + w2 * X3;
        if (fr == 0 || fr == 15) { const f32x4 xa = fr == 0 ? X0 : X2, xb = fr == 0 ? X1 : X3;
            u32x2e w; w.x = cvt_pk_bf16(xa[0], xa[1]); w.y = cvt_pk_bf16(xa[2], xa[3]); *(u32x2e*)(hp + col) = w;
            w.x = cvt_pk_bf16(xb[0], xb[1]); w.y = cvt_pk_bf16(xb[2], xb[3]); *(u32x2e*)(hp + N2 + col) = w; }
    }
    __device__ __forceinline__ void operator()(const f32x4 (&acc)[2][2][4][2], const Unit& u, int wr, int wc, int fr, int fq) const {
        constexpr int DFFc = 2816, N2 = 5632;
#pragma unroll
        for (int n = 0; n < 2; ++n) {
            const int cu = u.pn * 128 + wc * 32 + n * 16 + 4 * fq, cg = DFFc + cu;
            const f32x4 w0u = *(const f32x4*)(cw + cu), w1u = *(const f32x4*)(cw + N2 + cu), w2u = *(const f32x4*)(cw + 2 * N2 + cu), bu = *(const f32x4*)(cb + cu);
            const f32x4 w0g = *(const f32x4*)(cw + cg), w1g = *(const f32x4*)(cw + N2 + cg), w2g = *(const f32x4*)(cw + 2 * N2 + cg), bg = *(const f32x4*)(cb + cg);
#pragma unroll
            for (int ai = 0; ai < 2; ++ai) {
                const int row0 = u.pm * BM + ai * HALF + wr * 64 + 4 * fr;
                const f32x4 rs = *(const f32x4*)(rstd + row0);
                bf16_t* hp = halo + ((size_t)(row0 >> 6) * 4 + (fr == 0 ? 0 : 2)) * N2;
                f32x4 yu[4], yg[4];
                conv4(yu, acc[ai][0], n, rs, w0u, w1u, w2u, bu, cu, fr, hp);
                conv4(yg, acc[ai][1], n, rs, w0g, w1g, w2g, bg, cg, fr, hp);
#pragma unroll
                for (int m = 0; m < 4; ++m) if (fr != 0 || m >= 2) { const f32x4 o = silu_mul(yu[m], yg[m]); u32x2e w; w.x = cvt_pk_bf16(o[0], o[1]); w.y = cvt_pk_bf16(o[2], o[3]);
                    *(u32x2e*)(act + (size_t)(row0 + m) * DFFc + cu) = w; }
            }
        }
    }
};

template <bool BASE_F32> struct EpiResB {
    static constexpr bool PERM = true, AFTER_DRAIN = false, APERM = false;
    const void* base; bf16_t* out; int ldc;
    __device__ __forceinline__ void operator()(const f32x4 (&acc)[2][2][4][2], const Unit& u, int wr, int wc, int fr, int fq) const {
        const int col0 = u.pn * BM + wc * 32 + 8 * fq;
#pragma unroll
        for (int ai = 0; ai < 2; ++ai)
#pragma unroll
            for (int m = 0; m < 4; ++m) { const size_t off = (size_t)(u.pm * BM + ai * HALF + wr * 64 + m * 16 + fr) * ldc + col0;
#pragma unroll
                for (int bj = 0; bj < 2; ++bj) { f32x4 b0, b1;
                    if (BASE_F32) { b0 = *(const f32x4*)((const float*)base + off + bj * HALF); b1 = *(const f32x4*)((const float*)base + off + bj * HALF + 4); }
                    else { const u32x4 r = *(const u32x4*)((const bf16_t*)base + off + bj * HALF);
                        b0[0] = __uint_as_float(r.x << 16); b0[1] = __uint_as_float(r.x & 0xffff0000u); b0[2] = __uint_as_float(r.y << 16); b0[3] = __uint_as_float(r.y & 0xffff0000u);
                        b1[0] = __uint_as_float(r.z << 16); b1[1] = __uint_as_float(r.z & 0xffff0000u); b1[2] = __uint_as_float(r.w << 16); b1[3] = __uint_as_float(r.w & 0xffff0000u); }
                    const f32x4 o0 = b0 + acc[ai][bj][m][0], o1 = b1 + acc[ai][bj][m][1];
                    u32x4 w; w.x = cvt_pk_bf16(o0[0], o0[1]); w.y = cvt_pk_bf16(o0[2], o0[3]); w.z = cvt_pk_bf16(o1[0], o1[1]); w.w = cvt_pk_bf16(o1[2], o1[3]);
                    *(u32x4*)(out + off + bj * HALF) = w; } }
    }
};

struct EpiBf16S {
    static constexpr bool PERM = true, AFTER_DRAIN = false, APERM = false;
    bf16_t* O; int ldc; const float* rs;
    __device__ __forceinline__ void operator()(const f32x4 (&acc)[2][2][4][2], const Unit& u, int wr, int wc, int fr, int fq) const {
        const int row0 = u.pm * BM + wr * 64 + fr; const int col0 = u.pn * BM + wc * 32 + 8 * fq;
#pragma unroll
        for (int ai = 0; ai < 2; ++ai)
#pragma unroll
            for (int m = 0; m < 4; ++m) { const int row = row0 + ai * HALF + m * 16; const float s = rs[row]; bf16_t* rowp = O + (size_t)row * ldc + col0;
#pragma unroll
                for (int bj = 0; bj < 2; ++bj) { const f32x4 v0 = acc[ai][bj][m][0] * s, v1 = acc[ai][bj][m][1] * s;
                    u32x4 w; w.x = cvt_pk_bf16(v0[0], v0[1]); w.y = cvt_pk_bf16(v0[2], v0[3]); w.z = cvt_pk_bf16(v1[0], v1[1]); w.w = cvt_pk_bf16(v1[2], v1[3]);
                    *(u32x4*)(rowp + bj * HALF) = w; } }
    }
};

template <bool BASE_F32> struct EpiResBS {
    static constexpr bool PERM = true, AFTER_DRAIN = false, APERM = false;
    const void* base; bf16_t* out; int ldc; float* part;
    __device__ __forceinline__ void operator()(const f32x4 (&acc)[2][2][4][2], const Unit& u, int wr, int wc, int fr, int fq) const {
        const int col0 = u.pn * BM + wc * 32 + 8 * fq;
#pragma unroll
        for (int ai = 0; ai < 2; ++ai)
#pragma unroll
            for (int m = 0; m < 4; ++m) { const int row = u.pm * BM + ai * HALF + wr * 64 + m * 16 + fr; const size_t off = (size_t)row * ldc + col0; float ss = 0.f;
#pragma unroll
                for (int bj = 0; bj < 2; ++bj) { f32x4 b0, b1;
                    if (BASE_F32) { b0 = *(const f32x4*)((const float*)base + off + bj * HALF); b1 = *(const f32x4*)((const float*)base + off + bj * HALF + 4); }
                    else { const u32x4 r = *(const u32x4*)((const bf16_t*)base + off + bj * HALF);
                        b0[0] = __uint_as_float(r.x << 16); b0[1] = __uint_as_float(r.x & 0xffff0000u); b0[2] = __uint_as_float(r.y << 16); b0[3] = __uint_as_float(r.y & 0xffff0000u);
                        b1[0] = __uint_as_float(r.z << 16); b1[1] = __uint_as_float(r.z & 0xffff0000u); b1[2] = __uint_as_float(r.w << 16); b1[3] = __uint_as_float(r.w & 0xffff0000u); }
                    const f32x4 o0 = b0 + acc[ai][bj][m][0], o1 = b1 + acc[ai][bj][m][1];
                    ss += (o0[0] * o0[0] + o0[1] * o0[1]) + (o0[2] * o0[2] + o0[3] * o0[3]) + (o1[0] * o1[0] + o1[1] * o1[1]) + (o1[2] * o1[2] + o1[3] * o1[3]);
                    u32x4 w; w.x = cvt_pk_bf16(o0[0], o0[1]); w.y = cvt_pk_bf16(o0[2], o0[3]); w.z = cvt_pk_bf16(o1[0], o1[1]); w.w = cvt_pk_bf16(o1[2], o1[3]);
                    *(u32x4*)(out + off + bj * HALF) = w; }
                ss += __shfl_xor(ss, 16); ss += __shfl_xor(ss, 32);
                if (fq == 0) part[(size_t)row * 16 + u.pn * 4 + wc] = ss; }
    }
};
template <class Epi, class Sched, bool ALIGN_EPI = false, bool SP2 = false>
__device__ __forceinline__ void gemm_phase(PG8_LAS unsigned char* lds, const Gemm g, const Sched& S, const Epi& E) {
    int tid_l = threadIdx.x; asm volatile("" : "+v"(tid_l)); const int tid = tid_l, wid = __builtin_amdgcn_readfirstlane(tid >> 6), lane = tid & 63, wr = wid >> 2, wc = wid & 3, fr = lane & 15, fq = lane >> 4;
    const int K = g.K, nt = K / BK;
    unsigned voffA[2], voffB[2];
#pragma unroll
    for (int i = 0; i < 2; ++i) { int R, C; stage_rc(tid * 16 + i * 8192, R, C); const int Rb = Epi::PERM ? ((R & ~31) + perm32(R & 31)) : R;
        const int Ra = Epi::APERM ? ((R & 64) + (R & 15) * 4 + ((R >> 4) & 3)) : R; voffA[i] = (unsigned)(Ra * K + C) * 2u; voffB[i] = (unsigned)(Rb * K + C) * 2u; }
    const size_t kstep = (size_t)(BK * 2);
    const size_t hstep = (size_t)HALF * K * 2;
    const size_t tstep = 2 * hstep;
    const unsigned ldsw = (unsigned)wid * 1024u;
    const int aoff = lds_byte(wr * 64 + fr, fq * 8), boff = lds_byte(wc * 32 + fr, fq * 8);
#define PG8_SA(b, h) (((b) * 2 + (h)) * HTB)
#define PG8_SB(b, h) ((4 + (b) * 2 + (h)) * HTB)
#define PG8_STAGE(bufoff, gbase, voff) do { _Pragma("unroll") for (int _i = 0; _i < 2; ++_i) \
        __builtin_amdgcn_global_load_lds((const unsigned*)((const char*)(gbase) + (voff)[_i]), (PG8_LAS unsigned*)(lds + (bufoff) + ldsw + _i * 8192), 16, 0, 0); } while (0)
#define PG8_LDA(dst, b, h) do { _Pragma("unroll") for (int m = 0; m < 4; ++m) _Pragma("unroll") for (int k = 0; k < 2; ++k) dst[m][k] = *(const PG8_LAS bf16x8*)(lds + PG8_SA(b, h) + aoff + m * 2048 + k * 1024); } while (0)
#define PG8_LDB(dst, b, h) do { _Pragma("unroll") for (int n = 0; n < 2; ++n) _Pragma("unroll") for (int k = 0; k < 2; ++k) dst[n][k] = *(const PG8_LAS bf16x8*)(lds + PG8_SB(b, h) + boff + n * 2048 + k * 1024); } while (0)
#define PG8_MMA(ai, bj, At, Bt) do { __builtin_amdgcn_s_setprio(1); _Pragma("unroll") for (int m = 0; m < 4; ++m) _Pragma("unroll") for (int n = 0; n < 2; ++n) _Pragma("unroll") for (int k = 0; k < 2; ++k) \
        acc[ai][bj][m][n] = __builtin_amdgcn_mfma_f32_16x16x32_bf16(Bt[n][k], At[m][k], acc[ai][bj][m][n], 0, 0, 0); __builtin_amdgcn_s_setprio(0); } while (0)
#define PG8_WAIT_V(n) asm volatile("s_waitcnt vmcnt(" #n ")" ::: "memory")
#define PG8_WAIT_L(n) asm volatile("s_waitcnt lgkmcnt(" #n ")" ::: "memory")
#define PG8_BAR __builtin_amdgcn_s_barrier()
#define PG8_SCHED __builtin_amdgcn_sched_barrier(0)
    Unit cur, nxt; int ui = 0;
    if (!S.next(0, cur)) return;
    f32x4 acc[2][2][4][2];
#pragma unroll
    for (int a = 0; a < 2; ++a)
#pragma unroll
        for (int b = 0; b < 2; ++b)
#pragma unroll
            for (int m = 0; m < 4; ++m)
#pragma unroll
                for (int n = 0; n < 2; ++n) acc[a][b][m][n] = (f32x4){0.f, 0.f, 0.f, 0.f};
    bf16x8 At[4][2], B0[2][2], B1[2][2];
    const char* cA = (const char*)g.A + (size_t)cur.pm * tstep; const char* cB = (const char*)g.Bt + (size_t)cur.pn * tstep;
    S.a_ready(cur);
    if constexpr (SP2) {
        PG8_STAGE(PG8_SB(0, 0), cB, voffB); PG8_STAGE(PG8_SB(0, 1), cB + hstep, voffB); PG8_STAGE(PG8_SA(0, 0), cA, voffA); PG8_STAGE(PG8_SA(0, 1), cA + hstep, voffA);
        if (wr == 1) PG8_BAR;
        PG8_WAIT_V(2); PG8_BAR;
        PG8_STAGE(PG8_SB(1, 0), cB + kstep, voffB); PG8_STAGE(PG8_SA(1, 0), cA + kstep, voffA); PG8_STAGE(PG8_SB(1, 1), cB + hstep + kstep, voffB);
        PG8_WAIT_V(6); PG8_BAR;
    } else {
        PG8_STAGE(PG8_SB(0, 0), cB, voffB); PG8_STAGE(PG8_SA(0, 0), cA, voffA); PG8_STAGE(PG8_SB(0, 1), cB + hstep, voffB); PG8_STAGE(PG8_SA(0, 1), cA + hstep, voffA);
        if (wr == 1) PG8_BAR;
        PG8_WAIT_V(4); PG8_BAR;
        PG8_STAGE(PG8_SB(1, 0), cB + kstep, voffB); PG8_STAGE(PG8_SA(1, 0), cA + kstep, voffA); PG8_STAGE(PG8_SB(1, 1), cB + hstep + kstep, voffB);
        PG8_WAIT_V(6); PG8_BAR;
    }
    for (;;) {
        const bool has_next = S.next(ui + 1, nxt);
        const char* nA = has_next ? (const char*)g.A + (size_t)nxt.pm * tstep : cA; const char* nB = has_next ? (const char*)g.Bt + (size_t)nxt.pn * tstep : cB;
        for (int t = 0; t < nt; t += 2) {
            const bool last = (t == nt - 2);
            const char* a1 = cA + (size_t)(t + 1) * kstep;
            const char* a2 = last ? nA : cA + (size_t)(t + 2) * kstep; const char* b2 = last ? nB : cB + (size_t)(t + 2) * kstep;
            const char* a3 = a2 + kstep; const char* b3 = b2 + kstep;
            if (last && has_next) S.a_ready(nxt);
            if constexpr (SP2) {
            PG8_LDB(B0, 0, 0); PG8_LDB(B1, 0, 1); PG8_SCHED; PG8_LDA(At, 0, 0); PG8_STAGE(PG8_SA(1, 1), a1 + hstep, voffA);
            PG8_WAIT_V(8); PG8_WAIT_L(0); PG8_BAR; PG8_MMA(0, 0, At, B0); PG8_MMA(0, 1, At, B1); PG8_BAR; PG8_SCHED;
            PG8_LDA(At, 0, 1); PG8_STAGE(PG8_SB(0, 0), b2, voffB); PG8_STAGE(PG8_SB(0, 1), b2 + hstep, voffB); PG8_STAGE(PG8_SA(0, 0), a2, voffA);
            PG8_WAIT_V(8); PG8_WAIT_L(0); PG8_BAR; PG8_MMA(1, 0, At, B0); PG8_MMA(1, 1, At, B1); PG8_BAR; PG8_SCHED;
            PG8_LDB(B0, 1, 0); PG8_LDB(B1, 1, 1); PG8_SCHED; PG8_LDA(At, 1, 0); PG8_STAGE(PG8_SA(0, 1), a2 + hstep, voffA);
            PG8_WAIT_V(8); PG8_WAIT_L(0); PG8_BAR; PG8_MMA(0, 0, At, B0); PG8_MMA(0, 1, At, B1); PG8_BAR; PG8_SCHED;
            PG8_LDA(At, 1, 1); PG8_STAGE(PG8_SB(1, 0), b3, voffB); PG8_STAGE(PG8_SB(1, 1), b3 + hstep, voffB); PG8_STAGE(PG8_SA(1, 0), a3, voffA);
            PG8_WAIT_V(8); PG8_WAIT_L(0); PG8_BAR; PG8_MMA(1, 0, At, B0); PG8_MMA(1, 1, At, B1); PG8_BAR; PG8_SCHED;
            } else {
            PG8_LDB(B0, 0, 0); PG8_SCHED; PG8_LDA(At, 0, 0); PG8_STAGE(PG8_SA(1, 1), a1 + hstep, voffA);
            PG8_WAIT_L(8); PG8_BAR; PG8_WAIT_L(0); PG8_MMA(0, 0, At, B0); PG8_BAR; PG8_SCHED;
            PG8_LDB(B1, 0, 1); PG8_STAGE(PG8_SB(0, 0), b2, voffB);
            PG8_BAR; PG8_WAIT_L(0); PG8_MMA(0, 1, At, B1); PG8_BAR;
            PG8_LDA(At, 0, 1); PG8_STAGE(PG8_SA(0, 0), a2, voffA);
            PG8_BAR; PG8_WAIT_L(0); PG8_MMA(1, 0, At, B0); PG8_BAR; PG8_SCHED;
            PG8_STAGE(PG8_SB(0, 1), b2 + hstep, voffB);
            PG8_WAIT_V(6); PG8_BAR; PG8_MMA(1, 1, At, B1); PG8_BAR;
            PG8_LDB(B0, 1, 0); PG8_SCHED; PG8_LDA(At, 1, 0); PG8_STAGE(PG8_SA(0, 1), a2 + hstep, voffA);
            PG8_WAIT_L(8); PG8_BAR; PG8_WAIT_L(0); PG8_MMA(0, 0, At, B0); PG8_BAR; PG8_SCHED;
            PG8_LDB(B1, 1, 1); PG8_STAGE(PG8_SB(1, 0), b3, voffB);
            PG8_BAR; PG8_WAIT_L(0); PG8_MMA(0, 1, At, B1); PG8_BAR;
            PG8_LDA(At, 1, 1); PG8_STAGE(PG8_SA(1, 0), a3, voffA);
            PG8_BAR; PG8_WAIT_L(0); PG8_MMA(1, 0, At, B0); PG8_BAR; PG8_SCHED;
            PG8_STAGE(PG8_SB(1, 1), b3 + hstep, voffB);
            PG8_WAIT_V(6); PG8_BAR; PG8_MMA(1, 1, At, B1); PG8_BAR;
            }
        }
        if constexpr (ALIGN_EPI) { if (wr == 0) PG8_BAR; }
        if constexpr (!Epi::AFTER_DRAIN) { E(acc, cur, wr, wc, fr, fq); S.done(cur); }
        if (!has_next) break;
#pragma unroll
        for (int a = 0; a < 2; ++a)
#pragma unroll
            for (int b = 0; b < 2; ++b)
#pragma unroll
                for (int m = 0; m < 4; ++m)
#pragma unroll
                    for (int n = 0; n < 2; ++n) acc[a][b][m][n] = (f32x4){0.f, 0.f, 0.f, 0.f};
        cur = nxt; cA = nA; cB = nB; ++ui;
        if constexpr (ALIGN_EPI) { if (wr == 1) PG8_BAR; }
    }
    PG8_WAIT_V(0);
    if constexpr (!ALIGN_EPI) { if (wr == 0) PG8_BAR; }
    PG8_BAR;
    if constexpr (Epi::AFTER_DRAIN) { E.fused(acc, cur, wr, wc, fr, fq, lds, wid, lane); S.done(cur); }
#undef PG8_SA
#undef PG8_SB
#undef PG8_STAGE
#undef PG8_LDA
#undef PG8_LDB
#undef PG8_MMA
#undef PG8_WAIT_V
#undef PG8_WAIT_L
#undef PG8_BAR
#undef PG8_SCHED
}
}
#define LAS __attribute__((address_space(3)))
typedef unsigned short bf16;
typedef short bf16x8 __attribute__((ext_vector_type(8)));
typedef short s16x4 __attribute__((ext_vector_type(4)));
typedef float f32x16 __attribute__((ext_vector_type(16)));
typedef float f32x4 __attribute__((ext_vector_type(4)));
typedef unsigned u32x4 __attribute__((ext_vector_type(4)));
typedef unsigned u32x2 __attribute__((ext_vector_type(2)));

constexpr int DM = 1024, BATCH = 16, SEQ = 2048, MTOK = BATCH * SEQ, DEPTH = 2;
constexpr int NIN_SRC = 2308, NQKV = 2304, MIXW = 768, DFF = 2816, NFF2 = 5632;
constexpr float RMS_EPS = 1e-6f, L2E = 1.4426950408889634f, QSCALE = 0.125f * 1.4426950408889634f;
constexpr int C_FQ = 0, C_FK = 256, C_FV = 512, C_DQ = 768, C_DK = 1024, C_DV = 1280, C_CQ = 1536, C_CK = 1792, C_CV = 2048;
constexpr int MX_FOX = 0, MX_DIFF = 256, MX_CHK = 512;
constexpr int NTHREADS = 512, NWAVES = 8;
constexpr size_t MiB = 1u << 20;
constexpr size_t WS_CTL = 0, WS_FF = 1 * MiB, WS_CUM = 1 * MiB + 512 * 1024;
constexpr size_t WS_WIN = 2 * MiB, WS_WOUT = 14 * MiB, WS_WFI = 18 * MiB, WS_WFO = 40 * MiB;
constexpr size_t SZ_WIN = 6 * MiB, SZ_WOUT = 2 * MiB, SZ_WFI = 11 * MiB, SZ_WFO = (size_t)DM * DFF * 2;
constexpr size_t WS_H = 52 * MiB, WS_QKV = 116 * MiB, WS_MIX = 308 * MiB, WS_UV = 116 * MiB, WS_ACT = 260 * MiB, WS_XB = 436 * MiB, WS_END = 500 * MiB;
static_assert(WS_WFO + 2 * SZ_WFO <= WS_H, "ws map");
constexpr int HALF_M = MTOK / 2;
constexpr int LDS_RING = 131072, LDS_WF = 131072, LDS_MISC = 147456, LDS_TAB = 147456 + 256, LDS_BYTES = 155648;

typedef float f32x2_t __attribute__((ext_vector_type(2))); typedef __bf16 bf16x2_t __attribute__((ext_vector_type(2)));
__device__ __forceinline__ unsigned cvtpk(float lo, float hi) { f32x2_t v = {lo, hi}; bf16x2_t b = __builtin_convertvector(v, bf16x2_t); return __builtin_bit_cast(unsigned, b); }
__device__ __forceinline__ float bf2f(unsigned short v) { return __uint_as_float((unsigned)v << 16); }
__device__ __forceinline__ float wave_sum(float v) {
#pragma unroll
    for (int o = 1; o < 64; o <<= 1) v += __shfl_xor(v, o);
    return v;
}
__device__ __forceinline__ float ex2(float v) { return __builtin_amdgcn_exp2f(v); }

struct Args { const float* in[14]; float* out; unsigned char* ws; };
struct WMeta { bf16* dst; int K; float scale; const float* gk; };
constexpr int W_I_IN = 16 * 72, W_I_OUT = 12 * 32, W_I_FI = 16 * 176, W_I_FO = 44 * 32, W_I_L = W_I_IN + W_I_OUT + W_I_FI + W_I_FO;
__device__ __forceinline__ void witem_load(const Args& a, int it, int lane, float (&wv)[32], WMeta& mt) {
    const int l = it / W_I_L; int r = it % W_I_L;
    const float* W; int K, Nsrc, nblk, mode; bf16* WT;
    if (r < W_I_IN) { W = a.in[2] + (size_t)l * DM * NIN_SRC; K = DM; Nsrc = NIN_SRC; nblk = 72; WT = (bf16*)(a.ws + WS_WIN + l * SZ_WIN); mode = 1; }
    else if ((r -= W_I_IN) < W_I_OUT) { W = a.in[7] + (size_t)l * MIXW * DM; K = MIXW; Nsrc = DM; nblk = 32; WT = (bf16*)(a.ws + WS_WOUT + l * SZ_WOUT); mode = 0; }
    else if ((r -= W_I_OUT) < W_I_FI) { W = a.in[9] + (size_t)l * DM * NFF2; K = DM; Nsrc = NFF2; nblk = 176; WT = (bf16*)(a.ws + WS_WFI + l * SZ_WFI); mode = 2; }
    else { r -= W_I_FI; W = a.in[12] + (size_t)l * DFF * DM; K = DFF; Nsrc = DM; nblk = 32; WT = (bf16*)(a.ws + WS_WFO + l * SZ_WFO); mode = 0; }
    const int kb = r / nblk, nb = r % nblk, k0 = 64 * kb, n0 = 32 * nb;
    int sc0 = n0; float scale = 1.f;
    if (mode == 2) sc0 = (n0 >> 8) * 128 + (n0 & 127) + ((n0 & 128) ? DFF : 0);
    if (mode == 1) { sc0 = n0 + (n0 >= 768 ? 4 : 0);
        if ((n0 >= C_FQ && n0 < C_FK) || (n0 >= C_DQ && n0 < C_DK) || (n0 >= C_CQ && n0 < C_CK)) scale = QSCALE; }
    const float* src = W + (size_t)(k0 + (lane >> 5)) * Nsrc + sc0 + (lane & 31);
#pragma unroll
    for (int i = 0; i < 32; ++i) wv[i] = __builtin_nontemporal_load(src + (size_t)(2 * i) * Nsrc);
    mt.dst = WT + (size_t)n0 * K + k0; mt.K = K; mt.scale = scale; mt.gk = (mode == 1) ? a.in[1] + (size_t)l * DM + k0 : (mode == 2) ? a.in[8] + (size_t)l * DM + k0 : nullptr;
}
__device__ __forceinline__ void witem_store(const WMeta& mt, const float (&wv)[32], LAS float* scr, int lane) {
#pragma unroll
    for (int i = 0; i < 32; ++i) { const int kk = 2 * i + (lane >> 5); scr[kk * 33 + (lane & 31)] = wv[i] * (mt.gk ? mt.scale * mt.gk[kk] : mt.scale); }
    asm volatile("s_waitcnt lgkmcnt(0)" ::: "memory");
    const int c = lane & 7;
#pragma unroll
    for (int j = 0; j < 4; ++j) { const int n = (lane >> 3) + 8 * j; const LAS float* s = scr + (8 * c) * 33 + n;
        u32x4 o; o.x = cvtpk(s[0 * 33], s[1 * 33]); o.y = cvtpk(s[2 * 33], s[3 * 33]); o.z = cvtpk(s[4 * 33], s[5 * 33]); o.w = cvtpk(s[6 * 33], s[7 * 33]);
        *(u32x4*)(mt.dst + (size_t)n * mt.K + 8 * c) = o; }
}
__device__ __forceinline__ void phase_weights(const Args& a, LAS unsigned char* lds, int gw, int NGW, int wave, int lane) {
    LAS float* scr = (LAS float*)(lds + wave * 16896);
    for (int it = gw; it < DEPTH * W_I_L; it += 2 * NGW) {
        float wa[32], wb[32]; WMeta ma, mb; const bool two = it + NGW < DEPTH * W_I_L;
        witem_load(a, it, lane, wa, ma);
        if (two) witem_load(a, it + NGW, lane, wb, mb);
        witem_store(ma, wa, scr, lane);
        if (two) witem_store(mb, wb, scr + 64 * 33, lane);
        asm volatile("s_waitcnt lgkmcnt(0)" ::: "memory");
    }
}

template <bool XBF> struct RowLd;
template <> struct RowLd<false> { typedef f32x4 raw; static __device__ __forceinline__ raw ld(const void* x, size_t m, int lane, int j) { return __builtin_nontemporal_load((const f32x4*)((const float*)x + m * DM) + lane + 64 * j); }
    static __device__ __forceinline__ f32x4 cv(raw r) { return r; } };
template <> struct RowLd<true> { typedef u32x2 raw; static __device__ __forceinline__ raw ld(const void* x, size_t m, int lane, int j) { return *((const u32x2*)((const bf16*)x + m * DM) + lane + 64 * j); }
    static __device__ __forceinline__ f32x4 cv(raw r) { f32x4 v; v.x = __uint_as_float(r.x << 16); v.y = __uint_as_float(r.x & 0xffff0000u); v.z = __uint_as_float(r.y << 16); v.w = __uint_as_float(r.y & 0xffff0000u); return v; } };
template <int MODE, bool XBF>
__device__ __forceinline__ void phase_norm(const void* x, const float* g, bf16* H, float* outf, const float* w_in_l, const float* b_fox, float* FF,
                                           LAS unsigned char* lds, int gw, int NGW, int tid, int lane) {
    LAS f32x4* wf = (LAS f32x4*)(lds + LDS_WF);
    if (MODE == 1) {
        __syncthreads();
        for (int k = tid; k < DM; k += NTHREADS) wf[k] = *(const f32x4*)(w_in_l + (size_t)k * NIN_SRC + 768);
        __syncthreads();
    }
    f32x4 gv[4];
#pragma unroll
    for (int j = 0; j < 4; ++j) gv[j] = *((const f32x4*)g + lane + 64 * j);
    f32x4 v[4]; typename RowLd<XBF>::raw vn[4];
    if (gw < MTOK) {
#pragma unroll
        for (int j = 0; j < 4; ++j) vn[j] = RowLd<XBF>::ld(x, (size_t)gw, lane, j); }
    for (int m = gw; m < MTOK; m += NGW) {
        float s = 0.f;
#pragma unroll
        for (int j = 0; j < 4; ++j) v[j] = RowLd<XBF>::cv(vn[j]);
        if (m + NGW < MTOK) {
#pragma unroll
            for (int j = 0; j < 4; ++j) vn[j] = RowLd<XBF>::ld(x, (size_t)(m + NGW), lane, j); }
#pragma unroll
        for (int j = 0; j < 4; ++j) s += (v[j].x * v[j].x + v[j].y * v[j].y) + (v[j].z * v[j].z + v[j].w * v[j].w);
        const float rstd = 1.0f / sqrtf(wave_sum(s) * (1.f / DM) + RMS_EPS);
        if (MODE == 3) { if (lane == 0) outf[m] = rstd; continue; }
        if (MODE == 1) {
            if (!XBF) { u32x2* o = (u32x2*)(H + (size_t)m * DM) + lane;
#pragma unroll
                for (int j = 0; j < 4; ++j) { u32x2 w; w.x = cvtpk(v[j].x, v[j].y); w.y = cvtpk(v[j].z, v[j].w); o[64 * j] = w; } }
            if (lane == 0) outf[m] = rstd;
        }
#pragma unroll
        for (int j = 0; j < 4; ++j) v[j] = v[j] * rstd * gv[j];
        if (MODE == 2) {
            f32x4* o = (f32x4*)(outf + (size_t)m * DM) + lane;
#pragma unroll
            for (int j = 0; j < 4; ++j) __builtin_nontemporal_store(v[j], o + 64 * j);
        } else if (MODE == 0) {
            u32x2* o = (u32x2*)(H + (size_t)m * DM) + lane;
#pragma unroll
            for (int j = 0; j < 4; ++j) { u32x2 w; w.x = cvtpk(v[j].x, v[j].y); w.y = cvtpk(v[j].z, v[j].w); o[64 * j] = w; }
        }
        if (MODE == 1) {
            f32x4 d = {0.f, 0.f, 0.f, 0.f};
#pragma unroll
            for (int j = 0; j < 4; ++j) { const int k = 4 * lane + 256 * j;
                d += wf[k] * v[j].x; d += wf[k + 1] * v[j].y; d += wf[k + 2] * v[j].z; d += wf[k + 3] * v[j].w; }
            const bool h32 = (lane & 32) != 0, h16 = (lane & 16) != 0;
            float p0 = h32 ? d.z : d.x, p1 = h32 ? d.w : d.y;
            p0 += __shfl_xor(h32 ? d.x : d.z, 32); p1 += __shfl_xor(h32 ? d.y : d.w, 32);
            float r = h16 ? p1 : p0;
            r += __shfl_xor(h16 ? p0 : p1, 16);
            r += __shfl_xor(r, 8); r += __shfl_xor(r, 4); r += __shfl_xor(r, 2); r += __shfl_xor(r, 1);
            if ((lane & 15) == 0) { const int hh = lane >> 4; const float z = r + b_fox[hh];
                const float ls = fminf(z, 0.f) - log1pf(expf(-fabsf(z)));
                FF[(size_t)m * 4 + hh] = ls; }
        }
    }
}

__device__ __forceinline__ void cumsum_seq(const float* FF, float* CUM, int bh, int lane) {
    const int b = bh >> 2, h = bh & 3;
    const float* src = FF + ((size_t)b * SEQ + 32 * lane) * 4 + h;
    float v[32]; float s = 0.f;
#pragma unroll
    for (int i = 0; i < 32; ++i) { s += src[4 * i]; v[i] = s; }
    float inc = s;
#pragma unroll
    for (int o = 1; o < 64; o <<= 1) { const float t = __shfl_up(inc, o); if (lane >= o) inc += t; }
    const float excl = inc - s;
    float* dst = CUM + (size_t)bh * SEQ + 32 * lane;
#pragma unroll
    for (int i = 0; i < 32; i += 4) { f32x4 w = {v[i] + excl, v[i + 1] + excl, v[i + 2] + excl, v[i + 3] + excl}; *(f32x4*)(dst + i) = w; }
}

__device__ __forceinline__ void unpack8(const u32x4 a, float (&f)[8]) {
#pragma unroll
    for (int i = 0; i < 4; ++i) { f[2 * i] = __uint_as_float(a[i] << 16); f[2 * i + 1] = __uint_as_float(a[i] & 0xffff0000u); } }
__device__ __forceinline__ void phase_fixup(const bf16* HALO, bf16* ACT, const float* cw, const float* cb, int gt, int NGT) {
    constexpr int NCG = DFF / 8, NG = MTOK / 64;
    for (int it = gt; it < NG * 2 * NCG; it += NGT) {
        const int cg8 = it % NCG, rs = it / NCG, s = rs & 1, j = rs >> 1, c0 = cg8 * 8;
        const bool first = ((j * 64) % SEQ) == 0;
        const bf16* hj = HALO + (size_t)j * 4 * NFF2; const bf16* hp = hj - 4 * NFF2;
        const bf16* pt = hj + (size_t)s * NFF2;
        const bf16* p1 = (s == 0) ? hp + 3 * NFF2 : hj;
        const bf16* p2 = (s == 0) ? hp + 2 * NFF2 : hp + 3 * NFF2;
        const u32x4 z = {0u, 0u, 0u, 0u};
        float ut[8], u1[8], u2[8], gt_[8], g1[8], g2[8];
        unpack8(*(const u32x4*)(pt + c0), ut); unpack8(*(const u32x4*)(pt + DFF + c0), gt_);
        unpack8((s == 0 && first) ? z : *(const u32x4*)(p1 + c0), u1); unpack8((s == 0 && first) ? z : *(const u32x4*)(p1 + DFF + c0), g1);
        unpack8(first ? z : *(const u32x4*)(p2 + c0), u2); unpack8(first ? z : *(const u32x4*)(p2 + DFF + c0), g2);
        float o[8];
#pragma unroll
        for (int i = 0; i < 8; ++i) { const int c = c0 + i;
            const float yu = cb[c] + cw[c] * u2[i] + cw[NFF2 + c] * u1[i] + cw[2 * NFF2 + c] * ut[i];
            const float yg = cb[DFF + c] + cw[DFF + c] * g2[i] + cw[NFF2 + DFF + c] * g1[i] + cw[2 * NFF2 + DFF + c] * gt_[i];
            o[i] = yu * yg / (1.f + __expf(-yg)); }
        u32x4 w; w.x = cvtpk(o[0], o[1]); w.y = cvtpk(o[2], o[3]); w.z = cvtpk(o[4], o[5]); w.w = cvtpk(o[6], o[7]);
        *(u32x4*)(ACT + (size_t)(j * 64 + s) * DFF + c0) = w;
    }
}
__device__ __forceinline__ s16x4 vtr(LAS const char* p) { typedef short v4i16_t __attribute__((ext_vector_type(4))); return __builtin_bit_cast(s16x4, __builtin_amdgcn_ds_read_tr16_b64_v4i16((LAS v4i16_t*)p)); }
constexpr int KROWB = 144, KT_BYTES = 64 * KROWB;

__device__ __forceinline__ void qk_tile(f32x16& p0, f32x16& p1, LAS const char* kt, const bf16x8 (&qr)[4], int r32, int hi) {
    LAS const char* kb = kt + r32 * KROWB + hi * 16;
#pragma unroll
    for (int ks = 0; ks < 4; ++ks) {
        const bf16x8 a0 = *(LAS const bf16x8*)(kb + ks * 32), a1 = *(LAS const bf16x8*)(kb + 32 * KROWB + ks * 32);
        p0 = __builtin_amdgcn_mfma_f32_32x32x16_bf16(a0, qr[ks], p0, 0, 0, 0);
        p1 = __builtin_amdgcn_mfma_f32_32x32x16_bf16(a1, qr[ks], p1, 0, 0, 0);
    }
}
template <int NDB>
__device__ __forceinline__ void softmax_pv(f32x16& p0, f32x16& p1, float& m, float& l, f32x16 (&o)[NDB], LAS const char* vt, int vb) {
    float ma = fmaxf(fmaxf(p0[0], p0[1]), p1[0]), mb = fmaxf(fmaxf(p0[2], p0[3]), p1[1]);
    ma = fmaxf(fmaxf(ma, p1[2]), p1[3]);
#pragma unroll
    for (int r = 4; r < 16; r += 4) { ma = fmaxf(fmaxf(ma, p0[r]), p0[r + 1]); mb = fmaxf(fmaxf(mb, p0[r + 2]), p0[r + 3]); ma = fmaxf(fmaxf(ma, p1[r]), p1[r + 1]); mb = fmaxf(fmaxf(mb, p1[r + 2]), p1[r + 3]); }
    float mx = fmaxf(ma, mb);
    mx = fmaxf(mx, __shfl_xor(mx, 32));
    if (__builtin_amdgcn_ballot_w64(mx > m) != 0ull) {
        const float mn = fmaxf(m, mx);
        const float alpha = ex2(m - mn);
        m = mn; l *= alpha;
#pragma unroll
        for (int db = 0; db < NDB; ++db)
#pragma unroll
            for (int r = 0; r < 16; ++r) o[db][r] *= alpha;
    }
    const float mn = m;
    float rs = 0.f;
#pragma unroll
    for (int r = 0; r < 16; ++r) { p0[r] = ex2(p0[r] - mn); p1[r] = ex2(p1[r] - mn); rs += p0[r] + p1[r]; }
    l += rs;
    bf16x8 pf[4];
    { u32x4 w;
      w.x = cvtpk(p0[0], p0[1]); w.y = cvtpk(p0[2], p0[3]); w.z = cvtpk(p0[4], p0[5]); w.w = cvtpk(p0[6], p0[7]); pf[0] = __builtin_bit_cast(bf16x8, w);
      w.x = cvtpk(p0[8], p0[9]); w.y = cvtpk(p0[10], p0[11]); w.z = cvtpk(p0[12], p0[13]); w.w = cvtpk(p0[14], p0[15]); pf[1] = __builtin_bit_cast(bf16x8, w);
      w.x = cvtpk(p1[0], p1[1]); w.y = cvtpk(p1[2], p1[3]); w.z = cvtpk(p1[4], p1[5]); w.w = cvtpk(p1[6], p1[7]); pf[2] = __builtin_bit_cast(bf16x8, w);
      w.x = cvtpk(p1[8], p1[9]); w.y = cvtpk(p1[10], p1[11]); w.z = cvtpk(p1[12], p1[13]); w.w = cvtpk(p1[14], p1[15]); pf[3] = __builtin_bit_cast(bf16x8, w); }
#pragma unroll
    for (int kk = 0; kk < 4; ++kk)
#pragma unroll
        for (int db = 0; db < NDB; ++db) {
            const s16x4 lo = vtr(vt + vb + db * 4096 + kk * 1024), hh = vtr(vt + vb + db * 4096 + kk * 1024 + 512);
            const bf16x8 vf = {lo[0], lo[1], lo[2], lo[3], hh[0], hh[1], hh[2], hh[3]};
            o[db] = __builtin_amdgcn_mfma_f32_32x32x16_bf16(vf, pf[kk], o[db], 0, 0, 0);
        }
}

template <int MODE>
__device__ __forceinline__ void attn_unit64(const bf16* qkv, bf16* mix, const float* cum_bh, int b, int h, int blk, LAS unsigned char* lds, int tid, int wave, int lane) {
    constexpr int CUMOFF = KT_BYTES + 8192, BUFSZ = CUMOFF + 256;
    const int r32 = lane & 31, hi = lane >> 5;
    const size_t rowbase = (size_t)b * SEQ;
    const int Q0 = blk * 256, qw0 = Q0 + 32 * wave;
    const int CQ = (MODE == 0 ? C_FQ : C_CQ) + h * 64, CK = (MODE == 0 ? C_FK : C_CK) + h * 64, CV = (MODE == 0 ? C_FV : C_CV) + h * 64;
    const int c0 = 4 * blk, cw = c0 + (wave >> 1);
    int tbeg, tend, kvoff;
    if (MODE == 0) { tbeg = 0; tend = 4 * (blk + 1); kvoff = 0; }
    else { tbeg = (c0 >= 8) ? 0 : 8 - c0; tend = 12; kvoff = (c0 - 8) * 64; }
    const int srow = tid >> 3, sch = tid & 7;
    const bf16* kg = qkv + (rowbase + kvoff + srow) * NQKV + CK + sch * 8;
    const bf16* vg = qkv + (rowbase + kvoff + srow) * NQKV + CV + sch * 8;
    const int kdst = srow * KROWB + sch * 16, vdst = KT_BYTES + (sch >> 2) * 4096 + srow * 64 + (sch & 3) * 16;
    const float cref = (MODE == 0) ? cum_bh[Q0] : 0.f;
#define U64_LOAD(K, V, C, tt) do { if ((tt) >= tbeg) { K = *(const u32x4*)(kg + (size_t)(tt) * 64 * NQKV); V = *(const u32x4*)(vg + (size_t)(tt) * 64 * NQKV); \
        if (MODE == 0 && tid < 16) C = *(const f32x4*)(cum_bh + (tt) * 64 + 4 * tid); } } while (0)
#define U64_STAGE(K, V, C, buf) do { *(LAS u32x4*)((buf) + kdst) = K; *(LAS u32x4*)((buf) + vdst) = V; if (MODE == 0 && tid < 16) *(LAS f32x4*)((buf) + CUMOFF + tid * 16) = (cref - C) * L2E; } while (0)
#define LDS_BAR() asm volatile("s_waitcnt lgkmcnt(0)\n\ts_barrier" ::: "memory")
    u32x4 kA = {0u, 0u, 0u, 0u}, vA = kA, kB = kA, vB = kA; f32x4 cA = {0.f, 0.f, 0.f, 0.f}, cB = cA;
    U64_LOAD(kA, vA, cA, tend - 1); U64_LOAD(kB, vB, cB, tend - 2);
    bf16x8 qr[4];
#pragma unroll
    for (int ks = 0; ks < 4; ++ks) qr[ks] = *(const bf16x8*)(qkv + (rowbase + qw0 + r32) * NQKV + CQ + ks * 16 + hi * 8);
    float m = -1e30f, l = 0.f;
    f32x16 o[2];
#pragma unroll
    for (int db = 0; db < 2; ++db)
#pragma unroll
        for (int r = 0; r < 16; ++r) o[db][r] = 0.f;
    const int vb = (4 * hi + ((lane & 15) >> 2)) * 64 + ((lane >> 4) & 1) * 32 + (lane & 3) * 8;
    LAS const float* tab = (LAS const float*)(lds + LDS_TAB) + h * 192;
    auto compute = [&](const int t, LAS unsigned char* const buf) __attribute__((always_inline)) {
        const int kv0 = kvoff + 64 * t;
        bool doit;
        if (MODE == 0) doit = kv0 <= qw0 + 31; else { const int kc = c0 - 8 + t; doit = (kc >= cw - 8) && (kc <= cw); }
        if (doit) {
            f32x16 p0 = (f32x16){0.f, 0.f, 0.f, 0.f, 0.f, 0.f, 0.f, 0.f, 0.f, 0.f, 0.f, 0.f, 0.f, 0.f, 0.f, 0.f}, p1 = p0;
            if (MODE == 2 && cw - (c0 - 8 + t) >= 3) { const float bv = tab[191];
#pragma unroll
                for (int r = 0; r < 16; ++r) { p0[r] = bv; p1[r] = bv; } }
            if (MODE == 0) {
#pragma unroll
                for (int g = 0; g < 4; ++g) { const f32x4 ca = *(LAS const f32x4*)(buf + CUMOFF + (8 * g + 4 * hi) * 4), cb = *(LAS const f32x4*)(buf + CUMOFF + (32 + 8 * g + 4 * hi) * 4);
#pragma unroll
                    for (int i = 0; i < 4; ++i) { p0[4 * g + i] = ca[i]; p1[4 * g + i] = cb[i]; } }
            }
            qk_tile(p0, p1, (LAS const char*)buf, qr, r32, hi);
            if (MODE == 0) {
                if (kv0 + 63 > qw0) {
                    const int qa = qw0 + r32 - kv0 - 4 * hi;
#pragma unroll
                    for (int r = 0; r < 16; ++r) { const int kl = (r & 3) + 8 * (r >> 2); if (kl > qa) p0[r] = -INFINITY; if (kl + 32 > qa) p1[r] = -INFINITY; }
                }
            } else {
                const int dc = cw - (c0 - 8 + t);
                if (dc < 3) {
                    const int rel0 = qw0 + r32 - kv0 - 4 * hi + 63;
#pragma unroll
                    for (int r = 0; r < 16; ++r) { const int kl = (r & 3) + 8 * (r >> 2);
                        int i0 = rel0 - kl, i1 = rel0 - kl - 32; i0 = i0 < 0 ? 0 : (i0 > 191 ? 191 : i0); i1 = i1 < 0 ? 0 : (i1 > 191 ? 191 : i1);
                        p0[r] += tab[i0]; p1[r] += tab[i1]; }
                }
            }
            softmax_pv<2>(p0, p1, m, l, o, (LAS const char*)buf + KT_BYTES, vb);
        }
    };
    int pi = 0;
    for (int t = tend - 1; t >= tbeg; t -= 2, pi ^= 1) {
        LAS unsigned char* const sb = lds + (pi ? 2 * BUFSZ : 0); const bool two = (t - 1 >= tbeg);
        U64_STAGE(kA, vA, cA, sb); if (two) U64_STAGE(kB, vB, cB, sb + BUFSZ);
        LDS_BAR();
        U64_LOAD(kA, vA, cA, t - 2); U64_LOAD(kB, vB, cB, t - 3);
        compute(t, sb); if (two) compute(t - 1, sb + BUFSZ);
    }
#undef U64_LOAD
#undef U64_STAGE
    l += __shfl_xor(l, 32);
    const float inv = 1.0f / l;
    bf16* orow = mix + (rowbase + qw0 + r32) * MIXW + (MODE == 0 ? MX_FOX : MX_CHK) + h * 64 + 4 * hi;
#pragma unroll
    for (int db = 0; db < 2; ++db)
#pragma unroll
        for (int g = 0; g < 4; ++g) { u32x2 w; w.x = cvtpk(o[db][4 * g] * inv, o[db][4 * g + 1] * inv); w.y = cvtpk(o[db][4 * g + 2] * inv, o[db][4 * g + 3] * inv);
            *(u32x2*)(orow + 32 * db + 8 * g) = w; }
    __syncthreads();
}

template <int C>
__device__ __forceinline__ void diff_pass(const bf16* qkv, bf16* mix, float* park, int b, int h, int blk, float lam, float sl2, const float* gdiff, float outscale,
                                          LAS unsigned char* lds, int tid, int wave, int lane) {
    constexpr int VOFF = KT_BYTES, BUFSZ = VOFF + 16384;
    const int r32 = lane & 31, hi = lane >> 5;
    const size_t rowbase = (size_t)b * SEQ;
    const int Q0 = blk * 256, qw0 = Q0 + 32 * wave, cwv = qw0 >> 6, tend = 4 * (blk + 1);
    const int srow = tid >> 3, sch = tid & 7;
    const int vrow0 = tid >> 4, vch = tid & 15;
    const bf16* vg = qkv + (rowbase + vrow0) * NQKV + C_DV + h * 128 + vch * 8;
    const int kdst = srow * KROWB + sch * 16, vdst = VOFF + (vch >> 2) * 4096 + vrow0 * 64 + (vch & 3) * 16;
    const int vb = (4 * hi + ((lane & 15) >> 2)) * 64 + ((lane >> 4) & 1) * 32 + (lane & 3) * 8;
    const bf16* kg = qkv + (rowbase + srow) * NQKV + C_DK + h * 128 + C * 64 + sch * 8;
#define DF_LOAD(K, V0, V1, tt) do { if ((tt) >= 0) { const size_t go_ = (size_t)(tt) * 64 * NQKV; K = *(const u32x4*)(kg + go_); V0 = *(const u32x4*)(vg + go_); V1 = *(const u32x4*)(vg + go_ + (size_t)32 * NQKV); } } while (0)
#define DF_STAGE(K, V0, V1, buf) do { *(LAS u32x4*)((buf) + kdst) = K; *(LAS u32x4*)((buf) + vdst) = V0; *(LAS u32x4*)((buf) + vdst + 32 * 64) = V1; } while (0)
    u32x4 kA = {0u, 0u, 0u, 0u}, v0A = kA, v1A = kA, kB = kA, v0B = kA, v1B = kA;
    DF_LOAD(kA, v0A, v1A, tend - 1); DF_LOAD(kB, v0B, v1B, tend - 2);
    bf16x8 qr[4];
#pragma unroll
    for (int ks = 0; ks < 4; ++ks) qr[ks] = *(const bf16x8*)(qkv + (rowbase + qw0 + r32) * NQKV + C_DQ + h * 128 + C * 64 + ks * 16 + hi * 8);
    float m = -1e30f, l = 0.f;
    f32x16 o[4];
#pragma unroll
    for (int db = 0; db < 4; ++db)
#pragma unroll
        for (int r = 0; r < 16; ++r) o[db][r] = 0.f;
    f32x16 ab;
#pragma unroll
    for (int r = 0; r < 16; ++r) ab[r] = sl2 * (float)((r & 3) + 8 * (r >> 2) + 4 * hi);
    auto compute = [&](const int t, LAS unsigned char* const buf) __attribute__((always_inline)) {
        if (t <= cwv) {
            const int kv0 = 64 * t;
            f32x16 p0, p1;
            if (t < cwv) { const float d0 = sl2 * (float)(64 * (t - cwv)), d1 = d0 + 32.f * sl2;
#pragma unroll
                for (int r = 0; r < 16; ++r) { p0[r] = ab[r] + d0; p1[r] = ab[r] + d1; }
                qk_tile(p0, p1, (LAS const char*)buf, qr, r32, hi);
            } else { p0 = (f32x16){0.f, 0.f, 0.f, 0.f, 0.f, 0.f, 0.f, 0.f, 0.f, 0.f, 0.f, 0.f, 0.f, 0.f, 0.f, 0.f}; p1 = p0;
                qk_tile(p0, p1, (LAS const char*)buf, qr, r32, hi);
                const float ql = (float)(qw0 + r32 - kv0), base = ql - (float)(4 * hi);
#pragma unroll
                for (int r = 0; r < 16; ++r) { const float kl = (float)((r & 3) + 8 * (r >> 2)); p0[r] += sl2 * (ql - fabsf(base - kl)); p1[r] += sl2 * (ql - fabsf(base - kl - 32.f)); }
            }
            softmax_pv<4>(p0, p1, m, l, o, (LAS const char*)buf + VOFF, vb);
        }
    };
    int pi = 0;
    for (int t = tend - 1; t >= 0; t -= 2, pi ^= 1) {
        LAS unsigned char* const sb = lds + (pi ? 2 * BUFSZ : 0);
        DF_STAGE(kA, v0A, v1A, sb); DF_STAGE(kB, v0B, v1B, sb + BUFSZ);
        LDS_BAR();
        DF_LOAD(kA, v0A, v1A, t - 2); DF_LOAD(kB, v0B, v1B, t - 3);
        compute(t, sb); compute(t - 1, sb + BUFSZ);
    }
#undef DF_LOAD
#undef DF_STAGE
    l += __shfl_xor(l, 32);
    const float inv = 1.0f / l;
    if (C == 0) {
#pragma unroll
        for (int db = 0; db < 4; ++db)
#pragma unroll
            for (int r = 0; r < 16; ++r) park[(db * 16 + r) * NTHREADS] = o[db][r] * inv;
    } else {
        const float li = lam * inv;
        float ss = 0.f;
#pragma unroll
        for (int db = 0; db < 4; ++db) {
#pragma unroll
            for (int r = 0; r < 16; ++r) { const float v = park[(db * 16 + r) * NTHREADS] - o[db][r] * li; o[db][r] = v; ss += v * v; }
            asm volatile("" ::: "memory"); }
        ss += __shfl_xor(ss, 32);
        const float rn = outscale / sqrtf(ss * (1.f / 128.f) + RMS_EPS);
        bf16* orow = mix + (rowbase + qw0 + r32) * MIXW + MX_DIFF + h * 128 + 4 * hi;
#pragma unroll
        for (int db = 0; db < 4; ++db)
#pragma unroll
            for (int g = 0; g < 4; ++g) { const f32x4 gg = *(const f32x4*)(gdiff + 32 * db + 8 * g + 4 * hi);
                u32x2 w; w.x = cvtpk(o[db][4 * g] * rn * gg.x, o[db][4 * g + 1] * rn * gg.y); w.y = cvtpk(o[db][4 * g + 2] * rn * gg.z, o[db][4 * g + 3] * rn * gg.w);
                *(u32x2*)(orow + 32 * db + 8 * g) = w; }
    }
    __syncthreads();
}
__device__ __forceinline__ void attn_unit_diff2(const bf16* qkv, bf16* mix, int b, int h, int blk, float lam, float sl2, const float* gdiff, float outscale,
                                                LAS unsigned char* lds, int tid, int wave, int lane) {
    float* park = (float*)((unsigned char*)qkv - WS_QKV + WS_H) + (size_t)blockIdx.x * 64 * NTHREADS + tid;
    diff_pass<0>(qkv, mix, park, b, h, blk, lam, sl2, gdiff, outscale, lds, tid, wave, lane);
    int tid2 = threadIdx.x; asm volatile("" : "+v"(tid2) :: "memory"); __builtin_amdgcn_sched_barrier(0);
    float* park2 = (float*)((unsigned char*)qkv - WS_QKV + WS_H) + (size_t)blockIdx.x * 64 * NTHREADS + tid2;
    diff_pass<1>(qkv, mix, park2, b, h, blk, lam, sl2, gdiff, outscale, lds, tid2, __builtin_amdgcn_readfirstlane(tid2 >> 6), tid2 & 63);
}
#define SF(q) (0 << 5 | (q) << 1 | 0), (0 << 5 | (q) << 1 | 1)
#define SD(q) (1 << 5 | (q) << 1 | 0)
#define SC(q) (2 << 5 | (q) << 1 | 0), (2 << 5 | (q) << 1 | 1)
__device__ __forceinline__ int seg_code(int s) {
    constexpr unsigned char T[40] = { SD(7), SD(6), SD(5), SD(4), SD(3), SF(7), SD(2), SF(6), SF(5), SD(1), SF(4), SF(3), SD(0), SF(2),
        SC(7), SC(6), SC(5), SC(4), SC(3), SC(2), SC(1), SC(0), SF(1), SF(0) };
    return T[s];
}
__device__ __forceinline__ void phase_attn(const Args& a, int layer, unsigned* ctr, LAS unsigned char* lds, int tid0, int wave0, int lane0) {
    const bf16* qkv = (const bf16*)(a.ws + WS_QKV); bf16* mix = (bf16*)(a.ws + WS_MIX); const float* CUM = (const float*)(a.ws + WS_CUM);
    for (int i = tid0; i < 4 * 192; i += NTHREADS) ((LAS float*)(lds + LDS_TAB))[i] = a.in[6][(size_t)layer * 768 + i] * L2E;
    const float* dl = a.in[4] + (size_t)layer * 256;
    const float s01 = wave_sum(dl[lane0] * dl[64 + lane0]), s23 = wave_sum(dl[128 + lane0] * dl[192 + lane0]);
    const float lambda_init = 0.8f - 0.6f * expf(-0.3f * (float)layer);
    const float lam = expf(s01) - expf(s23) + lambda_init;
    const float* gdiff = a.in[5] + (size_t)layer * 128;
    LAS volatile unsigned* misc = (LAS volatile unsigned*)(lds + LDS_MISC);
    __syncthreads();
    for (;;) {
        if (threadIdx.x == 0) misc[0] = atomicAdd(ctr, 1u);
        __syncthreads();
        const unsigned idx = misc[0];
        int tidf = threadIdx.x; asm volatile("" : "+v"(tidf) :: "memory"); __builtin_amdgcn_sched_barrier(0);
        const int tid = tidf, lane = tidf & 63, wave = __builtin_amdgcn_readfirstlane(tidf >> 6);
        if (idx >= 1280u) break;
        const int code = seg_code((int)(idx >> 5)), kind = code >> 5, blk = (code >> 1) & 15, sub = (int)(idx & 31);
        if (kind == 1) { const int b = sub >> 1, h = sub & 1;
            attn_unit_diff2(qkv, mix, b, h, blk, lam, exp2f(-4.0f * (float)(h + 1)) * L2E, gdiff, 1.0f - lambda_init, lds, tid, wave, lane); }
        else { const int bh = (code & 1) * 32 + sub, b = bh >> 2, h = bh & 3;
            if (kind == 0) attn_unit64<0>(qkv, mix, CUM + (size_t)bh * SEQ, b, h, blk, lds, tid, wave, lane);
            else attn_unit64<2>(qkv, mix, nullptr, b, h, blk, lds, tid, wave, lane); }
    }
}
#define XB_TMO      128
#define XB_XCNT(j)  (256  + 64 * (j))
#define XB_XSUB(j)  (1280 + 64 * (j))
#define XB_XGEN(j)  (2304 + 64 * (j))
#define XB_TOP      3328
#define XB_TOPGEN   3392
#define XCD_BAR_WORDS 3456
#define XB_SPIN_CAP (1u << 18)

__device__ __forceinline__ unsigned xb_ld(unsigned* p)              { return __hip_atomic_load(p, __ATOMIC_RELAXED, __HIP_MEMORY_SCOPE_AGENT); }
__device__ __forceinline__ unsigned xb_add(unsigned* p, unsigned v) { return __hip_atomic_fetch_add(p, v, __ATOMIC_RELAXED, __HIP_MEMORY_SCOPE_AGENT); }
__device__ __forceinline__ unsigned xb_xcc_id() { return (unsigned)__builtin_amdgcn_s_getreg((3 << 11) | 20) & 0xFu; }
#define XB_SPIN(cond, bar) do { unsigned _sp = 0; while (cond) { __builtin_amdgcn_s_sleep(1); \
    if ((++_sp & 255u) == 0u) { if (xb_ld(&(bar)[XB_TMO])) break; if (_sp > XB_SPIN_CAP) { atomicAdd(&(bar)[XB_TMO], 1u); break; } } } } while (0)

struct XcdBarrier {
    unsigned* bar; unsigned x;
    volatile LAS unsigned* st;
};

__device__ __forceinline__ XcdBarrier xcd_barrier_post(unsigned* bar, volatile LAS unsigned* st) {
    XcdBarrier b; b.bar = bar; b.x = xb_xcc_id(); b.st = st;
    if (threadIdx.x == 0) (void)xb_add(&bar[XB_XCNT(b.x)], 1u);
    return b;
}
__device__ __forceinline__ void xcd_barrier_complete(unsigned* bar, unsigned x, unsigned& nloc, unsigned& nx) {
    const unsigned G = gridDim.x * gridDim.y * gridDim.z;
    unsigned sum, cnt, mine, sp = 0u;
    for (;;) {
        sum = 0u; cnt = 0u; mine = 0u;
#pragma unroll
        for (unsigned j = 0; j < 16; ++j) { const unsigned c = xb_ld(&bar[XB_XCNT(j)]); sum += c; cnt += (c > 0u) ? 1u : 0u; mine = (j == x) ? c : mine; }
        if (sum == G) break;
        __builtin_amdgcn_s_sleep(1);
        if ((++sp & 255u) == 0u) { if (xb_ld(&bar[XB_TMO])) break; if (sp > XB_SPIN_CAP) { atomicAdd(&bar[XB_TMO], 1u); break; } }
    }
    nloc = mine > 0u ? mine : 1u; nx = cnt > 0u ? cnt : 1u;
}

__device__ __forceinline__ void xcd_barrier(const XcdBarrier& b) {
    asm volatile("s_waitcnt vmcnt(0)" ::: "memory");
    __syncthreads();
    if (threadIdx.x == 0) {
        unsigned* bar = b.bar;
        __builtin_amdgcn_s_waitcnt(0);
        unsigned nloc = b.st[0], nx = b.st[1];
        if (nloc == 0u) { xcd_barrier_complete(bar, b.x, nloc, nx); b.st[0] = nloc; b.st[1] = nx; }
        const unsigned old = xb_add(&bar[XB_XSUB(b.x)], 1u);
        const unsigned gen = old / nloc;
        if (old + 1u == (gen + 1u) * nloc) {
            __builtin_amdgcn_fence(__ATOMIC_RELEASE, "agent");
            asm volatile("s_waitcnt vmcnt(0)" ::: "memory");
            const unsigned og = xb_add(&bar[XB_TOP], 1u);
            const unsigned tg = og / nx;
            if (og + 1u == (tg + 1u) * nx) xb_add(&bar[XB_TOPGEN], 1u);
            else XB_SPIN(xb_ld(&bar[XB_TOPGEN]) == tg, bar);
            __builtin_amdgcn_fence(__ATOMIC_ACQUIRE, "agent");
            xb_add(&bar[XB_XGEN(b.x)], 1u);
            asm volatile("s_waitcnt vmcnt(0)" ::: "memory");
        } else {
            XB_SPIN(xb_ld(&bar[XB_XGEN(b.x)]) == gen, bar);
            __builtin_amdgcn_fence(__ATOMIC_ACQUIRE, "agent");
            asm volatile("s_waitcnt vmcnt(0)" ::: "memory");
        }
    }
    __syncthreads();
}

#define GEMM_RUN(EPI, Aptr, Bptr, Mv, Nv, Kv, Eobj) GEMM_RUN2(EPI, Aptr, Bptr, Mv, Nv, Kv, Eobj, true, true)
#define GEMM_RUN2(EPI, Aptr, Bptr, Mv, Nv, Kv, Eobj, ALIGNV, SP2V) do { pg8::Gemm g_{(const pg8::bf16_t*)(Aptr), (const pg8::bf16_t*)(Bptr), (Mv), (Nv), (Kv)}; pg8::StaticOrder S_; S_.init((Mv), (Nv), (int)gridDim.x, (int)blockIdx.x); \
    pg8::gemm_phase<EPI, pg8::StaticOrder, ALIGNV, SP2V>(lds, g_, S_, Eobj); } while (0)

__global__ void __launch_bounds__(NTHREADS, 2) mk_fwd(Args a) {
    __shared__ __attribute__((aligned(16))) unsigned char lds_raw[LDS_BYTES];
    LAS unsigned char* lds = (LAS unsigned char*)lds_raw;
    cg::grid_group grid = cg::this_grid();
#define FRESH int tid = threadIdx.x; asm volatile("" : "+v"(tid)); const int lane = tid & 63, wave = __builtin_amdgcn_readfirstlane(tid >> 6); const int G = gridDim.x, gw = blockIdx.x * NWAVES + wave, NGW = G * NWAVES; (void)lane; (void)gw; (void)NGW; (void)G
    unsigned* ctl = (unsigned*)(a.ws + WS_CTL);
    unsigned* barw = ctl + 4096;
    volatile LAS unsigned* bst = (volatile LAS unsigned*)(lds + LDS_MISC + 64);
    if (threadIdx.x < 2) bst[threadIdx.x] = 0u;
    __syncthreads();
    if (a.out == nullptr) grid.sync();
    const XcdBarrier xbar = xcd_barrier_post(barw, bst);
#define GSYNC() xcd_barrier(xbar)
    bf16* H = (bf16*)(a.ws + WS_H); bf16* QKV = (bf16*)(a.ws + WS_QKV); bf16* MIX = (bf16*)(a.ws + WS_MIX); bf16* UV = (bf16*)(a.ws + WS_UV); bf16* ACT = (bf16*)(a.ws + WS_ACT); bf16* XB = (bf16*)(a.ws + WS_XB); float* RSTD = (float*)(a.ws + WS_CTL + 65536);
    float* FF = (float*)(a.ws + WS_FF); float* CUM = (float*)(a.ws + WS_CUM);
    { FRESH; phase_weights(a, lds, gw, NGW, wave, lane); }
    for (int l = 0; l < DEPTH; ++l) {
        if (l == 0) { FRESH; phase_norm<1, false>(a.in[0], a.in[1] + (size_t)l * DM, XB, RSTD, a.in[2] + (size_t)l * DM * NIN_SRC, a.in[3] + l * 4, FF, lds, gw, NGW, tid, lane); }
        else { FRESH; phase_norm<1, true>(XB, a.in[1] + (size_t)l * DM, nullptr, RSTD, a.in[2] + (size_t)l * DM * NIN_SRC, a.in[3] + l * 4, FF, lds, gw, NGW, tid, lane); }
        GSYNC();
        { FRESH; if (blockIdx.x < 64 && wave == 0) cumsum_seq(FF, CUM, blockIdx.x, lane); }
        { pg8::EpiBf16S E{(pg8::bf16_t*)QKV, NQKV, RSTD}; GEMM_RUN(pg8::EpiBf16S, XB, a.ws + WS_WIN + l * SZ_WIN, MTOK, NQKV, DM, E); }
        GSYNC();
        { FRESH; phase_attn(a, l, ctl + 64 * l, lds, tid, wave, lane); }
        GSYNC();
        { pg8::EpiResBS<false> E{XB, (pg8::bf16_t*)XB, DM, (float*)H}; GEMM_RUN(pg8::EpiResBS<false>, MIX, a.ws + WS_WOUT + l * SZ_WOUT, MTOK, DM, MIXW, E); }
        GSYNC();
        { FRESH; if (blockIdx.x < MTOK / NTHREADS) { const int row = blockIdx.x * NTHREADS + tid; const f32x4* p = (const f32x4*)((const float*)H + (size_t)row * 16);
            const f32x4 s4 = (p[0] + p[1]) + (p[2] + p[3]); RSTD[row] = 1.0f / sqrtf(((s4[0] + s4[1]) + (s4[2] + s4[3])) * (1.f / DM) + RMS_EPS); } }
        GSYNC();
        { pg8::EpiConv E{(pg8::bf16_t*)ACT, (pg8::bf16_t*)UV, a.in[10] + (size_t)l * 3 * NFF2, a.in[11] + (size_t)l * NFF2, RSTD}; GEMM_RUN(pg8::EpiConv, XB, a.ws + WS_WFI + l * SZ_WFI, MTOK, NFF2, DM, E); }
        GSYNC();
        { FRESH; phase_fixup(UV, ACT, a.in[10] + (size_t)l * 3 * NFF2, a.in[11] + (size_t)l * NFF2, blockIdx.x * NTHREADS + tid, G * NTHREADS); }
        GSYNC();
        { pg8::EpiResB<false> E{XB, (pg8::bf16_t*)XB, DM}; GEMM_RUN(pg8::EpiResB<false>, ACT, a.ws + WS_WFO + l * SZ_WFO, MTOK, DM, DFF, E); }
        GSYNC();
    }
    { FRESH; phase_norm<2, true>(XB, a.in[13], nullptr, a.out, nullptr, nullptr, nullptr, lds, gw, NGW, tid, lane); }
}

extern "C" void kernel_launch(void* const* d_in, const int* in_sizes, int n_in, void* d_out, int out_size, void* d_ws, size_t ws_size, hipStream_t stream) {
    static int grid_blocks = 0;
    if (grid_blocks == 0) {
        if (n_in != 14 || out_size != MTOK * DM || ws_size < WS_END || in_sizes[2] != DEPTH * DM * NIN_SRC || in_sizes[7] != DEPTH * MIXW * DM || in_sizes[9] != DEPTH * DM * NFF2 || in_sizes[12] != DEPTH * DFF * DM || in_sizes[6] != DEPTH * 4 * 192 || in_sizes[5] != DEPTH * 128) { fprintf(stderr, "kernel_launch: unexpected sizes n_in %d out %d ws %zu\n", n_in, out_size, ws_size); grid_blocks = -1; return; }
        int dev = 0, cus = 0, per_cu = 0;
        (void)hipGetDevice(&dev);
        (void)hipDeviceGetAttribute(&cus, hipDeviceAttributeMultiprocessorCount, dev);
        (void)hipOccupancyMaxActiveBlocksPerMultiprocessor(&per_cu, (const void*)mk_fwd, NTHREADS, 0);
        if (per_cu < 1) { fprintf(stderr, "kernel_launch: occupancy query says %d blocks/CU\n", per_cu); per_cu = 1; }
        (void)hipGetLastError();
        grid_blocks = cus * 1;
        fprintf(stderr, "kernel_launch: cus %d per_cu %d grid %d\n", cus, per_cu, grid_blocks);
    }
    if (grid_blocks < 0) return;
    if (hipMemsetAsync((char*)d_ws + WS_CTL, 0, 65536, stream) != hipSuccess) { fprintf(stderr, "kernel_launch: memset of control words failed\n"); return; }
    Args a{};
    for (int i = 0; i < 14; ++i) a.in[i] = (const float*)d_in[i];
    a.out = (float*)d_out; a.ws = (unsigned char*)d_ws;
    void* args[] = {&a};
    hipError_t e = hipLaunchCooperativeKernel((const void*)mk_fwd, dim3(grid_blocks), dim3(NTHREADS), args, 0, stream);
    if (e != hipSuccess) fprintf(stderr, "cooperative launch failed: %s (grid %d)\n", hipGetErrorString(e), grid_blocks);
}
```
